# Optimizing an MI355X kernel written in HIP

```python
import math
import jax, jax.numpy as jnp
from jax import lax
import numpy as np

D_MODEL = 4096
BATCH = 1
SEQ = 8192
DEPTH = 2

D_MIX = D_MODEL
A_HEADS = 8
A_HDIM = 64
A_WIDTH = A_HEADS * 2 * A_HDIM
B_HDIM = 64
B_WIDTH = 2048
B_HEADS = B_WIDTH // B_HDIM
B_DECAY_LORA = 96
B_AAA_LORA = 96
B_MV_LORA = 64
B_GATE_LORA = 256
B_GN_EPS = 64e-5
C_HEADS = 8
C_HDIM = 128
C_WIDTH = C_HEADS * C_HDIM
IDX_HEADS = 16
IDX_HDIM = 64
TOPK_MAX = 256
D_FF = 4 * D_MODEL
Q_BLOCK = 128
EPS = 1e-6
SPLITS = (A_WIDTH, A_WIDTH, A_WIDTH,
          B_WIDTH, B_WIDTH, B_WIDTH,
          C_WIDTH, C_WIDTH, C_WIDTH,
          IDX_HEADS * IDX_HDIM, IDX_HDIM, IDX_HEADS)
D_IN = 3 * A_WIDTH + 3 * B_WIDTH + 3 * C_WIDTH + IDX_HEADS * IDX_HDIM + IDX_HDIM + IDX_HEADS

kernel_name = "hymba_diffattn_rwkv7_dsa_trunk"


def rms_norm(x, g, eps=EPS):
    xf = x.astype(jnp.float32)
    y = xf * lax.rsqrt(jnp.mean(xf * xf, axis=-1, keepdims=True) + eps)
    return (y * g.astype(jnp.float32)).astype(x.dtype)


def token_shift(t):
    return jnp.pad(t, ((0, 0), (1, 0), (0, 0)))[:, :-1]


def diff_attention(q, k, v, lam, lam_init, subln_g):
    B, S, _ = q.shape
    nb = S // Q_BLOCK
    scale = A_HDIM ** -0.5
    q = q.reshape(B, S, A_HEADS, 2, A_HDIM)
    k = k.reshape(B, S, A_HEADS, 2, A_HDIM)
    v = v.reshape(B, S, A_HEADS, 2 * A_HDIM)
    qb = q.reshape(B, nb, Q_BLOCK, A_HEADS, 2, A_HDIM).transpose(1, 0, 2, 3, 4, 5)
    kpos = jnp.arange(S)

    def block(args):
        qi, i = args
        qpos = i * Q_BLOCK + jnp.arange(Q_BLOCK)
        s = jnp.einsum('bqhmd,bkhmd->bhmqk', qi, k).astype(jnp.float32) * scale
        s = jnp.where(kpos[None, :] <= qpos[:, None], s, -jnp.inf)
        p = jax.nn.softmax(s, axis=-1)
        p = p[:, :, 0] - lam * p[:, :, 1]
        return jnp.einsum('bhqk,bkhe->bqhe', p.astype(v.dtype), v)

    o = lax.map(block, (qb, jnp.arange(nb)))
    o = o.transpose(1, 0, 2, 3, 4).reshape(B, S, A_HEADS, 2 * A_HDIM)
    o = rms_norm(o, subln_g) * (1.0 - lam_init)
    return o.reshape(B, S, A_WIDTH)


def wkv7_scan(r, w, k, v, a, b):
    Bsz, S, H, N = r.shape

    def step(state, inp):
        r_t, w_t, k_t, v_t, a_t, b_t = inp
        sa = jnp.einsum('bhvk,bhk->bhv', state, a_t)
        state = (state * w_t[:, :, None, :]
                 + sa[..., None] * b_t[:, :, None, :]
                 + v_t[..., None] * k_t[:, :, None, :])
        y = jnp.einsum('bhvk,bhk->bhv', state, r_t)
        return state, y

    xs = (r.transpose(1, 0, 2, 3), w.transpose(1, 0, 2, 3), k.transpose(1, 0, 2, 3),
          v.transpose(1, 0, 2, 3), a.transpose(1, 0, 2, 3), b.transpose(1, 0, 2, 3))
    s0 = jnp.zeros((Bsz, H, N, N), jnp.float32)
    _, y = lax.scan(step, s0, xs)
    return y.transpose(1, 0, 2, 3)


def rwkv7_mixer(h, r, k, v, mu_rkv, mu_wag, w0, w1, w2, a0, a1, a2, g1, g2,
                k_k, k_a, r_k, ln_w, ln_b, v_res):
    B, S, _ = h.shape
    f32 = jnp.float32
    r = r + (token_shift(r) - r) * mu_rkv[0]
    k = k + (token_shift(k) - k) * mu_rkv[1]
    v = v + (token_shift(v) - v) * mu_rkv[2]
    dh = token_shift(h) - h
    xw = h + dh * mu_wag[0]
    xa = h + dh * mu_wag[1]
    xg = h + dh * mu_wag[2]
    wlog = -jax.nn.softplus(-(w0 + jnp.tanh(xw @ w1) @ w2).astype(f32)) - 0.5
    decay = jnp.exp(-jnp.exp(wlog))
    a = jax.nn.sigmoid((a0 + (xa @ a1) @ a2).astype(f32))
    g = jax.nn.sigmoid(xg @ g1) @ g2
    if v_res is not None:
        v_first, v_mu, v0, v1, v2 = v_res
        xv = h + dh * v_mu
        v = v + (v_first - v) * jax.nn.sigmoid(v0 + (xv @ v1) @ v2)
    v_out = v

    def heads(t):
        return t.reshape(B, S, B_HEADS, B_HDIM).astype(f32)

    kk = heads(k * k_k)
    kk = kk / jnp.maximum(jnp.sqrt(jnp.sum(kk * kk, axis=-1, keepdims=True)), 1e-12)
    k_new = k.astype(f32) * (1.0 + (a - 1.0) * k_a.astype(f32))
    rh, kh, vh, ah = heads(r), heads(k_new), heads(v), heads(a)
    y = wkv7_scan(rh, heads(decay), kh, vh, -kk, kk * ah)
    mean = jnp.mean(y, axis=-1, keepdims=True)
    var = jnp.mean(jnp.square(y - mean), axis=-1, keepdims=True)
    yn = ((y - mean) * lax.rsqrt(var + B_GN_EPS)).reshape(B, S, B_WIDTH)
    yn = yn * ln_w.astype(f32) + ln_b.astype(f32)
    bonus = jnp.sum(rh * kh * r_k.astype(f32), axis=-1, keepdims=True) * vh
    out = (yn + bonus.reshape(B, S, B_WIDTH)) * g.astype(f32)
    return out.astype(h.dtype), v_out


def dsa_mixer(q, k, v, qi, ki, wi):
    B, S, _ = q.shape
    nb = S // Q_BLOCK
    topk = min(TOPK_MAX, S // 4)
    scale = C_HDIM ** -0.5
    q = q.reshape(B, S, C_HEADS, C_HDIM)
    k = k.reshape(B, S, C_HEADS, C_HDIM)
    v = v.reshape(B, S, C_HEADS, C_HDIM)
    qi = qi.reshape(B, S, IDX_HEADS, IDX_HDIM)
    wi = wi * (IDX_HEADS ** -0.5 * IDX_HDIM ** -0.5)
    qb = q.reshape(B, nb, Q_BLOCK, C_HEADS, C_HDIM).transpose(1, 0, 2, 3, 4)
    qib = qi.reshape(B, nb, Q_BLOCK, IDX_HEADS, IDX_HDIM).transpose(1, 0, 2, 3, 4)
    wib = wi.reshape(B, nb, Q_BLOCK, IDX_HEADS).transpose(1, 0, 2, 3)
    kpos = jnp.arange(S)

    def block(args):
        qc, qic, wic, i = args
        qpos = i * Q_BLOCK + jnp.arange(Q_BLOCK)
        dots = jnp.einsum('bqhd,bkd->bqhk', qic, ki).astype(jnp.float32)
        score = jnp.einsum('bqh,bqhk->bqk', wic.astype(jnp.float32), jax.nn.relu(dots))
        score = jnp.where(kpos[None, None, :] <= qpos[None, :, None], score, -jnp.inf)
        _, idx = lax.top_k(score, topk)
        kg = jax.vmap(lambda kb, ib: kb[ib])(k, idx)
        vg = jax.vmap(lambda vb, ib: vb[ib])(v, idx)
        valid = idx <= qpos[None, :, None]
        s = jnp.einsum('bqhd,bqkhd->bqhk', qc, kg).astype(jnp.float32) * scale
        s = jnp.where(valid[:, :, None, :], s, -jnp.inf)
        p = jax.nn.softmax(s, axis=-1)
        return jnp.einsum('bqhk,bqkhd->bqhd', p.astype(vg.dtype), vg)

    o = lax.map(block, (qb, qib, wib, jnp.arange(nb)))
    return o.transpose(1, 0, 2, 3, 4).reshape(B, S, C_WIDTH)


def setup_inputs(seed: int = 0) -> dict:
    key = jax.random.key(seed)
    keys = jax.random.split(key, 40)
    counter = [0]

    def nk():
        kk = keys[counter[0]]
        counter[0] += 1
        return kk

    def nrm(shape, scale):
        return scale * jax.random.normal(nk(), shape, jnp.float32)

    def unif(shape, lo, hi):
        return jax.random.uniform(nk(), shape, jnp.float32, lo, hi)

    L = DEPTH
    Lv = DEPTH - 1
    return {
        "x": nrm((BATCH, SEQ, D_MODEL), 1.0),
        "norm_mix_g": 1.0 + nrm((L, D_MODEL), 0.02),
        "w_in": nrm((L, D_MODEL, D_IN), D_MODEL ** -0.5),
        "lam_q1": nrm((L, A_HDIM), 0.1),
        "lam_k1": nrm((L, A_HDIM), 0.1),
        "lam_q2": nrm((L, A_HDIM), 0.1),
        "lam_k2": nrm((L, A_HDIM), 0.1),
        "diff_subln_g": 1.0 + nrm((L, 2 * A_HDIM), 0.02),
        "rw_mu_rkv": unif((L, 3, B_WIDTH), 0.0, 1.0),
        "rw_mu_wag": unif((L, 3, D_MODEL), 0.0, 1.0),
        "rw_w0": unif((L, B_WIDTH), -4.0, 1.0),
        "rw_w1": nrm((L, D_MODEL, B_DECAY_LORA), D_MODEL ** -0.5),
        "rw_w2": nrm((L, B_DECAY_LORA, B_WIDTH), 0.1 * B_DECAY_LORA ** -0.5),
        "rw_a0": nrm((L, B_WIDTH), 0.1),
        "rw_a1": nrm((L, D_MODEL, B_AAA_LORA), D_MODEL ** -0.5),
        "rw_a2": nrm((L, B_AAA_LORA, B_WIDTH), 0.5 * B_AAA_LORA ** -0.5),
        "rw_g1": nrm((L, D_MODEL, B_GATE_LORA), D_MODEL ** -0.5),
        "rw_g2": nrm((L, B_GATE_LORA, B_WIDTH), B_GATE_LORA ** -0.5),
        "rw_k_k": 0.85 + nrm((L, B_WIDTH), 0.05),
        "rw_k_a": 1.0 + nrm((L, B_WIDTH), 0.05),
        "rw_r_k": nrm((L, B_HEADS, B_HDIM), 0.1),
        "rw_ln_w": 1.0 + nrm((L, B_WIDTH), 0.02),
        "rw_ln_b": nrm((L, B_WIDTH), 0.02),
        "rw_v_mu": unif((Lv, D_MODEL), 0.0, 1.0),
        "rw_v0": 0.5 + nrm((Lv, B_WIDTH), 0.1),
        "rw_v1": nrm((Lv, D_MODEL, B_MV_LORA), D_MODEL ** -0.5),
        "rw_v2": nrm((Lv, B_MV_LORA, B_WIDTH), 0.5 * B_MV_LORA ** -0.5),
        "w_out": nrm((L, D_MIX, D_MODEL), D_MIX ** -0.5),
        "norm_ffn_g": 1.0 + nrm((L, D_MODEL), 0.02),
        "w_up": nrm((L, D_MODEL, D_FF), D_MODEL ** -0.5),
        "w_down": nrm((L, D_FF, D_MODEL), D_FF ** -0.5),
        "norm_final_g": 1.0 + nrm((D_MODEL,), 0.02),
    }


def reference(x, norm_mix_g, w_in, lam_q1, lam_k1, lam_q2, lam_k2, diff_subln_g,
              rw_mu_rkv, rw_mu_wag, rw_w0, rw_w1, rw_w2, rw_a0, rw_a1, rw_a2,
              rw_g1, rw_g2, rw_k_k, rw_k_a, rw_r_k, rw_ln_w, rw_ln_b,
              rw_v_mu, rw_v0, rw_v1, rw_v2, w_out, norm_ffn_g, w_up, w_down,
              norm_final_g):
    cuts = []
    acc = 0
    for s in SPLITS[:-1]:
        acc += s
        cuts.append(acc)
    v_first = None
    for l in range(DEPTH):
        h = rms_norm(x, norm_mix_g[l])
        proj = h @ w_in[l]
        (qa, ka, va, rb, kb, vb, qc, kc, vc, qi, ki, wi) = jnp.split(proj, cuts, axis=-1)
        lam_init = 0.8 - 0.6 * math.exp(-0.3 * l)
        lam = (jnp.exp(jnp.sum(lam_q1[l] * lam_k1[l]).astype(jnp.float32))
               - jnp.exp(jnp.sum(lam_q2[l] * lam_k2[l]).astype(jnp.float32)) + lam_init)
        o_a = diff_attention(qa, ka, va, lam, lam_init, diff_subln_g[l])
        v_res = None if l == 0 else (v_first, rw_v_mu[l - 1], rw_v0[l - 1], rw_v1[l - 1], rw_v2[l - 1])
        o_b, v_out = rwkv7_mixer(h, rb, kb, vb, rw_mu_rkv[l], rw_mu_wag[l], rw_w0[l], rw_w1[l], rw_w2[l],
                                 rw_a0[l], rw_a1[l], rw_a2[l], rw_g1[l], rw_g2[l], rw_k_k[l], rw_k_a[l],
                                 rw_r_k[l], rw_ln_w[l], rw_ln_b[l], v_res)
        if l == 0:
            v_first = v_out
        o_c = dsa_mixer(qc, kc, vc, qi, ki, wi)
        mixed = jnp.concatenate([o_a, o_b.astype(o_a.dtype), o_c], axis=-1)
        x = x + mixed @ w_out[l]
        h2 = rms_norm(x, norm_ffn_g[l])
        x = x + jnp.square(jax.nn.relu(h2 @ w_up[l])) @ w_down[l]
    return rms_norm(x, norm_final_g)
```

```cpp
#include <hip/hip_runtime.h>
#include <hip/hip_bf16.h>
#include <cstdio>
#include <cstdint>
#include <cmath>
#include <unistd.h>
namespace pg8 {
#define PG8_LAS __attribute__((address_space(3)))
typedef unsigned short bf16_t;
typedef short bf16x8 __attribute__((ext_vector_type(8)));
typedef float f32x4 __attribute__((ext_vector_type(4)));
typedef unsigned u32x4 __attribute__((ext_vector_type(4)));
constexpr int BM = 256, BK = 64, HALF = 128, HTB = HALF * BK * 2  , STAGE_BYTES = 8 * HTB, NXCD = 8, WGM = 8;

__host__ __device__ __forceinline__ int lds_byte(int r, int c) { const int st = (r >> 4) * 2 + (c >> 5), rr = r & 15, cc = c & 31, ob = rr * 64 + cc * 2; return st * 1024 + (ob ^ (((ob >> 9) & 1) << 5)); }
__host__ __device__ __forceinline__ void stage_rc(int b, int& R, int& C) { const int st = b / 1024, sb = b % 1024, swz = sb ^ (((sb >> 9) & 1) << 5); R = (st >> 1) * 16 + swz / 64; C = (st & 1) * 32 + (swz % 64) / 2; }
__host__ __device__ __forceinline__ int perm32(int rho) { const int n = rho >> 4, i = rho & 15; return 8 * (i >> 2) + 4 * n + (i & 3); }

struct Unit { int pm, pn; };
struct Gemm { const bf16_t* A; const bf16_t* Bt; int M, N, K, lda, ldb; };

struct StaticOrder {
    int nM, nN, nwg, G, c;
    __host__ __device__ void init(int M, int N, int G_, int c_) { nM = M / BM; nN = N / BM; nwg = nM * nN; G = G_; c = c_; }
    __host__ __device__ bool next(int i, Unit& u) const {
        const long L = (long)i * G + c; if (L >= nwg) return false;
        int wgid = (int)L; { const int q = nwg / NXCD, r = nwg % NXCD, xcd = wgid % NXCD, off = wgid / NXCD; wgid = (xcd < r ? xcd * (q + 1) : r * (q + 1) + (xcd - r) * q) + off; }
        const int nig = WGM * nN, gid = wgid / nig, fm = gid * WGM, gsz = (nM - fm) < WGM ? (nM - fm) : WGM;
        u.pm = fm + ((wgid % nig) % gsz); u.pn = (wgid % nig) / gsz; return true;
    }
    __device__ __forceinline__ void a_ready(const Unit&) const {}
    __device__ __forceinline__ size_t a_off(const Unit&) const { return 0; }
    __device__ __forceinline__ void done(const Unit&) const {}
};


__device__ __forceinline__ unsigned cvt_pk_bf16(float lo, float hi) { unsigned r; asm volatile("v_cvt_pk_bf16_f32 %0, %1, %2" : "=v"(r) : "v"(lo), "v"(hi)); return r; }
template <int MODE> struct EpiBf16x {
    static constexpr bool PERM = true, AFTER_DRAIN = false;
    bf16_t* O; int ldc; float sc; int nsc;
    __device__ __forceinline__ void operator()(const f32x4 (&acc)[2][2][4][2], const Unit& u, int wr, int wc, int fr, int fq) const {
        const int row0 = u.pm * BM + wr * 64 + fr, col0 = u.pn * BM + wc * 32 + 8 * fq;
        const float s = (MODE == 0 && u.pn < nsc) ? sc : 1.f;
#pragma unroll
        for (int ai = 0; ai < 2; ++ai)
#pragma unroll
            for (int m = 0; m < 4; ++m) { bf16_t* rowp = O + (size_t)(row0 + ai * HALF + m * 16) * ldc + col0;
#pragma unroll
                for (int bj = 0; bj < 2; ++bj) { f32x4 v0 = acc[ai][bj][m][0], v1 = acc[ai][bj][m][1];
                    if (MODE == 0) { v0 = v0 * s; v1 = v1 * s; }
                    if (MODE == 1) {
#pragma unroll
                        for (int j = 0; j < 4; ++j) { const float a = fmaxf(v0[j], 0.f), b = fmaxf(v1[j], 0.f); v0[j] = a * a; v1[j] = b * b; } }
                    u32x4 w; w.x = cvt_pk_bf16(v0[0], v0[1]); w.y = cvt_pk_bf16(v0[2], v0[3]); w.z = cvt_pk_bf16(v1[0], v1[1]); w.w = cvt_pk_bf16(v1[2], v1[3]);
                    *(u32x4*)(rowp + bj * HALF) = w; } }
    }
};
struct EpiF32x {
    static constexpr bool PERM = false, AFTER_DRAIN = false;
    float* C; int ldc; const float* base;
    __device__ __forceinline__ void operator()(const f32x4 (&acc)[2][2][4][2], const Unit& u, int wr, int wc, int fr, int fq) const {
        const int row0 = u.pm * BM + wr * 64 + fr, col0 = u.pn * BM + wc * 32 + 4 * fq;
#pragma unroll
        for (int ai = 0; ai < 2; ++ai)
#pragma unroll
            for (int m = 0; m < 4; ++m) { const size_t off = (size_t)(row0 + ai * HALF + m * 16) * ldc + col0;
#pragma unroll
                for (int bj = 0; bj < 2; ++bj)
#pragma unroll
                    for (int n = 0; n < 2; ++n) { f32x4 v = acc[ai][bj][m][n]; if (base) v = v + *(const f32x4*)(base + off + bj * HALF + n * 16); *(f32x4*)(C + off + bj * HALF + n * 16) = v; }
                asm volatile("" ::: "memory"); }
    }
};
struct LoraOrder : StaticOrder {
    __device__ __forceinline__ size_t a_off(const Unit& u) const { return (size_t)(u.pn >> 3) * 256 * 2; }
};
template <class Epi, class Sched, bool ALIGN_EPI = false, bool SP2 = false>
__device__ __forceinline__ void gemm_phase(PG8_LAS unsigned char* lds, const Gemm g, const Sched& S, const Epi& E, const int tid) {
    const int wid = __builtin_amdgcn_readfirstlane(tid >> 6), lane = tid & 63, wr = wid >> 2, wc = wid & 3, fr = lane & 15, fq = lane >> 4;
    const int K = g.K, nt = K / BK;
    unsigned voffA[2], voffB[2];
#pragma unroll
    for (int i = 0; i < 2; ++i) { int R, C; stage_rc(tid * 16 + i * 8192, R, C); const int Rb = Epi::PERM ? ((R & ~31) + perm32(R & 31)) : R;
        voffA[i] = (unsigned)(R * g.lda + C) * 2u; voffB[i] = (unsigned)(Rb * g.ldb + C) * 2u; }
    const size_t kstep = (size_t)(BK * 2);
    const size_t hA = (size_t)HALF * g.lda * 2, hB = (size_t)HALF * g.ldb * 2;
    const size_t tA = 2 * hA, tB = 2 * hB;
    const unsigned ldsw = (unsigned)wid * 1024u;
    const int aoff = lds_byte(wr * 64 + fr, fq * 8), boff = lds_byte(wc * 32 + fr, fq * 8);
#define PG8_SA(b, h) (((b) * 2 + (h)) * HTB)
#define PG8_SB(b, h) ((4 + (b) * 2 + (h)) * HTB)
#define PG8_STAGE(bufoff, gbase, voff) do { _Pragma("unroll") for (int _i = 0; _i < 2; ++_i) \
        __builtin_amdgcn_global_load_lds((const unsigned*)((const char*)(gbase) + (voff)[_i]), (PG8_LAS unsigned*)(lds + (bufoff) + ldsw + _i * 8192), 16, 0, 0); } while (0)
#define PG8_LDA(dst, b, h) do { _Pragma("unroll") for (int m = 0; m < 4; ++m) _Pragma("unroll") for (int k = 0; k < 2; ++k) dst[m][k] = *(const PG8_LAS bf16x8*)(lds + PG8_SA(b, h) + aoff + m * 2048 + k * 1024); } while (0)
#define PG8_LDB(dst, b, h) do { _Pragma("unroll") for (int n = 0; n < 2; ++n) _Pragma("unroll") for (int k = 0; k < 2; ++k) dst[n][k] = *(const PG8_LAS bf16x8*)(lds + PG8_SB(b, h) + boff + n * 2048 + k * 1024); } while (0)
#define PG8_MMA(ai, bj, At, Bt) do { __builtin_amdgcn_s_setprio(1); _Pragma("unroll") for (int m = 0; m < 4; ++m) _Pragma("unroll") for (int n = 0; n < 2; ++n) _Pragma("unroll") for (int k = 0; k < 2; ++k) \
        acc[ai][bj][m][n] = __builtin_amdgcn_mfma_f32_16x16x32_bf16(Bt[n][k], At[m][k], acc[ai][bj][m][n], 0, 0, 0); __builtin_amdgcn_s_setprio(0); } while (0)
#define PG8_WAIT_V(n) asm volatile("s_waitcnt vmcnt(" #n ")" ::: "memory")
#define PG8_WAIT_L(n) asm volatile("s_waitcnt lgkmcnt(" #n ")" ::: "memory")
#define PG8_BAR __builtin_amdgcn_s_barrier()
#define PG8_SCHED __builtin_amdgcn_sched_barrier(0)
    Unit cur, nxt; int ui = 0;
    if (!S.next(0, cur)) return;
    f32x4 acc[2][2][4][2];
#pragma unroll
    for (int a = 0; a < 2; ++a)
#pragma unroll
        for (int b = 0; b < 2; ++b)
#pragma unroll
            for (int m = 0; m < 4; ++m)
#pragma unroll
                for (int n = 0; n < 2; ++n) acc[a][b][m][n] = (f32x4){0.f, 0.f, 0.f, 0.f};
    bf16x8 At[4][2], B0[2][2], B1[2][2];
    const char* cA = (const char*)g.A + (size_t)cur.pm * tA + S.a_off(cur); const char* cB = (const char*)g.Bt + (size_t)cur.pn * tB;
    S.a_ready(cur);
    if constexpr (SP2) {
        PG8_STAGE(PG8_SB(0, 0), cB, voffB); PG8_STAGE(PG8_SB(0, 1), cB + hB, voffB); PG8_STAGE(PG8_SA(0, 0), cA, voffA); PG8_STAGE(PG8_SA(0, 1), cA + hA, voffA);
        if (wr == 1) PG8_BAR;
        PG8_WAIT_V(2); PG8_BAR;
        PG8_STAGE(PG8_SB(1, 0), cB + kstep, voffB); PG8_STAGE(PG8_SA(1, 0), cA + kstep, voffA); PG8_STAGE(PG8_SB(1, 1), cB + hB + kstep, voffB);
        PG8_WAIT_V(6); PG8_BAR;
    } else {
        PG8_STAGE(PG8_SB(0, 0), cB, voffB); PG8_STAGE(PG8_SA(0, 0), cA, voffA); PG8_STAGE(PG8_SB(0, 1), cB + hB, voffB); PG8_STAGE(PG8_SA(0, 1), cA + hA, voffA);
        if (wr == 1) PG8_BAR;
        PG8_WAIT_V(4); PG8_BAR;
        PG8_STAGE(PG8_SB(1, 0), cB + kstep, voffB); PG8_STAGE(PG8_SA(1, 0), cA + kstep, voffA); PG8_STAGE(PG8_SB(1, 1), cB + hB + kstep, voffB);
        PG8_WAIT_V(6); PG8_BAR;
    }
    for (;;) {
        const bool has_next = S.next(ui + 1, nxt);
        const char* nA = has_next ? (const char*)g.A + (size_t)nxt.pm * tA + S.a_off(nxt) : cA; const char* nB = has_next ? (const char*)g.Bt + (size_t)nxt.pn * tB : cB;
        for (int t = 0; t < nt; t += 2) {
            const bool last = (t == nt - 2);
            const char* a1 = cA + (size_t)(t + 1) * kstep;
            const char* a2 = last ? nA : cA + (size_t)(t + 2) * kstep; const char* b2 = last ? nB : cB + (size_t)(t + 2) * kstep;
            const char* a3 = a2 + kstep; const char* b3 = b2 + kstep;
            if (last && has_next) S.a_ready(nxt);
            if constexpr (SP2) {
            PG8_LDB(B0, 0, 0); PG8_LDB(B1, 0, 1); PG8_SCHED; PG8_LDA(At, 0, 0); PG8_STAGE(PG8_SA(1, 1), a1 + hA, voffA);
            PG8_WAIT_V(8); PG8_WAIT_L(0); PG8_BAR; PG8_MMA(0, 0, At, B0); PG8_MMA(0, 1, At, B1); PG8_BAR; PG8_SCHED;
            PG8_LDA(At, 0, 1); PG8_STAGE(PG8_SB(0, 0), b2, voffB); PG8_STAGE(PG8_SB(0, 1), b2 + hB, voffB); PG8_STAGE(PG8_SA(0, 0), a2, voffA);
            PG8_WAIT_V(8); PG8_WAIT_L(0); PG8_BAR; PG8_MMA(1, 0, At, B0); PG8_MMA(1, 1, At, B1); PG8_BAR; PG8_SCHED;
            PG8_LDB(B0, 1, 0); PG8_LDB(B1, 1, 1); PG8_SCHED; PG8_LDA(At, 1, 0); PG8_STAGE(PG8_SA(0, 1), a2 + hA, voffA);
            PG8_WAIT_V(8); PG8_WAIT_L(0); PG8_BAR; PG8_MMA(0, 0, At, B0); PG8_MMA(0, 1, At, B1); PG8_BAR; PG8_SCHED;
            PG8_LDA(At, 1, 1); PG8_STAGE(PG8_SB(1, 0), b3, voffB); PG8_STAGE(PG8_SB(1, 1), b3 + hB, voffB); PG8_STAGE(PG8_SA(1, 0), a3, voffA);
            PG8_WAIT_V(8); PG8_WAIT_L(0); PG8_BAR; PG8_MMA(1, 0, At, B0); PG8_MMA(1, 1, At, B1); PG8_BAR; PG8_SCHED;
            } else {
            PG8_LDB(B0, 0, 0); PG8_SCHED; PG8_LDA(At, 0, 0); PG8_STAGE(PG8_SA(1, 1), a1 + hA, voffA);
            PG8_WAIT_L(8); PG8_BAR; PG8_WAIT_L(0); PG8_MMA(0, 0, At, B0); PG8_BAR; PG8_SCHED;
            PG8_LDB(B1, 0, 1); PG8_STAGE(PG8_SB(0, 0), b2, voffB);
            PG8_BAR; PG8_WAIT_L(0); PG8_MMA(0, 1, At, B1); PG8_BAR;
            PG8_LDA(At, 0, 1); PG8_STAGE(PG8_SA(0, 0), a2, voffA);
            PG8_BAR; PG8_WAIT_L(0); PG8_MMA(1, 0, At, B0); PG8_BAR; PG8_SCHED;
            PG8_STAGE(PG8_SB(0, 1), b2 + hB, voffB);
            PG8_WAIT_V(6); PG8_BAR; PG8_MMA(1, 1, At, B1); PG8_BAR;
            PG8_LDB(B0, 1, 0); PG8_SCHED; PG8_LDA(At, 1, 0); PG8_STAGE(PG8_SA(0, 1), a2 + hA, voffA);
            PG8_WAIT_L(8); PG8_BAR; PG8_WAIT_L(0); PG8_MMA(0, 0, At, B0); PG8_BAR; PG8_SCHED;
            PG8_LDB(B1, 1, 1); PG8_STAGE(PG8_SB(1, 0), b3, voffB);
            PG8_BAR; PG8_WAIT_L(0); PG8_MMA(0, 1, At, B1); PG8_BAR;
            PG8_LDA(At, 1, 1); PG8_STAGE(PG8_SA(1, 0), a3, voffA);
            PG8_BAR; PG8_WAIT_L(0); PG8_MMA(1, 0, At, B0); PG8_BAR; PG8_SCHED;
            PG8_STAGE(PG8_SB(1, 1), b3 + hB, voffB);
            PG8_WAIT_V(6); PG8_BAR; PG8_MMA(1, 1, At, B1); PG8_BAR;
            }
        }
        if constexpr (ALIGN_EPI) { if (wr == 0) PG8_BAR; }
        if constexpr (!Epi::AFTER_DRAIN) { E(acc, cur, wr, wc, fr, fq); S.done(cur); }
        if (!has_next) break;
#pragma unroll
        for (int a = 0; a < 2; ++a)
#pragma unroll
            for (int b = 0; b < 2; ++b)
#pragma unroll
                for (int m = 0; m < 4; ++m)
#pragma unroll
                    for (int n = 0; n < 2; ++n) acc[a][b][m][n] = (f32x4){0.f, 0.f, 0.f, 0.f};
        cur = nxt; cA = nA; cB = nB; ++ui;
        if constexpr (ALIGN_EPI) { if (wr == 1) PG8_BAR; }
    }
    PG8_WAIT_V(0);
    if constexpr (!ALIGN_EPI) { if (wr == 0) PG8_BAR; }
    PG8_BAR;
    if constexpr (Epi::AFTER_DRAIN) { E.fused(acc, cur, wr, wc, fr, fq, lds, wid, lane); S.done(cur); }
#undef PG8_SA
#undef PG8_SB
#undef PG8_STAGE
#undef PG8_LDA
#undef PG8_LDB
#undef PG8_MMA
#undef PG8_WAIT_V
#undef PG8_WAIT_L
#undef PG8_BAR
#undef PG8_SCHED
}
}
#include <hip/hip_bf16.h>
#include <cmath>
namespace attn_body {
using bf16=__hip_bfloat16;
using bf16x8=__attribute__((ext_vector_type(8)))short;
using s16x4=__attribute__((ext_vector_type(4)))short;
using f32x16=__attribute__((ext_vector_type(16)))float;
using u32x4=__attribute__((ext_vector_type(4)))unsigned;
constexpr int SEQ=8192,D=64,DM=14592,DO=1024;
constexpr int NW=8,QBLK=32,QB=QBLK*NW,KVBLK=64,NQB=SEQ/QB;
constexpr int ATTN_UNIT_ROWS=QB;
__device__ __forceinline__ int crow(int r,int hi){return (r&3)+8*(r>>2)+4*hi;}
#define SBAR() __builtin_amdgcn_sched_barrier(0)
__device__ __forceinline__ void cmask(f32x16&p0,f32x16&p1,int jb,int qrel,int hi){
  const float NEG=-INFINITY; int kb=64*jb+4*hi;
  #pragma unroll
  for(int r=0;r<16;++r){int kv=kb+(r&3)+8*(r>>2); if(kv>qrel)p0[r]=NEG; if(kv+32>qrel)p1[r]=NEG;}
}

constexpr int NSLOT=3, SLOTB=8192;
constexpr int LDS_K=0, LDS_V=NSLOT*SLOTB, LDS_WS=2*NSLOT*SLOTB, LDS_OST=LDS_WS+NW*64*4, LDS_BYTES=LDS_OST+NW*4096;
constexpr float C2=0.125f*1.4426950408889634f;
__device__ __forceinline__ void glds16(const void*sbase,unsigned voff,unsigned lds_dst){unsigned keep;
  asm volatile("s_mov_b32 %0, m0\n\ts_mov_b32 m0, %3\n\ts_nop 0\n\tglobal_load_lds_dwordx4 %1, %2\n\ts_mov_b32 m0, %0":"=&s"(keep):"v"(voff),"s"(sbase),"s"(lds_dst):"memory");}
__device__ __forceinline__ float max3f(float a,float b,float c){float r;asm("v_max3_f32 %0, %1, %2, %3":"=v"(r):"v"(a),"v"(b),"v"(c));return r;}
__device__ __forceinline__ float max2f(float a,float b){float r;asm("v_max_f32_e32 %0, %1, %2":"=v"(r):"v"(a),"v"(b));return r;}
__device__ __forceinline__ float fadd_s(float a,float b){float r;asm("v_add_f32_e32 %0, %1, %2":"=v"(r):"v"(a),"v"(b));return r;}
__device__ __forceinline__ float fsub_s(float a,float b){float r;asm("v_sub_f32_e32 %0, %1, %2":"=v"(r):"v"(a),"v"(b));return r;}
typedef float f32x2_t __attribute__((ext_vector_type(2))); typedef __bf16 bf16x2_t __attribute__((ext_vector_type(2)));
__device__ __forceinline__ unsigned cvtpk_s(float lo,float hi){f32x2_t v={lo,hi};bf16x2_t b=__builtin_convertvector(v,bf16x2_t);return __builtin_bit_cast(unsigned,b);}
#define WAIT_BAR(N) asm volatile("s_waitcnt vmcnt(" #N ") lgkmcnt(0)\n\ts_barrier":::"memory")

__device__ __forceinline__ void qkt(f32x16&p0,f32x16&p1,const char*Kslot,const bf16x8*qr,const f32x16&negm,int r32,int hi){
  const char*kb=Kslot+hi*1024+r32*16;
  #pragma unroll
  for(int d0=0;d0<4;++d0){
    const bf16x8 b0=*reinterpret_cast<const bf16x8*>(kb+d0*2048);
    const bf16x8 b1=*reinterpret_cast<const bf16x8*>(kb+d0*2048+512);
    if(d0==0){p0=__builtin_amdgcn_mfma_f32_32x32x16_bf16(b0,qr[0],negm,0,0,0);p1=__builtin_amdgcn_mfma_f32_32x32x16_bf16(b1,qr[0],negm,0,0,0);}
    else{p0=__builtin_amdgcn_mfma_f32_32x32x16_bf16(b0,qr[d0],p0,0,0,0);p1=__builtin_amdgcn_mfma_f32_32x32x16_bf16(b1,qr[d0],p1,0,0,0);}}
}
typedef __attribute__((address_space(3))) const char* lds_cptr;
typedef short v4i16_t __attribute__((ext_vector_type(4)));
__device__ __forceinline__ void kload8(bf16x8*kf,lds_cptr kp){
  kf[0]=*(const __attribute__((address_space(3))) bf16x8*)(kp);      kf[1]=*(const __attribute__((address_space(3))) bf16x8*)(kp+512);
  kf[2]=*(const __attribute__((address_space(3))) bf16x8*)(kp+2048); kf[3]=*(const __attribute__((address_space(3))) bf16x8*)(kp+2560);
  kf[4]=*(const __attribute__((address_space(3))) bf16x8*)(kp+4096); kf[5]=*(const __attribute__((address_space(3))) bf16x8*)(kp+4608);
  kf[6]=*(const __attribute__((address_space(3))) bf16x8*)(kp+6144); kf[7]=*(const __attribute__((address_space(3))) bf16x8*)(kp+6656);
}
__device__ __forceinline__ void kload2(bf16x8*kf,lds_cptr kp,int j){ kf[2*j]=*(const __attribute__((address_space(3))) bf16x8*)(kp+j*2048); kf[2*j+1]=*(const __attribute__((address_space(3))) bf16x8*)(kp+j*2048+512); }
__device__ __forceinline__ s16x4 vtr(lds_cptr p){ return __builtin_bit_cast(s16x4,__builtin_amdgcn_ds_read_tr16_b64_v4i16((__attribute__((address_space(3))) v4i16_t*)p)); }
__device__ __forceinline__ float rowmax(const f32x16&p0,const f32x16&p1){
  float a=max3f(p0[0],p0[1],p1[0]),b=max3f(p0[2],p0[3],p1[1]);a=max3f(a,p1[2],p1[3]);
  #pragma unroll
  for(int r=4;r<16;r+=4){a=max3f(a,p0[r],p0[r+1]);b=max3f(b,p0[r+2],p0[r+3]);a=max3f(a,p1[r],p1[r+1]);b=max3f(b,p1[r+2],p1[r+3]);}
  const float m=max2f(a,b);
  auto rr=__builtin_amdgcn_permlane32_swap(__float_as_uint(m),__float_as_uint(m),false,false);
  return max2f(__uint_as_float(rr[0]),__uint_as_float(rr[1]));
}
__device__ __forceinline__ void pv(f32x16*o,int vb,bf16x8 pa0,bf16x8 pa1,bf16x8 pa2,bf16x8 pa3){
  #pragma unroll
  for(int d0=0;d0<2;++d0){s16x4 lo[4],hi[4];
    #pragma unroll
    for(int ks=0;ks<4;++ks){
      asm volatile("ds_read_b64_tr_b16 %0,%1 offset:%c2":"=&v"(lo[ks]):"v"(vb),"i"(d0*4096+ks*1024):"memory");
      asm volatile("ds_read_b64_tr_b16 %0,%1 offset:%c2":"=&v"(hi[ks]):"v"(vb),"i"(d0*4096+ks*1024+512):"memory");}
    asm volatile("s_waitcnt lgkmcnt(0)":::"memory");SBAR();
    #define PK(k) (bf16x8){lo[k][0],lo[k][1],lo[k][2],lo[k][3],hi[k][0],hi[k][1],hi[k][2],hi[k][3]}
    o[d0]=__builtin_amdgcn_mfma_f32_32x32x16_bf16(pa0,PK(0),o[d0],0,0,0);
    o[d0]=__builtin_amdgcn_mfma_f32_32x32x16_bf16(pa1,PK(1),o[d0],0,0,0);
    o[d0]=__builtin_amdgcn_mfma_f32_32x32x16_bf16(pa2,PK(2),o[d0],0,0,0);
    o[d0]=__builtin_amdgcn_mfma_f32_32x32x16_bf16(pa3,PK(3),o[d0],0,0,0);
    #undef PK
  }
}

#ifndef ATTN_STORE16
#define ATTN_STORE16(p,v) (*(u32x4*)(p)=(v))
#endif
template<int THRL> __device__ __forceinline__ void attn_unit(int qc,int kc,int vc,int oc,int qb,const bf16*Q,const bf16*__restrict__ K,const bf16*__restrict__ V,bf16*O,char*shm,const int tid){
  const int lane=tid&63,r32=lane&31,hi=lane>>5; const int wid=__builtin_amdgcn_readfirstlane(tid>>6);
  const long rowbase=0; const int q0=qb*QB;
  const bf16*Qw=Q+(rowbase+q0+wid*QBLK)*DM+qc;
  const bf16*Kh=K+rowbase*DM+kc,*Vh=V+rowbase*DM+vc;
  const unsigned lds0=(unsigned)(uintptr_t)shm;
  float*wsf=(float*)(shm+LDS_WS)+wid*64;
  const unsigned koff=(unsigned)(lane*DM+wid*8)*2u;
  const unsigned voff=(unsigned)((16*(wid&3)+(lane>>2))*DM+(wid>>2)*32+(lane&3)*8)*2u;
  const unsigned kdst=lds0+LDS_K+wid*1024, vdst=lds0+LDS_V+wid*1024;
  #define DMA_K(t,slot) glds16((const char*)Kh+(size_t)(t)*(KVBLK*DM*2),koff,(unsigned)__builtin_amdgcn_readfirstlane(kdst+(slot)))
  #define DMA_V(t,slot) glds16((const char*)Vh+(size_t)(t)*(KVBLK*DM*2),voff,(unsigned)__builtin_amdgcn_readfirstlane(vdst+(slot)))
  const int vb0=(int)(lds0+LDS_V)+((lane>>4)&1)*32+(lane&3)*8+(4*hi+((lane&15)>>2))*64;
  const char*Kbase=shm+LDS_K; bf16x8 kf[8];
  const lds_cptr shm3=(lds_cptr)shm; const lds_cptr kp0=shm3+LDS_K+hi*1024+r32*16; const lds_cptr vp0=shm3+LDS_V+((lane>>4)&1)*32+(lane&3)*8+(4*hi+((lane&15)>>2))*64;
  const int NT=(q0+QB)/KVBLK;
  DMA_K(0,0);DMA_V(0,0);DMA_K(1,SLOTB);
  bf16x8 qr[4];
  #pragma unroll
  for(int d0=0;d0<4;++d0)qr[d0]=*reinterpret_cast<const bf16x8*>(&Qw[(long)r32*DM+d0*16+hi*8]);
  float mhat=0.f,l_reg=0.f;f32x16 o[2];o[0]=f32x16{};o[1]=f32x16{};f32x16 negm=f32x16{};asm volatile("":"+v"(negm));
  const int qrel=wid*QBLK+r32;
  #define CMASK(P0,P1,t) do{int jb_=(t)-(NT-4); if(jb_>=0)cmask(P0,P1,jb_,qrel,hi);}while(0)
  bool resc=false;
  #define START(P0,P1) do{ const float rm=rowmax(P0,P1); resc=false; \
    { const float dl=rm; mhat=fadd_s(mhat,dl); \
      _Pragma("unroll") for(int r=0;r<16;++r){P0[r]=fsub_s(P0[r],dl);P1[r]=fsub_s(P1[r],dl);} \
      _Pragma("unroll") for(int r=0;r<16;++r)negm[r]=-mhat; asm volatile("":"+v"(negm)); } \
    _Pragma("unroll") for(int r=0;r<16;++r)P0[r]=__builtin_amdgcn_exp2f(P0[r]); }while(0)
  #define RESC() do{ if(resc){ asm volatile("s_waitcnt lgkmcnt(0)":::"memory"); \
      _Pragma("unroll") for(int d_=0;d_<2;++d_) _Pragma("unroll") for(int r=0;r<16;++r)o[d_][r]*=wsf[crow(r,hi)]; } }while(0)
  f32x16 pA0,pA1,pB0,pB1;
  int sl_prev=0,sl_cur=0,sl_next=SLOTB;
  #define ROT() do{sl_prev=sl_cur;sl_cur=sl_next;sl_next=(sl_next==(NSLOT-1)*SLOTB)?0:sl_next+SLOTB;}while(0)
  DMA_K(2,2*SLOTB);
  WAIT_BAR(3);
  qkt(pA0,pA1,Kbase,qr,negm,r32,hi);asm volatile("s_nop 15\n\ts_nop 7":"+v"(pA0),"+v"(pA1));CMASK(pA0,pA1,0);
  START(pA0,pA1);
  _Pragma("unroll") for(int r=0;r<16;++r)pA1[r]=__builtin_amdgcn_exp2f(pA1[r]);
  WAIT_BAR(0);
  DMA_K(3,0);DMA_V(1,SLOTB);
  ROT();
  kload8(kf,kp0+sl_cur);
  WAIT_BAR(2);
  s16x4 vlo[8],vhi[8]; u32x4 pw0,pw1,pw2,pw3;
  #define PKW(P,B) cvtpk_s(P[B],P[B+1])
  #define PAF(k) __builtin_bit_cast(bf16x8,pw##k)
  #define VFR(i) (bf16x8){vlo[i][0],vlo[i][1],vlo[i][2],vlo[i][3],vhi[i][0],vhi[i][1],vhi[i][2],vhi[i][3]}
  #define PIN(x) asm volatile("":"+v"(x))
  #define MX3(a,b,c) __builtin_fmaxf(__builtin_fmaxf((a),(b)),(c))
  #define GAPA(MF,A0,A1,A2,A3,W0,W1,PW) do{ MF; sacc+=A0; sacc+=A1; sacc+=A2; sacc+=A3; PIN(sacc); W0; W1; PIN(PW); SBAR(); }while(0)
  #define EX(v) __builtin_amdgcn_exp2f(v)
  #define GAPB(MF,X,B) do{ MF; X[B]=EX(X[B]); X[B+1]=EX(X[B+1]); X[B+2]=EX(X[B+2]); X[B+3]=EX(X[B+3]); PIN(X); SBAR(); }while(0)
  #define VRD(i) do{ vlo[i]=vtr(vp_+(((i)>>2)*4096+((i)&3)*1024)); vhi[i]=vtr(vp_+(((i)>>2)*4096+((i)&3)*1024+512)); }while(0)
  #define KRD(G,j) do{ if(G){ kload2(kf,kp0+sl_next,j); SBAR(); } }while(0)
  #define STEP(C0,C1,P0,P1,t,GK,GV,GL) do{ SBAR(); \
    const lds_cptr vp_=vp0+sl_prev; \
    VRD(0); SBAR(); float sacc=(P0[0]+P0[1]); \
    GAPA(C0=__builtin_amdgcn_mfma_f32_32x32x16_bf16(kf[0],qr[0],negm,0,0,0), P0[2],P0[3],P0[4],P0[5],     pw0[0]=PKW(P0,0), pw0[1]=PKW(P0,2), pw0); \
    VRD(4); SBAR(); GAPA(C1=__builtin_amdgcn_mfma_f32_32x32x16_bf16(kf[1],qr[0],negm,0,0,0), P0[6],P0[7],P0[8],P0[9],     pw0[2]=PKW(P0,4), pw0[3]=PKW(P0,6), pw0); \
    VRD(1); SBAR(); GAPA(C0=__builtin_amdgcn_mfma_f32_32x32x16_bf16(kf[2],qr[1],C0,0,0,0),   P0[10],P0[11],P0[12],P0[13], pw1[0]=PKW(P0,8), pw1[1]=PKW(P0,10), pw1); \
    VRD(5); SBAR(); GAPA(C1=__builtin_amdgcn_mfma_f32_32x32x16_bf16(kf[3],qr[1],C1,0,0,0),   P0[14],P0[15],P1[0],P1[1],   pw1[2]=PKW(P0,12),pw1[3]=PKW(P0,14), pw1); \
    VRD(2); SBAR(); GAPA(C0=__builtin_amdgcn_mfma_f32_32x32x16_bf16(kf[4],qr[2],C0,0,0,0),   P1[2],P1[3],P1[4],P1[5],     pw2[0]=PKW(P1,0), pw2[1]=PKW(P1,2), pw2); \
    VRD(6); SBAR(); GAPA(C1=__builtin_amdgcn_mfma_f32_32x32x16_bf16(kf[5],qr[2],C1,0,0,0),   P1[6],P1[7],P1[8],P1[9],     pw2[2]=PKW(P1,4), pw2[3]=PKW(P1,6), pw2); \
    VRD(3); SBAR(); GAPA(C0=__builtin_amdgcn_mfma_f32_32x32x16_bf16(kf[6],qr[3],C0,0,0,0),   P1[10],P1[11],P1[12],P1[13], pw3[0]=PKW(P1,8), pw3[1]=PKW(P1,10), pw3); \
    VRD(7); SBAR(); GAPA(C1=__builtin_amdgcn_mfma_f32_32x32x16_bf16(kf[7],qr[3],C1,0,0,0),   P1[14],P1[15],0.f,0.f,       pw3[2]=PKW(P1,12),pw3[3]=PKW(P1,14), pw3); \
    l_reg+=sacc; \
    if(GK){DMA_K((t)+3,sl_cur);} if(GV){DMA_V((t)+1,sl_next);} \
    CMASK(C0,C1,t); \
    { float a=MX3(C0[0],C0[1],C1[0]),b=MX3(C0[2],C0[3],C1[1]); a=MX3(a,C1[2],C1[3]); \
      _Pragma("unroll") for(int r=4;r<16;r+=4){a=MX3(a,C0[r],C0[r+1]);b=MX3(b,C0[r+2],C0[r+3]);a=MX3(a,C1[r],C1[r+1]);b=MX3(b,C1[r+2],C1[r+3]);} \
      float rm=__builtin_fmaxf(a,b); { auto rr=__builtin_amdgcn_permlane32_swap(__float_as_uint(rm),__float_as_uint(rm),false,false); rm=__builtin_fmaxf(__uint_as_float(rr[0]),__uint_as_float(rr[1])); } \
      resc=false; \
      if(__builtin_expect(__any(rm>(float)THRL),0)){ const float dl=__builtin_fmaxf(rm,0.f); mhat+=dl; \
        _Pragma("unroll") for(int r=0;r<16;++r){C0[r]-=dl;C1[r]-=dl;} \
        _Pragma("unroll") for(int r=0;r<16;++r)negm[r]=-mhat; asm volatile("":"+v"(negm)); \
        const float f=__builtin_amdgcn_exp2f(-dl); l_reg*=f; if(hi==0)wsf[r32]=f; resc=true; } } \
    SBAR(); \
    GAPB(o[0]=__builtin_amdgcn_mfma_f32_32x32x16_bf16(PAF(0),VFR(0),o[0],0,0,0), C0,0); \
    GAPB(o[1]=__builtin_amdgcn_mfma_f32_32x32x16_bf16(PAF(0),VFR(4),o[1],0,0,0), C0,4); \
    KRD(GL,0); GAPB(o[0]=__builtin_amdgcn_mfma_f32_32x32x16_bf16(PAF(1),VFR(1),o[0],0,0,0), C0,8); \
    KRD(GL,1); GAPB(o[1]=__builtin_amdgcn_mfma_f32_32x32x16_bf16(PAF(1),VFR(5),o[1],0,0,0), C0,12); \
    KRD(GL,2); GAPB(o[0]=__builtin_amdgcn_mfma_f32_32x32x16_bf16(PAF(2),VFR(2),o[0],0,0,0), C1,0); \
    KRD(GL,3); GAPB(o[1]=__builtin_amdgcn_mfma_f32_32x32x16_bf16(PAF(2),VFR(6),o[1],0,0,0), C1,4); \
    GAPB(o[0]=__builtin_amdgcn_mfma_f32_32x32x16_bf16(PAF(3),VFR(3),o[0],0,0,0), C1,8); \
    GAPB(o[1]=__builtin_amdgcn_mfma_f32_32x32x16_bf16(PAF(3),VFR(7),o[1],0,0,0), C1,12); \
    }while(0)
  int t=1;
  #undef CMASK
  #define CMASK(P0,P1,t) do{}while(0)
  for(;t+5<NT;t+=2){
    STEP(pB0,pB1,pA0,pA1,t,true,true,true);     WAIT_BAR(2); RESC(); ROT();
    STEP(pA0,pA1,pB0,pB1,t+1,true,true,true);   WAIT_BAR(2); RESC(); ROT();
  }
  #undef CMASK
  #define CMASK(P0,P1,t) do{int jb_=(t)-(NT-4); if(jb_>=0)cmask(P0,P1,jb_,qrel,hi);}while(0)
  #define ENDW(tt) do{ if((tt)+3<NT){WAIT_BAR(2);} else if((tt)+2<NT){WAIT_BAR(1);} else {WAIT_BAR(0);} }while(0)
  for(;t+1<NT;t+=2){
    STEP(pB0,pB1,pA0,pA1,t,(t+3<NT),(t+1<NT),(t+1<NT));       ENDW(t);   RESC(); ROT();
    STEP(pA0,pA1,pB0,pB1,t+1,(t+4<NT),(t+2<NT),(t+2<NT));     ENDW(t+1); RESC(); ROT();
  }
  STEP(pB0,pB1,pA0,pA1,NT-1,false,false,false); RESC();
  { float sacc=pB0[0]+pB0[1]; _Pragma("unroll") for(int r=2;r<16;++r)sacc+=pB0[r]; _Pragma("unroll") for(int r=0;r<16;++r)sacc+=pB1[r]; l_reg+=sacc;
    pw0=(u32x4){PKW(pB0,0),PKW(pB0,2),PKW(pB0,4),PKW(pB0,6)};pw1=(u32x4){PKW(pB0,8),PKW(pB0,10),PKW(pB0,12),PKW(pB0,14)};pw2=(u32x4){PKW(pB1,0),PKW(pB1,2),PKW(pB1,4),PKW(pB1,6)};pw3=(u32x4){PKW(pB1,8),PKW(pB1,10),PKW(pB1,12),PKW(pB1,14)};
    SBAR(); pv(o,vb0+sl_cur,PAF(0),PAF(1),PAF(2),PAF(3)); }
  #undef PKW
  #undef PAF
  #undef VFR
  #undef PIN
  #undef MX3
  #undef GAPA
  #undef GAPB
  #undef EX
  #undef VRD
  #undef KRD
  #undef STEP
  #undef ENDW
  {auto rr=__builtin_amdgcn_permlane32_swap(__float_as_uint(l_reg),__float_as_uint(l_reg),false,false);l_reg=__uint_as_float(rr[0])+__uint_as_float(rr[1]);}
  if(hi==0)wsf[32+r32]=l_reg;asm volatile("s_waitcnt lgkmcnt(0)":::"memory");
  float rli[16];
  #pragma unroll
  for(int r=0;r<16;++r)rli[r]=__builtin_amdgcn_rcpf(wsf[32+crow(r,hi)]);
  bf16*Ow=O+(rowbase+q0+wid*QBLK)*DO+oc;
  { bf16*stg=(bf16*)(shm+LDS_OST)+wid*2048;
    #pragma unroll
    for(int r=0;r<16;++r){const int orow=crow(r,hi);
      #pragma unroll
      for(int d0=0;d0<2;++d0)stg[orow*64+d0*32+r32]=__float2bfloat16(o[d0][r]*rli[r]);}
    asm volatile("s_waitcnt lgkmcnt(0)":::"memory");
    #pragma unroll
    for(int i=0;i<4;++i){const int row=i*8+(lane>>3),ch=lane&7; const u32x4 v=*(const u32x4*)(stg+row*64+ch*8); ATTN_STORE16(Ow+(long)row*DO+ch*8,v);} }
  asm volatile("s_waitcnt lgkmcnt(0)\n\ts_barrier":::"memory");
  #undef DMA_K
  #undef DMA_V
  #undef CMASK
  #undef START
  #undef RESC
  #undef ROT
}
constexpr int ATTN_LDS_BYTES=LDS_BYTES;
struct AttnTensors { const bf16* Q; const bf16* K; const bf16* V; bf16* O0; bf16* O1; };
struct AttnUnit { int bh; int qb; };
struct StaticOrder {
  int vcu;
  __device__ __forceinline__ explicit StaticOrder(int grid_,int block):vcu((grid_%8==0)?(block%8)*(grid_/8)+block/8:block),grid(grid_){}
  int grid;
  __device__ __forceinline__ bool next(int i,AttnUnit&u)const{ const int v=vcu+(i>>2)*grid; if(v>=256)return false; const int s=v&7,j=i&3; u.bh=v>>3; u.qb=(j==0)?s:(j==1)?15-s:(j==2)?16+s:31-s; return true; }
  __device__ __forceinline__ void a_ready(const AttnUnit&)const{}
  __device__ __forceinline__ void done(const AttnUnit&)const{}
};
template<class Sched,int THRL=8> __device__ __forceinline__ void attn_phase(char*lds,const AttnTensors&T,const Sched&S,const int tid){
  AttnUnit u;
  for(int i=0;S.next(i,u);++i){ S.a_ready(u); const int h=u.bh>>2,m=(u.bh>>1)&1,vh=u.bh&1; attn_unit<THRL>((2*h+m)*64,1024+(2*h+m)*64,2048+h*128+vh*64,h*128+vh*64,u.qb,T.Q,T.K,T.V,m?T.O1:T.O0,lds,tid); S.done(u); }
}
#undef SBAR
#undef WAIT_BAR
}
#define GAS __attribute__((address_space(1)))
#define LAS __attribute__((address_space(3)))
typedef unsigned short bf16;
typedef unsigned v4u __attribute__((ext_vector_type(4)));
typedef float f32x4 __attribute__((ext_vector_type(4)));
typedef short bf16x8 __attribute__((ext_vector_type(8)));
typedef GAS unsigned gu32;
typedef GAS unsigned long long gu64;
#define RLX_AGENT __ATOMIC_RELAXED, __HIP_MEMORY_SCOPE_AGENT
#define LDS_WAIT() asm volatile("s_waitcnt lgkmcnt(0)" ::: "memory")
#define VM_WAIT() asm volatile("s_waitcnt vmcnt(0)" ::: "memory")
__device__ __forceinline__ unsigned long long rt() { return __builtin_amdgcn_s_memrealtime(); }
__device__ __forceinline__ unsigned f2bf(float f) { unsigned u = __builtin_bit_cast(unsigned, f); return (u + 0x7fffu + ((u >> 16) & 1u)) >> 16; }
__device__ __forceinline__ unsigned pk2(float lo, float hi) { return f2bf(lo) | (f2bf(hi) << 16); }

#define XB_TMO      128
#define XB_XCNT(j)  (256  + 64 * (j))
#define XB_XSUB(j)  (1280 + 64 * (j))
#define XB_XGEN(j)  (2304 + 64 * (j))
#define XB_TOP      3328
#define XB_TOPGEN   3392
#define XCD_BAR_WORDS 3456
#define XB_SPIN_CAP (1u << 18)

__device__ __forceinline__ unsigned xb_ld(unsigned* p)              { return __hip_atomic_load(p, __ATOMIC_RELAXED, __HIP_MEMORY_SCOPE_AGENT); }
__device__ __forceinline__ unsigned xb_add(unsigned* p, unsigned v) { return __hip_atomic_fetch_add(p, v, __ATOMIC_RELAXED, __HIP_MEMORY_SCOPE_AGENT); }
__device__ __forceinline__ unsigned xb_xcc_id() { return (unsigned)__builtin_amdgcn_s_getreg((3 << 11) | 20) & 0xFu; }
#define XB_SPIN(cond, bar) do { unsigned _sp = 0; while (cond) { __builtin_amdgcn_s_sleep(1); \
    if ((++_sp & 255u) == 0u) { if (xb_ld(&(bar)[XB_TMO])) break; if (_sp > XB_SPIN_CAP) { atomicAdd(&(bar)[XB_TMO], 1u); break; } } } } while (0)

struct XcdBarrier {
    unsigned* bar; unsigned x;
    volatile LAS unsigned* st;
};

__device__ __forceinline__ XcdBarrier xcd_barrier_post(unsigned* bar, volatile LAS unsigned* st) {
    XcdBarrier b; b.bar = bar; b.x = xb_xcc_id(); b.st = st;
    if (threadIdx.x == 0) (void)xb_add(&bar[XB_XCNT(b.x)], 1u);
    return b;
}
__device__ __forceinline__ void xcd_barrier_complete(unsigned* bar, unsigned x, unsigned& nloc, unsigned& nx) {
    const unsigned G = gridDim.x * gridDim.y * gridDim.z;
    unsigned sum, cnt, mine, sp = 0u;
    for (;;) {
        sum = 0u; cnt = 0u; mine = 0u;
#pragma unroll
        for (unsigned j = 0; j < 16; ++j) { const unsigned c = xb_ld(&bar[XB_XCNT(j)]); sum += c; cnt += (c > 0u) ? 1u : 0u; mine = (j == x) ? c : mine; }
        if (sum == G) break;
        __builtin_amdgcn_s_sleep(1);
        if ((++sp & 255u) == 0u) { if (xb_ld(&bar[XB_TMO])) break; if (sp > XB_SPIN_CAP) { atomicAdd(&bar[XB_TMO], 1u); break; } }
    }
    nloc = mine > 0u ? mine : 1u; nx = cnt > 0u ? cnt : 1u;
}

__device__ __forceinline__ void xcd_barrier(const XcdBarrier& b, const bool leader_thread) {
    asm volatile("s_waitcnt vmcnt(0)" ::: "memory");
    __syncthreads();
    if (leader_thread) {
        unsigned* bar = b.bar;
        __builtin_amdgcn_s_waitcnt(0);
        unsigned nloc = b.st[0], nx = b.st[1];
        if (nloc == 0u) { xcd_barrier_complete(bar, b.x, nloc, nx); b.st[0] = nloc; b.st[1] = nx; }
        const unsigned old = xb_add(&bar[XB_XSUB(b.x)], 1u);
        const unsigned gen = old / nloc;
        if (old + 1u == (gen + 1u) * nloc) {
            __builtin_amdgcn_fence(__ATOMIC_RELEASE, "agent");
            asm volatile("s_waitcnt vmcnt(0)" ::: "memory");
            const unsigned og = xb_add(&bar[XB_TOP], 1u);
            const unsigned tg = og / nx;
            if (og + 1u == (tg + 1u) * nx) xb_add(&bar[XB_TOPGEN], 1u);
            else XB_SPIN(xb_ld(&bar[XB_TOPGEN]) == tg, bar);
            __builtin_amdgcn_fence(__ATOMIC_ACQUIRE, "agent");
            xb_add(&bar[XB_XGEN(b.x)], 1u);
            asm volatile("s_waitcnt vmcnt(0)" ::: "memory");
        } else {
            XB_SPIN(xb_ld(&bar[XB_XGEN(b.x)]) == gen, bar);
            __builtin_amdgcn_fence(__ATOMIC_ACQUIRE, "agent");
            asm volatile("s_waitcnt vmcnt(0)" ::: "memory");
        }
    }
    __syncthreads();
}

constexpr int SEQ = 8192, DM = 4096, DIN = 13392, LDP = 14592, DFF = 16384, BW = 2048;
constexpr int C_QA = 0, C_KA = 1024, C_VA = 2048, C_RB = 3072, C_KB = 5120, C_VB = 7168, C_QC = 9216, C_KC = 10240, C_VC = 11264, C_QI = 12288, C_KI = 13312, C_WI = 13376;
constexpr int C_LWH = 13392, C_LWS = 13488, C_LAH = 13584, C_LAS = 13680, C_LGH = 13776, C_LGS = 14032, C_LVH = 14288, C_LVS = 14352;
constexpr float RMS_EPS = 1e-6f, GN_EPS = 64e-5f;
constexpr float QA_SCALE = 0.125f * 1.4426950408889634f;
constexpr float QC_SCALE = 0.08838834764831845f * 1.4426950408889634f;

enum { I_X = 0, I_NMG, I_WIN, I_LQ1, I_LK1, I_LQ2, I_LK2, I_SUBLN, I_MURKV, I_MUWAG, I_W0, I_W1, I_W2, I_A0, I_A1, I_A2, I_G1, I_G2, I_KK, I_KA, I_RK, I_LNW, I_LNB,
       I_VMU, I_V0, I_V1, I_V2, I_WOUT, I_NFG, I_WUP, I_WDN, I_NFIN, N_INPUTS };

constexpr size_t MiB = 1u << 20;
constexpr size_t WS_CTL = 0, CTL_ZERO_BYTES = 1 * MiB;
constexpr size_t SZ_WIN = (size_t)LDP * DM * 2, SZ_WOUT = (size_t)DM * DM * 2, SZ_WFF = (size_t)DFF * DM * 2, SZ_BT2 = (size_t)8192 * 256 * 2;
constexpr size_t WS_WIN = 2 * MiB;
constexpr size_t WS_WOUT = WS_WIN + SZ_WIN;
constexpr size_t WS_WUP = WS_WOUT + SZ_WOUT;
constexpr size_t WS_WDN = WS_WUP + SZ_WFF;
constexpr size_t WS_BT2 = WS_WDN + SZ_WFF;
constexpr size_t SZ_SB = (size_t)SEQ * BW * 4;
constexpr size_t WS_VF = WS_BT2 + SZ_BT2;
constexpr size_t WS_H = WS_VF + SZ_SB;
constexpr size_t WS_MIX = WS_H + (size_t)SEQ * DM * 2;
constexpr size_t WS_P = WS_MIX + (size_t)SEQ * DM * 2;
constexpr size_t WS_AP = WS_P + (size_t)SEQ * LDP * 2;
constexpr size_t WS_Z = WS_AP + (size_t)SEQ * 1024 * 2;
constexpr size_t WS_U = WS_Z;
constexpr size_t WS_SR = WS_Z + (size_t)SEQ * 8192 * 4, WS_SW = WS_SR + SZ_SB, WS_SK = WS_SW + SZ_SB, WS_SV = WS_SK + SZ_SB, WS_SA = WS_SV + SZ_SB, WS_SBB = WS_SA + SZ_SB;
constexpr size_t WS_Y = WS_SBB + SZ_SB;
constexpr size_t WS_O0 = WS_Y + SZ_SB, WS_O1 = WS_O0 + (size_t)SEQ * 1024 * 2;
constexpr size_t WS_SC = WS_O1 + (size_t)SEQ * 1024 * 2;
constexpr size_t WS_IDX = WS_SC + (size_t)SEQ * SEQ * 4;
constexpr size_t WS_END = WS_IDX + (size_t)SEQ * 256 * 4;
static_assert(WS_END <= 2040 * MiB && (size_t)SEQ * DFF * 2 <= (size_t)SEQ * 8192 * 4, "d_ws map must fit the 2 GiB workspace");
constexpr int CW_TMO = 0, CW_CODE = 1, CW_LAM = 16;
constexpr int CW_BAR = 4096;

constexpr int RING_OFF = 0, RING_BYTES = 131072;
constexpr int LDSCTL_OFF = RING_BYTES, MISC_OFF = LDSCTL_OFF + 320;
constexpr int LDS_BYTES = 147456;
constexpr int NWAVES = 8;

__device__ __forceinline__ float bf2f(unsigned short b) { return __uint_as_float(((unsigned)b) << 16); }
__device__ __forceinline__ float bflo(unsigned w) { return __uint_as_float(w << 16); }
__device__ __forceinline__ float bfhi(unsigned w) { return __uint_as_float(w & 0xffff0000u); }
#define DPPF(v, ctrl) __builtin_bit_cast(float, __builtin_amdgcn_update_dpp(0, __builtin_bit_cast(int, (v)), (ctrl), 0xF, 0xF, false))
#define DPPF_ROWS(old, v, ctrl, rows) __builtin_bit_cast(float, __builtin_amdgcn_update_dpp(__builtin_bit_cast(int, (old)), __builtin_bit_cast(int, (v)), (ctrl), (rows), 0xF, false))
__device__ __forceinline__ float dpp_sum16(float v) {
    v += DPPF(v, 0xB1);
    v += DPPF(v, 0x4E);
    v += DPPF(v, 0x141);
    v += DPPF(v, 0x140);
    return v;
}
__device__ __forceinline__ float dpp_max16(float v) {
    v = fmaxf(v, DPPF(v, 0xB1)); v = fmaxf(v, DPPF(v, 0x4E)); v = fmaxf(v, DPPF(v, 0x141)); v = fmaxf(v, DPPF(v, 0x140));
    return v;
}
__device__ __forceinline__ float wave_sum(float v) {
    v = dpp_sum16(v);
    v += DPPF_ROWS(0.f, v, 0x142, 0xA);
    v += DPPF_ROWS(0.f, v, 0x143, 0xC);
    return __builtin_bit_cast(float, __builtin_amdgcn_readlane(__builtin_bit_cast(int, v), 63));
}
__device__ __forceinline__ float wave_max(float v) {
    v = dpp_max16(v);
    v = fmaxf(v, DPPF_ROWS(v, v, 0x142, 0xA));
    v = fmaxf(v, DPPF_ROWS(v, v, 0x143, 0xC));
    return __builtin_bit_cast(float, __builtin_amdgcn_readlane(__builtin_bit_cast(int, v), 63));
}
__device__ __forceinline__ float swap32_sum(float v) {
    auto rr = __builtin_amdgcn_permlane32_swap(__float_as_uint(v), __float_as_uint(v), false, false);
    return __uint_as_float(rr[0]) + __uint_as_float(rr[1]);
}
__device__ __forceinline__ unsigned bperm_u32(unsigned v, int src_lane) { return (unsigned)__builtin_amdgcn_ds_bpermute(src_lane << 2, (int)v); }
__device__ __forceinline__ float sigmoidf_(float x) { return 1.0f / (1.0f + __expf(-x)); }

__device__ __forceinline__ void transpose_item(const float* W, int N, bf16* WT, int ldk, int row_off, const float* ks, int mode, LAS float* scr, int item, int lane) {
    const int nblk = (N + 31) >> 5, kb = item / nblk, nb = item - kb * nblk, k0 = 64 * kb, n0 = 32 * nb;
    const int n_r = n0 + (lane & 31);
#pragma unroll 8
    for (int i = 0; i < 32; ++i) { const int kk = 2 * i + (lane >> 5); float v = 0.f;
        if (n_r < N) v = W[(size_t)(k0 + kk) * N + n_r];
        if (mode) { const float s = ks[k0 + kk]; v *= (mode == 1) ? (1.f - s) : s; }
        scr[kk * 33 + (lane & 31)] = v; }
    LDS_WAIT(); asm volatile("" ::: "memory");
    const int c = lane & 7;
#pragma unroll
    for (int j = 0; j < 4; ++j) { const int n = (lane >> 3) + 8 * j; const LAS float* s = scr + (8 * c) * 33 + n;
        v4u o; o.x = pk2(s[0 * 33], s[1 * 33]); o.y = pk2(s[2 * 33], s[3 * 33]); o.z = pk2(s[4 * 33], s[5 * 33]); o.w = pk2(s[6 * 33], s[7 * 33]);
        if (n0 + n < N) *(GAS v4u*)(WT + (size_t)(row_off + n0 + n) * ldk + k0 + 8 * c) = o; }
    LDS_WAIT(); asm volatile("" ::: "memory");
}

template <int OFF> __device__ __forceinline__ unsigned long long karg64() {
    auto kp = __builtin_amdgcn_kernarg_segment_ptr(); unsigned long long v;
    asm volatile("s_load_dwordx2 %0, %1, %2\n\ts_waitcnt lgkmcnt(0)" : "=s"(v) : "s"(kp), "n"(OFF) : "memory");
    return v;
}
template <int IDX_> __device__ __forceinline__ const float* inp() { return (const float*)(const GAS float*)karg64<IDX_ * 8>(); }
#define ARG_OUT ((float*)(GAS float*)karg64<N_INPUTS * 8>())
#define ARG_WS ((unsigned char*)(GAS unsigned char*)karg64<N_INPUTS * 8 + 8>())
struct Ctx { int tid, lane, wave, G, bx, vcu, gw, NGW, l; unsigned char* ws; };
__device__ __forceinline__ Ctx ctx_make(int wave, int layer = 0) {
    Ctx c; int ln; asm volatile("v_mbcnt_lo_u32_b32 %0, -1, 0\n\tv_mbcnt_hi_u32_b32 %0, -1, %0" : "=v"(ln)); int g = gridDim.x, b = blockIdx.x; asm volatile("" : "+s"(g), "+s"(b), "+s"(wave));
    c.tid = wave * 64 + ln; c.lane = ln; c.wave = wave; c.G = g; c.bx = b;
    c.vcu = (g % 8 == 0) ? (b % 8) * (g / 8) + b / 8 : b; c.gw = c.vcu * NWAVES + c.wave; c.NGW = g * NWAVES; c.ws = ARG_WS; asm volatile("" : "+s"(layer)); c.l = layer; return c;
}

__device__ __forceinline__ void layer_prologue(unsigned char* ws, gu32* ctl, LAS unsigned char* lds, const int l, int gw, int NGW, int wave, int lane) {
    LAS float* scr = (LAS float*)(lds + RING_OFF + wave * 16384);
    constexpr int IT_IN = (DM / 64) * ((DIN + 31) / 32), IT_L96 = (DM / 64) * 3, IT_L256 = (DM / 64) * 8, IT_L64 = (DM / 64) * 2;
    constexpr int IT_OUT = (DM / 64) * (DM / 32), IT_UP = (DM / 64) * (DFF / 32), IT_DN = (DFF / 64) * (DM / 32);
    constexpr int IT_LAYER = IT_IN + 4 * IT_L96 + 2 * IT_L256 + 2 * IT_L64 + IT_OUT + IT_UP + IT_DN;
    for (int it = gw; it < IT_LAYER; it += NGW) {
        int r = it;
        bf16* Wi = (bf16*)(ws + WS_WIN);
        const float* mu = inp<I_MUWAG>() + (size_t)l * 3 * DM;
        if (r < IT_IN) { transpose_item(inp<I_WIN>() + (size_t)l * DM * DIN, DIN, Wi, DM, 0, nullptr, 0, scr, r, lane); continue; } r -= IT_IN;
        if (r < IT_L96) { transpose_item(inp<I_W1>() + (size_t)l * DM * 96, 96, Wi, DM, C_LWH, mu, 1, scr, r, lane); continue; } r -= IT_L96;
        if (r < IT_L96) { transpose_item(inp<I_W1>() + (size_t)l * DM * 96, 96, Wi, DM, C_LWS, mu, 2, scr, r, lane); continue; } r -= IT_L96;
        if (r < IT_L96) { transpose_item(inp<I_A1>() + (size_t)l * DM * 96, 96, Wi, DM, C_LAH, mu + DM, 1, scr, r, lane); continue; } r -= IT_L96;
        if (r < IT_L96) { transpose_item(inp<I_A1>() + (size_t)l * DM * 96, 96, Wi, DM, C_LAS, mu + DM, 2, scr, r, lane); continue; } r -= IT_L96;
        if (r < IT_L256) { transpose_item(inp<I_G1>() + (size_t)l * DM * 256, 256, Wi, DM, C_LGH, mu + 2 * DM, 1, scr, r, lane); continue; } r -= IT_L256;
        if (r < IT_L256) { transpose_item(inp<I_G1>() + (size_t)l * DM * 256, 256, Wi, DM, C_LGS, mu + 2 * DM, 2, scr, r, lane); continue; } r -= IT_L256;
        if (r < IT_L64) { if (l == 1) transpose_item(inp<I_V1>(), 64, Wi, DM, C_LVH, inp<I_VMU>(), 1, scr, r, lane); continue; } r -= IT_L64;
        if (r < IT_L64) { if (l == 1) transpose_item(inp<I_V1>(), 64, Wi, DM, C_LVS, inp<I_VMU>(), 2, scr, r, lane); continue; } r -= IT_L64;
        if (r < IT_OUT) { transpose_item(inp<I_WOUT>() + (size_t)l * DM * DM, DM, (bf16*)(ws + WS_WOUT), DM, 0, nullptr, 0, scr, r, lane); continue; } r -= IT_OUT;
        if (r < IT_UP) { transpose_item(inp<I_WUP>() + (size_t)l * DM * DFF, DFF, (bf16*)(ws + WS_WUP), DM, 0, nullptr, 0, scr, r, lane); continue; } r -= IT_UP;
        transpose_item(inp<I_WDN>() + (size_t)l * DFF * DM, DM, (bf16*)(ws + WS_WDN), DFF, 0, nullptr, 0, scr, r, lane);
    }
    for (int i = gw * 64 + lane; i < 8192 * 32; i += NGW * 64) {
        const int n = i >> 5, k8 = i & 31, grp = n >> 11, c = n & 2047;
        const float* src; int rank;
        if (grp == 0) { src = inp<I_W2>() + (size_t)l * 96 * BW; rank = 96; }
        else if (grp == 1) { src = inp<I_A2>() + (size_t)l * 96 * BW; rank = 96; }
        else if (grp == 2) { src = inp<I_G2>() + (size_t)l * 256 * BW; rank = 256; }
        else { src = inp<I_V2>(); rank = (l == 1) ? 64 : 0; }
        float v[8];
#pragma unroll
        for (int e = 0; e < 8; ++e) { const int k = 8 * k8 + e; v[e] = (k < rank) ? src[(size_t)k * BW + c] : 0.f; }
        v4u o; o.x = pk2(v[0], v[1]); o.y = pk2(v[2], v[3]); o.z = pk2(v[4], v[5]); o.w = pk2(v[6], v[7]);
        *(GAS v4u*)((bf16*)(ws + WS_BT2) + (size_t)n * 256 + 8 * k8) = o;
    }
    if (gw == 0) {
        const float a = wave_sum(inp<I_LQ1>()[l * 64 + lane] * inp<I_LK1>()[l * 64 + lane]), b = wave_sum(inp<I_LQ2>()[l * 64 + lane] * inp<I_LK2>()[l * 64 + lane]);
        const float lam_init = 0.8f - 0.6f * expf(-0.3f * (float)l);
        if (lane == 0) __hip_atomic_store(ctl + CW_LAM + l, __float_as_uint(expf(a) - expf(b) + lam_init), RLX_AGENT); }
}

__device__ __forceinline__ void rmsnorm_rows_bf16(const float* src, const float* g, bf16* dst, int gw, int NGW, int lane) {
    for (int m = gw; m < SEQ; m += NGW) {
        const GAS f32x4* xr = (const GAS f32x4*)(src + (size_t)m * DM) + lane; const GAS f32x4* gr = (const GAS f32x4*)g + lane;
        f32x4 v[16]; float s = 0.f;
#pragma unroll
        for (int j = 0; j < 16; ++j) { v[j] = xr[64 * j]; s += (v[j].x * v[j].x + v[j].y * v[j].y) + (v[j].z * v[j].z + v[j].w * v[j].w); }
        const float rstd = 1.0f / sqrtf(wave_sum(s) * (1.f / DM) + RMS_EPS);
        GAS unsigned long long* o8 = (GAS unsigned long long*)(dst + (size_t)m * DM) + lane;
#pragma unroll
        for (int j = 0; j < 16; ++j) { const f32x4 gv = gr[64 * j];
            o8[64 * j] = (unsigned long long)pk2(v[j].x * rstd * gv.x, v[j].y * rstd * gv.y) | ((unsigned long long)pk2(v[j].z * rstd * gv.z, v[j].w * rstd * gv.w) << 32); }
    }
}
__device__ __forceinline__ void rmsnorm_rows_f32_inplace(float* x, const float* g, int gw, int NGW, int lane) {
    for (int m = gw; m < SEQ; m += NGW) {
        GAS f32x4* xr = (GAS f32x4*)(x + (size_t)m * DM) + lane; const GAS f32x4* gr = (const GAS f32x4*)g + lane;
        f32x4 v[16]; float s = 0.f;
#pragma unroll
        for (int j = 0; j < 16; ++j) { v[j] = xr[64 * j]; s += (v[j].x * v[j].x + v[j].y * v[j].y) + (v[j].z * v[j].z + v[j].w * v[j].w); }
        const float rstd = 1.0f / sqrtf(wave_sum(s) * (1.f / DM) + RMS_EPS);
#pragma unroll
        for (int j = 0; j < 16; ++j) { const f32x4 gv = gr[64 * j]; xr[64 * j] = v[j] * rstd * gv; }
    }
}

__device__ __forceinline__ void lora_prep(const bf16* P, bf16* AP, int layer, int gw, int NGW, int lane) {
    for (int t = gw; t < SEQ; t += NGW) {
        const bf16* cur = P + (size_t)t * LDP; const bf16* prv = cur - LDP;
#pragma unroll
        for (int k = 0; k < 16; ++k) { const int grp = k >> 2, i = lane + 64 * (k & 3);
            const int rank = (grp == 2) ? 256 : (grp == 3 ? ((layer == 1) ? 64 : 0) : 96);
            const int ch = (grp == 0) ? C_LWH : (grp == 1) ? C_LAH : (grp == 2) ? C_LGH : C_LVH, cs = (grp == 0) ? C_LWS : (grp == 1) ? C_LAS : (grp == 2) ? C_LGS : C_LVS;
            float v = 0.f;
            if (i < rank) { v = bf2f(cur[ch + i]); if (t > 0) v += bf2f(prv[cs + i]);
                if (grp == 0) v = tanhf(v); else if (grp == 2) v = sigmoidf_(v); }
            AP[(size_t)t * 1024 + grp * 256 + i] = (bf16)f2bf(v); }
    }
}

__device__ __forceinline__ void rwkv_prep(unsigned char* ws, int layer, int gw, int NGW, int lane) {
    const bf16* P = (const bf16*)(ws + WS_P); const float* Z = (const float*)(ws + WS_Z);
    float* SR = (float*)(ws + WS_SR); float* SW = (float*)(ws + WS_SW); float* SK = (float*)(ws + WS_SK); float* SV = (float*)(ws + WS_SV); float* SA = (float*)(ws + WS_SA); float* SB = (float*)(ws + WS_SBB);
    float* VF = (float*)(ws + WS_VF);
    const float* mu = inp<I_MURKV>() + (size_t)layer * 3 * BW;
    for (int task = gw; task < SEQ * 32; task += NGW) {
        const int t = task >> 5, head = task & 31, c = head * 64 + lane;
        const bf16* cur = P + (size_t)t * LDP; const bf16* prv = cur - LDP;
        float r = bf2f(cur[C_RB + c]), k = bf2f(cur[C_KB + c]), v = bf2f(cur[C_VB + c]);
        float rp = 0.f, kp = 0.f, vp = 0.f; if (t > 0) { rp = bf2f(prv[C_RB + c]); kp = bf2f(prv[C_KB + c]); vp = bf2f(prv[C_VB + c]); }
        r += (rp - r) * mu[c]; k += (kp - k) * mu[BW + c]; v += (vp - v) * mu[2 * BW + c];
        const float* z = Z + (size_t)t * 8192;
        const float decay = __expf(-0.6065306597126334f * sigmoidf_(inp<I_W0>()[layer * BW + c] + z[c]));
        const float a = sigmoidf_(inp<I_A0>()[layer * BW + c] + z[BW + c]);
        if (layer == 0) VF[(size_t)t * BW + c] = v;
        else { const float vf = VF[(size_t)t * BW + c]; v += (vf - v) * sigmoidf_(inp<I_V0>()[c] + z[3 * BW + c]); }
        float kk = k * inp<I_KK>()[layer * BW + c];
        const float nrm = sqrtf(wave_sum(kk * kk));
        kk = kk / fmaxf(nrm, 1e-12f);
        const float kn = k * (1.0f + (a - 1.0f) * inp<I_KA>()[layer * BW + c]);
        const size_t o = (size_t)t * BW + c;
        SR[o] = r; SW[o] = decay; SK[o] = kn; SV[o] = v; SA[o] = -kk; SB[o] = kk * a;
    }
}

struct ScanIn { f32x4 r, w, k, a, b; float v; };
__device__ __forceinline__ void scan_unit(unsigned char* ws, int unit, int wave, int lane) {
    const int head = unit >> 1, half = unit & 1, row = half * 32 + wave * 4 + (lane >> 4), kq = lane & 15;
    const size_t cb = (size_t)head * 64 + 4 * kq;
    const float* pr = (const float*)(ws + WS_SR) + cb; const float* pw = (const float*)(ws + WS_SW) + cb; const float* pk = (const float*)(ws + WS_SK) + cb;
    const float* pa = (const float*)(ws + WS_SA) + cb; const float* pb = (const float*)(ws + WS_SBB) + cb; const float* pv = (const float*)(ws + WS_SV) + head * 64 + row;
    float* py = (float*)(ws + WS_Y) + head * 64 + row;
    f32x4 S = (f32x4){0.f, 0.f, 0.f, 0.f};
    ScanIn A[4], B[4];
#define SCAN_LOAD(X, t0) do { _Pragma("unroll") for (int i_ = 0; i_ < 4; ++i_) { const size_t o_ = (size_t)((t0) + i_) * BW; \
        X[i_].r = *(const GAS f32x4*)(pr + o_); X[i_].w = *(const GAS f32x4*)(pw + o_); X[i_].k = *(const GAS f32x4*)(pk + o_); X[i_].a = *(const GAS f32x4*)(pa + o_); X[i_].b = *(const GAS f32x4*)(pb + o_); X[i_].v = pv[o_]; } } while (0)
#define SCAN_STEPS(X, t0) do { _Pragma("unroll") for (int i_ = 0; i_ < 4; ++i_) { \
        float sa = (S.x * X[i_].a.x + S.y * X[i_].a.y) + (S.z * X[i_].a.z + S.w * X[i_].a.w); sa = dpp_sum16(sa); \
        S = S * X[i_].w + (X[i_].b * sa + X[i_].k * X[i_].v); \
        float y = (S.x * X[i_].r.x + S.y * X[i_].r.y) + (S.z * X[i_].r.z + S.w * X[i_].r.w); y = dpp_sum16(y); \
        if (kq == 0) py[(size_t)((t0) + i_) * BW] = y; } } while (0)
    SCAN_LOAD(A, 0);
    for (int t0 = 0; t0 < SEQ; t0 += 8) {
        SCAN_LOAD(B, t0 + 4);
        SCAN_STEPS(A, t0);
        if (t0 + 8 < SEQ) SCAN_LOAD(A, t0 + 8);
        SCAN_STEPS(B, t0 + 4);
    }
#undef SCAN_LOAD
#undef SCAN_STEPS
}

__device__ __forceinline__ void idx_scores_quad(const bf16* P, float* Sc, int t0, int lane) {
    typedef float f32x16 __attribute__((ext_vector_type(16)));
    const int r = lane & 31, hh = lane >> 5;
    bf16x8 af[2][4]; float wq[2][16];
#pragma unroll
    for (int a = 0; a < 2; ++a) {
        const bf16* qrow = P + (size_t)(t0 + 2 * a + (r >> 4)) * LDP + C_QI + (r & 15) * 64 + hh * 8;
#pragma unroll
        for (int ks = 0; ks < 4; ++ks) af[a][ks] = *(const GAS bf16x8*)(qrow + ks * 16);
#pragma unroll
        for (int i = 0; i < 16; ++i) { const int head = (i & 3) + 8 * ((i >> 2) & 1) + 4 * hh; wq[a][i] = bf2f(P[(size_t)(t0 + 2 * a + (i >> 3)) * LDP + C_WI + head]); }
    }
    const int nkt = (t0 + 3) / 32 + 1;
    for (int kt = 0; kt < nkt; ++kt) {
        const int key = kt * 32 + r;
        const bf16* krow = P + (size_t)key * LDP + C_KI + hh * 8;
        bf16x8 bfr[4];
#pragma unroll
        for (int ks = 0; ks < 4; ++ks) bfr[ks] = *(const GAS bf16x8*)(krow + ks * 16);
#pragma unroll
        for (int a = 0; a < 2; ++a) {
            f32x16 acc;
#pragma unroll
            for (int i = 0; i < 16; ++i) acc[i] = 0.f;
#pragma unroll
            for (int ks = 0; ks < 4; ++ks) acc = __builtin_amdgcn_mfma_f32_32x32x16_bf16(af[a][ks], bfr[ks], acc, 0, 0, 0);
            float s0 = 0.f, s1 = 0.f;
#pragma unroll
            for (int i = 0; i < 8; ++i) { s0 += wq[a][i] * fmaxf(acc[i], 0.f); s1 += wq[a][8 + i] * fmaxf(acc[8 + i], 0.f); }
            s0 = swap32_sum(s0); s1 = swap32_sum(s1);
            Sc[(size_t)(t0 + 2 * a + hh) * SEQ + key] = hh ? s1 : s0;
        }
    }
}

__device__ __forceinline__ unsigned f2key(float f) { const unsigned u = __float_as_uint(f); return (u & 0x80000000u) ? ~u : (u | 0x80000000u); }
__device__ __forceinline__ void topk_row(const float* sc, int L, int* out, LAS unsigned* hist, int lane) {
    unsigned prefix = 0u, himask = 0u; int kneed = 256;
    for (int pass = 0; pass < 4; ++pass) {
        const int shift = 24 - 8 * pass;
#pragma unroll
        for (int b = 0; b < 4; ++b) hist[lane + 64 * b] = 0u;
        LDS_WAIT(); asm volatile("" ::: "memory");
        for (int i = lane; i < L; i += 64) { const unsigned u = f2key(sc[i]); if ((u & himask) == prefix) __hip_atomic_fetch_add(&hist[(u >> shift) & 255u], 1u, __ATOMIC_RELAXED, __HIP_MEMORY_SCOPE_WORKGROUP); }
        LDS_WAIT(); asm volatile("" ::: "memory");
        unsigned c[4];
#pragma unroll
        for (int j = 0; j < 4; ++j) c[j] = hist[4 * lane + j];
        const unsigned tot = (c[0] + c[1]) + (c[2] + c[3]);
        unsigned inc = tot;
#pragma unroll
        for (int o = 1; o < 64; o <<= 1) { const unsigned v = bperm_u32(inc, (lane + o) & 63); if (lane + o < 64) inc += v; }
        unsigned cum = inc - tot; bool found = false; unsigned d = 0u, gt = 0u;
#pragma unroll
        for (int j = 3; j >= 0; --j) { if (!found && cum < (unsigned)kneed && (unsigned)kneed <= cum + c[j]) { found = true; d = 4u * lane + j; gt = cum; } cum += c[j]; }
        const unsigned long long m = __ballot(found);
        const int src = m ? (int)__builtin_ctzll(m) : 0;
        d = (unsigned)__builtin_amdgcn_readlane((int)d, src); gt = (unsigned)__builtin_amdgcn_readlane((int)gt, src);
        prefix |= d << shift; himask |= 0xFFu << shift; kneed -= (int)gt;
        LDS_WAIT(); asm volatile("" ::: "memory");
    }
    int pos = 0, eqtaken = 0;
    const unsigned long long lt = (1ull << lane) - 1ull;
    for (int base = 0; base < L; base += 64) {
        const int i = base + lane; const bool valid = i < L; unsigned u = 0u; if (valid) u = f2key(sc[i]);
        const bool gtm = valid && u > prefix, eqm = valid && u == prefix;
        const unsigned long long meq = __ballot(eqm);
        const bool take = gtm || (eqm && (eqtaken + __popcll(meq & lt) < kneed));
        const unsigned long long mt = __ballot(take);
        const int p = pos + __popcll(mt & lt);
        if (take && p < 256) out[p] = i;
        pos += __popcll(mt); eqtaken += __popcll(meq);
    }
}

__device__ __forceinline__ void sparse_attn_task(const bf16* P, const int* idxbuf, bf16* mix, int t, int h, LAS float* wsf, int lane) {
    const int n = (t < 256) ? (t + 1) : 256;
    LAS float* qs = wsf; LAS float* ps = wsf + 128; LAS int* is = (LAS int*)(wsf + 384);
#pragma unroll
    for (int d = lane; d < 128; d += 64) qs[d] = bf2f(P[(size_t)t * LDP + C_QC + h * 128 + d]) * QC_SCALE;
#pragma unroll
    for (int j = lane; j < 256; j += 64) is[j] = (j < n) ? ((t < 256) ? j : idxbuf[(size_t)t * 256 + j]) : 0;
    LDS_WAIT(); asm volatile("" ::: "memory");
    float sc[4]; float mx = -INFINITY;
#pragma unroll
    for (int jj = 0; jj < 4; ++jj) { const int j = jj * 64 + lane; float s = -INFINITY;
        if (j < n) { const bf16* kr = P + (size_t)is[j] * LDP + C_KC + h * 128; s = 0.f;
#pragma unroll 4
            for (int c = 0; c < 16; ++c) { const v4u kv = *(const GAS v4u*)(kr + c * 8);
                s += qs[c * 8 + 0] * bflo(kv.x) + qs[c * 8 + 1] * bfhi(kv.x) + qs[c * 8 + 2] * bflo(kv.y) + qs[c * 8 + 3] * bfhi(kv.y)
                   + qs[c * 8 + 4] * bflo(kv.z) + qs[c * 8 + 5] * bfhi(kv.z) + qs[c * 8 + 6] * bflo(kv.w) + qs[c * 8 + 7] * bfhi(kv.w); } }
        sc[jj] = s; mx = fmaxf(mx, s); }
    mx = wave_max(mx);
    float sum = 0.f;
#pragma unroll
    for (int jj = 0; jj < 4; ++jj) { const int j = jj * 64 + lane; const float p = (j < n) ? exp2f(sc[jj] - mx) : 0.f; ps[j] = p; sum += p; }
    sum = wave_sum(sum);
    LDS_WAIT(); asm volatile("" ::: "memory");
    float o0 = 0.f, o1 = 0.f;
    const bf16* vb = P + C_VC + h * 128 + 2 * lane;
#pragma unroll 8
    for (int j = 0; j < n; ++j) { const float p = ps[j]; const unsigned vv = *(const GAS unsigned*)(vb + (size_t)is[j] * LDP); o0 += p * bflo(vv); o1 += p * bfhi(vv); }
    const float inv = 1.0f / sum;
    *(GAS unsigned*)(mix + (size_t)t * DM + 3072 + h * 128 + 2 * lane) = pk2(o0 * inv, o1 * inv);
    LDS_WAIT(); asm volatile("" ::: "memory");
}

__device__ __forceinline__ void finalize_mix(unsigned char* ws, gu32* ctl, int layer, int gw, int NGW, int lane) {
    const bf16* O0 = (const bf16*)(ws + WS_O0); const bf16* O1 = (const bf16*)(ws + WS_O1); bf16* mix = (bf16*)(ws + WS_MIX);
    const float lam = __uint_as_float(__hip_atomic_load(ctl + CW_LAM + layer, RLX_AGENT));
    const float lam_init = 0.8f - 0.6f * expf(-0.3f * (float)layer);
    const float* Y = (const float*)(ws + WS_Y); const float* SR = (const float*)(ws + WS_SR); const float* SK = (const float*)(ws + WS_SK); const float* SV = (const float*)(ws + WS_SV);
    const float* Z = (const float*)(ws + WS_Z);
    for (int task = gw; task < SEQ * 40; task += NGW) {
        const int t = task / 40, j = task - t * 40;
        if (j < 8) {
            const size_t o = (size_t)t * 1024 + j * 128 + 2 * lane;
            const unsigned a = *(const GAS unsigned*)(O0 + o), b = *(const GAS unsigned*)(O1 + o);
            const float x0 = bflo(a) - lam * bflo(b), x1 = bfhi(a) - lam * bfhi(b);
            const float ms = wave_sum(x0 * x0 + x1 * x1) * (1.f / 128.f);
            const float rs = (1.0f / sqrtf(ms + RMS_EPS)) * (1.0f - lam_init);
            const float* g = inp<I_SUBLN>() + layer * 128 + 2 * lane;
            *(GAS unsigned*)(mix + (size_t)t * DM + j * 128 + 2 * lane) = pk2(x0 * rs * g[0], x1 * rs * g[1]);
        } else {
            const int head = j - 8, c = head * 64 + lane; const size_t o = (size_t)t * BW + c;
            const float y = Y[o];
            const float mean = wave_sum(y) * (1.f / 64.f); const float dlt = y - mean;
            const float var = wave_sum(dlt * dlt) * (1.f / 64.f);
            const float yn = dlt * (1.0f / sqrtf(var + GN_EPS)) * inp<I_LNW>()[layer * BW + c] + inp<I_LNB>()[layer * BW + c];
            const float bonus = wave_sum(SR[o] * SK[o] * inp<I_RK>()[layer * BW + c]) * SV[o];
            const float g = Z[(size_t)t * 8192 + 2 * BW + c];
            mix[(size_t)t * DM + 1024 + c] = (bf16)f2bf((yn + bonus) * g);
        }
    }
}

constexpr int NPL = 15;
constexpr int PH_FINAL = 2 * NPL, N_PHASES = PH_FINAL + 1;
struct Args { const float* in[N_INPUTS]; float* out; unsigned char* ws; int ph_lo, ph_hi; };
static_assert(sizeof(Args) == N_INPUTS * 8 + 24, "kernarg layout: in[i] at 8*i, out, ws, ph_lo, ph_hi");
__device__ __forceinline__ XcdBarrier bar_make(unsigned char* ws, volatile LAS unsigned* misc) { XcdBarrier b; b.bar = (unsigned*)(ws + WS_CTL) + CW_BAR; b.x = xb_xcc_id(); b.st = misc + 8; return b; }

extern __shared__ __attribute__((aligned(16))) unsigned char lds_[];
#define IN(k) (lo <= (k) && (k) < hi)
#define SEAM(k) do { if (IN(k) && IN((k) + 1)) { const Ctx cb_ = ctx_make(wave0); xcd_barrier(bar_make(cb_.ws, MISC), cb_.tid == 0); } } while (0)
#define WSP(T, off) ((T*)(c.ws + (off)))
template <int L> __device__ __forceinline__ void layer_phases(const int lo, const int hi, const int wave0) {
    LAS unsigned char* lds = (LAS unsigned char*)lds_;
    volatile LAS unsigned* MISC = (volatile LAS unsigned*)(lds + MISC_OFF);
    constexpr int pb = L * NPL;
        if (IN(pb + 0)) { const Ctx c = ctx_make(wave0, L); layer_prologue(c.ws, (gu32*)(c.ws + WS_CTL), lds, c.l, c.gw, c.NGW, c.wave, c.lane);
            rmsnorm_rows_bf16(c.l == 0 ? inp<I_X>() : ARG_OUT, inp<I_NMG>() + (size_t)c.l * DM, WSP(bf16, WS_H), c.gw, c.NGW, c.lane); SEAM(pb + 0); }
        if (IN(pb + 1)) { const Ctx c = ctx_make(wave0, L);
            pg8::Gemm g{WSP(bf16, WS_H), WSP(bf16, WS_WIN), SEQ, LDP, DM, DM, DM}; pg8::StaticOrder S; S.init(SEQ, LDP, c.G, c.bx);
            pg8::EpiBf16x<0> E{WSP(bf16, WS_P), LDP, QA_SCALE, 4};
            pg8::gemm_phase<pg8::EpiBf16x<0>, pg8::StaticOrder, true, true>(lds + RING_OFF, g, S, E, c.tid);
            SEAM(pb + 1);
        }
        if (IN(pb + 2)) { const Ctx c = ctx_make(wave0, L); lora_prep(WSP(bf16, WS_P), WSP(bf16, WS_AP), c.l, c.gw, c.NGW, c.lane); SEAM(pb + 2); }
        if (IN(pb + 3)) { const Ctx c = ctx_make(wave0, L);
            const int N2 = (c.l == 0) ? 6144 : 8192;
            pg8::Gemm g{WSP(bf16, WS_AP), WSP(bf16, WS_BT2), SEQ, N2, 256, 1024, 256}; pg8::LoraOrder S; S.init(SEQ, N2, c.G, c.bx);
            pg8::EpiF32x E{WSP(float, WS_Z), 8192, nullptr};
            pg8::gemm_phase<pg8::EpiF32x, pg8::LoraOrder, true, true>(lds + RING_OFF, g, S, E, c.tid);
            SEAM(pb + 3);
        }
        if (IN(pb + 4)) { const Ctx c = ctx_make(wave0, L); rwkv_prep(c.ws, c.l, c.gw, c.NGW, c.lane); SEAM(pb + 4); }
        if (IN(pb + 5)) { const Ctx c = ctx_make(wave0, L); for (int u = c.vcu; u < 64; u += c.G) scan_unit(c.ws, u, c.wave, c.lane); SEAM(pb + 5); }
        if (IN(pb + 6)) { const Ctx c = ctx_make(wave0, L);
            const attn_body::AttnTensors AT{WSP(const attn_body::bf16, WS_P), WSP(const attn_body::bf16, WS_P), WSP(const attn_body::bf16, WS_P), WSP(attn_body::bf16, WS_O0), WSP(attn_body::bf16, WS_O1)};
            const attn_body::StaticOrder S(c.G, c.bx);
            attn_body::attn_phase<attn_body::StaticOrder>((char*)lds_ + RING_OFF, AT, S, c.tid);
            SEAM(pb + 6);
        }
        if (IN(pb + 7)) { const Ctx c = ctx_make(wave0, L);
            for (int j = c.gw; j < 1024; j += c.NGW) { idx_scores_quad(WSP(bf16, WS_P), WSP(float, WS_SC), 4 * j, c.lane); idx_scores_quad(WSP(bf16, WS_P), WSP(float, WS_SC), 4 * (2047 - j), c.lane); }
            SEAM(pb + 7); }
        if (IN(pb + 8)) { const Ctx c = ctx_make(wave0, L); LAS unsigned* hist = (LAS unsigned*)(lds + RING_OFF + c.wave * 16384);
            for (int row = 256 + c.gw; row < SEQ; row += c.NGW) topk_row(WSP(float, WS_SC) + (size_t)row * SEQ, row + 1, WSP(int, WS_IDX) + (size_t)row * 256, hist, c.lane);
            SEAM(pb + 8); }
        if (IN(pb + 9)) { const Ctx c = ctx_make(wave0, L); LAS float* wsf = (LAS float*)(lds + RING_OFF + c.wave * 16384);
            for (int task = c.gw; task < SEQ * 8; task += c.NGW) sparse_attn_task(WSP(bf16, WS_P), WSP(int, WS_IDX), WSP(bf16, WS_MIX), task >> 3, task & 7, wsf, c.lane);
            SEAM(pb + 9); }
        if (IN(pb + 10)) { const Ctx c = ctx_make(wave0, L); finalize_mix(c.ws, (gu32*)(c.ws + WS_CTL), c.l, c.gw, c.NGW, c.lane); SEAM(pb + 10); }
        if (IN(pb + 11)) { const Ctx c = ctx_make(wave0, L);
            pg8::Gemm g{WSP(bf16, WS_MIX), WSP(bf16, WS_WOUT), SEQ, DM, DM, DM, DM}; pg8::StaticOrder S; S.init(SEQ, DM, c.G, c.bx);
            float* out = ARG_OUT; pg8::EpiF32x E{out, DM, c.l == 0 ? inp<I_X>() : out};
            pg8::gemm_phase<pg8::EpiF32x, pg8::StaticOrder, true, true>(lds + RING_OFF, g, S, E, c.tid);
            SEAM(pb + 11);
        }
        if (IN(pb + 12)) { const Ctx c = ctx_make(wave0, L); rmsnorm_rows_bf16(ARG_OUT, inp<I_NFG>() + (size_t)c.l * DM, WSP(bf16, WS_H), c.gw, c.NGW, c.lane); SEAM(pb + 12); }
        if (IN(pb + 13)) { const Ctx c = ctx_make(wave0, L);
            pg8::Gemm g{WSP(bf16, WS_H), WSP(bf16, WS_WUP), SEQ, DFF, DM, DM, DM}; pg8::StaticOrder S; S.init(SEQ, DFF, c.G, c.bx);
            pg8::EpiBf16x<1> E{WSP(bf16, WS_U), DFF, 1.f, 0};
            pg8::gemm_phase<pg8::EpiBf16x<1>, pg8::StaticOrder, true, true>(lds + RING_OFF, g, S, E, c.tid);
            SEAM(pb + 13);
        }
        if (IN(pb + 14)) { const Ctx c = ctx_make(wave0, L);
            pg8::Gemm g{WSP(bf16, WS_U), WSP(bf16, WS_WDN), SEQ, DM, DFF, DFF, DFF}; pg8::StaticOrder S; S.init(SEQ, DM, c.G, c.bx);
            float* out = ARG_OUT; pg8::EpiF32x E{out, DM, out};
            pg8::gemm_phase<pg8::EpiF32x, pg8::StaticOrder, true, true>(lds + RING_OFF, g, S, E, c.tid);
            SEAM(pb + 14);
        }
    }
__global__ void __launch_bounds__(NWAVES * 64, 2) mk_fwd(Args args) {
    LAS unsigned char* lds = (LAS unsigned char*)lds_;
    volatile LAS unsigned* MISC = (volatile LAS unsigned*)(lds + MISC_OFF);
    for (int u = threadIdx.x; u < (LDS_BYTES - LDSCTL_OFF) / 4; u += NWAVES * 64) ((LAS unsigned*)(lds + LDSCTL_OFF))[u] = 0u;
    __syncthreads();
    const int lo = args.ph_lo, hi = args.ph_hi, wave0 = __builtin_amdgcn_readfirstlane((int)threadIdx.x >> 6);
    if (hi - lo > 1) (void)xcd_barrier_post((unsigned*)(ARG_WS + WS_CTL) + CW_BAR, MISC + 8);

    layer_phases<0>(lo, hi, wave0);
    layer_phases<1>(lo, hi, wave0);
    if (IN(PH_FINAL)) { const Ctx c = ctx_make(wave0); rmsnorm_rows_f32_inplace(ARG_OUT, inp<I_NFIN>(), c.gw, c.NGW, c.lane); }
#undef IN
#undef SEAM
#undef WSP
}

extern "C" void kernel_launch(void* const* d_in, const int* in_sizes, int n_in, void* d_out, int out_size, void* d_ws, size_t ws_size, hipStream_t stream) {
    static int grid = 0;
    if (grid == 0) {
        if (n_in != N_INPUTS || in_sizes[0] != SEQ * DM || out_size != SEQ * DM || ws_size < WS_END) {
            fprintf(stderr, "kernel_launch: unexpected shapes: n_in %d in0 %d out %d ws %zu (need %zu)\n", n_in, n_in > 0 ? in_sizes[0] : -1, out_size, ws_size, (size_t)WS_END); _exit(77); }
        int dev = 0, cus = 0;
        if (hipGetDevice(&dev) != hipSuccess || hipDeviceGetAttribute(&cus, hipDeviceAttributeMultiprocessorCount, dev) != hipSuccess) { grid = -1; return; }
        if (hipFuncSetAttribute((const void*)mk_fwd, hipFuncAttributeMaxDynamicSharedMemorySize, LDS_BYTES) != hipSuccess) { fprintf(stderr, "kernel_launch: hipFuncSetAttribute failed\n"); grid = -1; return; }
        (void)hipGetLastError();
        grid = cus;
    }
    if (grid < 0) return;
    if (hipMemsetAsync((char*)d_ws + WS_CTL, 0, CTL_ZERO_BYTES, stream) != hipSuccess) return;
    Args a{};
    for (int i = 0; i < N_INPUTS; ++i) a.in[i] = (const float*)d_in[i];
    a.out = (float*)d_out; a.ws = (unsigned char*)d_ws;
#ifndef MK_ONE_LAUNCH
#ifndef MK_MAXPH
#define MK_MAXPH N_PHASES
#endif
    for (int ph = 0; ph < MK_MAXPH; ++ph) { a.ph_lo = ph; a.ph_hi = ph + 1;
        hipLaunchKernelGGL(mk_fwd, dim3(grid), dim3(NWAVES * 64), LDS_BYTES, stream, a); }
#else
    a.ph_lo = 0; a.ph_hi = N_PHASES;
    hipLaunchKernelGGL(mk_fwd, dim3(grid), dim3(NWAVES * 64), LDS_BYTES, stream, a);
#endif
}
```

```cpp
#define MK_ONE_LAUNCH 1
#include <hip/hip_runtime.h>
#include <hip/hip_bf16.h>
#include <cstdio>
#include <cstdint>
#include <cmath>
#include <unistd.h>
namespace pg8 {
#define PG8_LAS __attribute__((address_space(3)))
typedef unsigned short bf16_t;
typedef short bf16x8 __attribute__((ext_vector_type(8)));
typedef float f32x4 __attribute__((ext_vector_type(4)));
typedef unsigned u32x4 __attribute__((ext_vector_type(4)));
constexpr int BM = 256, BK = 64, HALF = 128, HTB = HALF * BK * 2  , STAGE_BYTES = 8 * HTB, NXCD = 8, WGM = 8;

__host__ __device__ __forceinline__ int lds_byte(int r, int c) { const int st = (r >> 4) * 2 + (c >> 5), rr = r & 15, cc = c & 31, ob = rr * 64 + cc * 2; return st * 1024 + (ob ^ (((ob >> 9) & 1) << 5)); }
__host__ __device__ __forceinline__ void stage_rc(int b, int& R, int& C) { const int st = b / 1024, sb = b % 1024, swz = sb ^ (((sb >> 9) & 1) << 5); R = (st >> 1) * 16 + swz / 64; C = (st & 1) * 32 + (swz % 64) / 2; }
__host__ __device__ __forceinline__ int perm32(int rho) { const int n = rho >> 4, i = rho & 15; return 8 * (i >> 2) + 4 * n + (i & 3); }

struct Unit { int pm, pn; };
struct Gemm { const bf16_t* A; const bf16_t* Bt; int M, N, K, lda, ldb; };

struct StaticOrder {
    int nM, nN, nwg, G, c;
    __host__ __device__ void init(int M, int N, int G_, int c_) { nM = M / BM; nN = N / BM; nwg = nM * nN; G = G_; c = c_; }
    __host__ __device__ bool next(int i, Unit& u) const {
        const long L = (long)i * G + c; if (L >= nwg) return false;
        int wgid = (int)L; { const int q = nwg / NXCD, r = nwg % NXCD, xcd = wgid % NXCD, off = wgid / NXCD; wgid = (xcd < r ? xcd * (q + 1) : r * (q + 1) + (xcd - r) * q) + off; }
        const int nig = WGM * nN, gid = wgid / nig, fm = gid * WGM, gsz = (nM - fm) < WGM ? (nM - fm) : WGM;
        u.pm = fm + ((wgid % nig) % gsz); u.pn = (wgid % nig) / gsz; return true;
    }
    __device__ __forceinline__ void a_ready(const Unit&) const {}
    __device__ __forceinline__ size_t a_off(const Unit&) const { return 0; }
    __device__ __forceinline__ int b_tile(const Unit& u) const { return u.pn; }
    __device__ __forceinline__ size_t b_off(const Unit&) const { return 0; }
    __device__ __forceinline__ void done(const Unit&) const {}
};
struct SplitKOrder {
    int nM, NS, G, c; size_t wbytes;
    __host__ __device__ void init(int M, int ns, int kwin, int G_, int c_) { nM = M / BM; NS = ns; G = G_; c = c_; wbytes = (size_t)kwin * 2; }
    __host__ __device__ bool next(int i, Unit& u) const { const long L = (long)i * G + c; if (L >= (long)nM * NS) return false; u.pm = (int)(L / NS); u.pn = (int)(L % NS); return true; }
    __device__ __forceinline__ void a_ready(const Unit&) const {}
    __device__ __forceinline__ size_t a_off(const Unit& u) const { return (size_t)u.pn * wbytes; }
    __device__ __forceinline__ int b_tile(const Unit&) const { return 0; }
    __device__ __forceinline__ size_t b_off(const Unit& u) const { return (size_t)u.pn * wbytes; }
    __device__ __forceinline__ void done(const Unit&) const {}
};


__device__ __forceinline__ unsigned cvt_pk_bf16(float lo, float hi) { unsigned r; asm volatile("v_cvt_pk_bf16_f32 %0, %1, %2" : "=v"(r) : "v"(lo), "v"(hi)); return r; }
template <int MODE> struct EpiBf16x {
    static constexpr bool PERM = true, AFTER_DRAIN = false;
    bf16_t* O; int ldc; float sc; int nsc; float sc2; int lo2, hi2;
    __device__ __forceinline__ void operator()(const f32x4 (&acc)[2][2][4][2], const Unit& u, int wr, int wc, int fr, int fq) const {
        const int row0 = u.pm * BM + wr * 64 + fr, col0 = u.pn * BM + wc * 32 + 8 * fq;
        const float s = (MODE == 0) ? ((u.pn < nsc) ? sc : ((u.pn >= lo2 && u.pn < hi2) ? sc2 : 1.f)) : 1.f;
#pragma unroll
        for (int ai = 0; ai < 2; ++ai)
#pragma unroll
            for (int m = 0; m < 4; ++m) { bf16_t* rowp = O + (size_t)(row0 + ai * HALF + m * 16) * ldc + col0;
#pragma unroll
                for (int bj = 0; bj < 2; ++bj) { f32x4 v0 = acc[ai][bj][m][0], v1 = acc[ai][bj][m][1];
                    if (MODE == 0) { v0 = v0 * s; v1 = v1 * s; }
                    if (MODE == 1) {
#pragma unroll
                        for (int j = 0; j < 4; ++j) { const float a = fmaxf(v0[j], 0.f), b = fmaxf(v1[j], 0.f); v0[j] = a * a; v1[j] = b * b; } }
                    u32x4 w; w.x = cvt_pk_bf16(v0[0], v0[1]); w.y = cvt_pk_bf16(v0[2], v0[3]); w.z = cvt_pk_bf16(v1[0], v1[1]); w.w = cvt_pk_bf16(v1[2], v1[3]);
                    *(u32x4*)(rowp + bj * HALF) = w; } }
    }
};
struct EpiF32x {
    static constexpr bool PERM = false, AFTER_DRAIN = false;
    float* C; int ldc; const float* base;
    __device__ __forceinline__ void operator()(const f32x4 (&acc)[2][2][4][2], const Unit& u, int wr, int wc, int fr, int fq) const {
        const int row0 = u.pm * BM + wr * 64 + fr, col0 = u.pn * BM + wc * 32 + 4 * fq;
#pragma unroll
        for (int ai = 0; ai < 2; ++ai)
#pragma unroll
            for (int m = 0; m < 4; ++m) { const size_t off = (size_t)(row0 + ai * HALF + m * 16) * ldc + col0;
#pragma unroll
                for (int bj = 0; bj < 2; ++bj)
#pragma unroll
                    for (int n = 0; n < 2; ++n) { f32x4 v = acc[ai][bj][m][n]; if (base) v = v + *(const f32x4*)(base + off + bj * HALF + n * 16); *(f32x4*)(C + off + bj * HALF + n * 16) = v; }
                asm volatile("" ::: "memory"); }
    }
};

__device__ __forceinline__ float xor16_sum(float v) { auto rr = __builtin_amdgcn_permlane16_swap(__float_as_uint(v), __float_as_uint(v), false, false); return __uint_as_float(rr[0]) + __uint_as_float(rr[1]); }
__device__ __forceinline__ float xor32_sum(float v) { auto rr = __builtin_amdgcn_permlane32_swap(__float_as_uint(v), __float_as_uint(v), false, false); return __uint_as_float(rr[0]) + __uint_as_float(rr[1]); }
struct EpiF32xN {
    static constexpr bool PERM = true, AFTER_DRAIN = false;
    float* C; int ldc; const float* base; bf16_t* XB; unsigned long long* SS;
    __device__ __forceinline__ void operator()(const f32x4 (&acc)[2][2][4][2], const Unit& u, int wr, int wc, int fr, int fq) const {
        const int row0 = u.pm * BM + wr * 64 + fr, col0 = u.pn * BM + wc * 32 + 8 * fq;
#pragma unroll
        for (int ai = 0; ai < 2; ++ai)
#pragma unroll
            for (int m = 0; m < 4; ++m) { const int row = row0 + ai * HALF + m * 16; const size_t off = (size_t)row * ldc + col0; float s = 0.f;
#pragma unroll
                for (int bj = 0; bj < 2; ++bj) { f32x4 v0 = acc[ai][bj][m][0], v1 = acc[ai][bj][m][1];
                    v0 = v0 + *(const f32x4*)(base + off + bj * HALF); v1 = v1 + *(const f32x4*)(base + off + bj * HALF + 4);
                    *(f32x4*)(C + off + bj * HALF) = v0; *(f32x4*)(C + off + bj * HALF + 4) = v1;
                    s += (v0[0] * v0[0] + v0[1] * v0[1]) + (v0[2] * v0[2] + v0[3] * v0[3]) + (v1[0] * v1[0] + v1[1] * v1[1]) + (v1[2] * v1[2] + v1[3] * v1[3]);
                    u32x4 w; w.x = cvt_pk_bf16(v0[0], v0[1]); w.y = cvt_pk_bf16(v0[2], v0[3]); w.z = cvt_pk_bf16(v1[0], v1[1]); w.w = cvt_pk_bf16(v1[2], v1[3]);
                    *(u32x4*)(XB + off + bj * HALF) = w; }
                s = xor16_sum(s); s = xor32_sum(s);
                if (fq == 0) __hip_atomic_fetch_add(SS + row, (unsigned long long)(s * 16777216.f), __ATOMIC_RELAXED, __HIP_MEMORY_SCOPE_AGENT);
                asm volatile("" ::: "memory"); }
    }
};
struct EpiUpN {
    static constexpr bool PERM = true, AFTER_DRAIN = false;
    bf16_t* O; int ldc; const unsigned long long* SS; float inv_n, eps;
    __device__ __forceinline__ void operator()(const f32x4 (&acc)[2][2][4][2], const Unit& u, int wr, int wc, int fr, int fq) const {
        const int row0 = u.pm * BM + wr * 64 + fr, col0 = u.pn * BM + wc * 32 + 8 * fq;
#pragma unroll
        for (int ai = 0; ai < 2; ++ai)
#pragma unroll
            for (int m = 0; m < 4; ++m) { const int row = row0 + ai * HALF + m * 16; bf16_t* rowp = O + (size_t)row * ldc + col0;
                const float rstd = 1.0f / sqrtf((float)SS[row] * (inv_n * (1.f / 16777216.f)) + eps);
#pragma unroll
                for (int bj = 0; bj < 2; ++bj) { f32x4 v0 = acc[ai][bj][m][0] * rstd, v1 = acc[ai][bj][m][1] * rstd;
#pragma unroll
                    for (int j = 0; j < 4; ++j) { const float a = fmaxf(v0[j], 0.f), b = fmaxf(v1[j], 0.f); v0[j] = a * a; v1[j] = b * b; }
                    u32x4 w; w.x = cvt_pk_bf16(v0[0], v0[1]); w.y = cvt_pk_bf16(v0[2], v0[3]); w.z = cvt_pk_bf16(v1[0], v1[1]); w.w = cvt_pk_bf16(v1[2], v1[3]);
                    *(u32x4*)(rowp + bj * HALF) = w; } }
    }
};

struct EpiLora {
    static constexpr bool PERM = true, AFTER_DRAIN = false;
    float* ZW; bf16_t* ZB;
    __device__ __forceinline__ void operator()(const f32x4 (&acc)[2][2][4][2], const Unit& u, int wr, int wc, int fr, int fq) const {
        const int row0 = u.pm * BM + wr * 64 + fr, col0 = u.pn * BM + wc * 32 + 8 * fq;
        if (u.pn < 8) {
#pragma unroll
            for (int ai = 0; ai < 2; ++ai)
#pragma unroll
                for (int m = 0; m < 4; ++m) { float* rowp = ZW + (size_t)(row0 + ai * HALF + m * 16) * 2048 + col0;
#pragma unroll
                    for (int bj = 0; bj < 2; ++bj) { *(f32x4*)(rowp + bj * HALF) = acc[ai][bj][m][0]; *(f32x4*)(rowp + bj * HALF + 4) = acc[ai][bj][m][1]; }
                    asm volatile("" ::: "memory"); }
        } else {
#pragma unroll
            for (int ai = 0; ai < 2; ++ai)
#pragma unroll
                for (int m = 0; m < 4; ++m) { bf16_t* rowp = ZB + (size_t)(row0 + ai * HALF + m * 16) * 6144 + (col0 - 2048);
#pragma unroll
                    for (int bj = 0; bj < 2; ++bj) { const f32x4 v0 = acc[ai][bj][m][0], v1 = acc[ai][bj][m][1];
                        u32x4 w; w.x = cvt_pk_bf16(v0[0], v0[1]); w.y = cvt_pk_bf16(v0[2], v0[3]); w.z = cvt_pk_bf16(v1[0], v1[1]); w.w = cvt_pk_bf16(v1[2], v1[3]);
                        *(u32x4*)(rowp + bj * HALF) = w; }
                    asm volatile("" ::: "memory"); }
        }
    }
};
struct LoraOrder : StaticOrder {
    __device__ __forceinline__ size_t a_off(const Unit& u) const { return (size_t)(u.pn >> 3) * 256 * 2; }
};
template <class Epi, class Sched, bool ALIGN_EPI = false, bool SP2 = false>
__device__ __forceinline__ void gemm_phase(PG8_LAS unsigned char* lds, const Gemm g, const Sched& S, const Epi& E, const int tid) {
    const int wid = __builtin_amdgcn_readfirstlane(tid >> 6), lane = tid & 63, wr = wid >> 2, wc = wid & 3, fr = lane & 15, fq = lane >> 4;
    const int K = g.K, nt = K / BK;
    unsigned voffA[2], voffB[2];
#pragma unroll
    for (int i = 0; i < 2; ++i) { int R, C; stage_rc(tid * 16 + i * 8192, R, C); const int Rb = Epi::PERM ? ((R & ~31) + perm32(R & 31)) : R;
        voffA[i] = (unsigned)(R * g.lda + C) * 2u; voffB[i] = (unsigned)(Rb * g.ldb + C) * 2u; }
    const size_t kstep = (size_t)(BK * 2);
    const size_t hA = (size_t)HALF * g.lda * 2, hB = (size_t)HALF * g.ldb * 2;
    const size_t tA = 2 * hA, tB = 2 * hB;
    const unsigned ldsw = (unsigned)wid * 1024u;
    const int aoff = lds_byte(wr * 64 + fr, fq * 8), boff = lds_byte(wc * 32 + fr, fq * 8);
#define PG8_SA(b, h) (((b) * 2 + (h)) * HTB)
#define PG8_SB(b, h) ((4 + (b) * 2 + (h)) * HTB)
#define PG8_STAGE(bufoff, gbase, voff) do { _Pragma("unroll") for (int _i = 0; _i < 2; ++_i) \
        __builtin_amdgcn_global_load_lds((const unsigned*)((const char*)(gbase) + (voff)[_i]), (PG8_LAS unsigned*)(lds + (bufoff) + ldsw + _i * 8192), 16, 0, 0); } while (0)
#define PG8_LDA(dst, b, h) do { _Pragma("unroll") for (int m = 0; m < 4; ++m) _Pragma("unroll") for (int k = 0; k < 2; ++k) dst[m][k] = *(const PG8_LAS bf16x8*)(lds + PG8_SA(b, h) + aoff + m * 2048 + k * 1024); } while (0)
#define PG8_LDB(dst, b, h) do { _Pragma("unroll") for (int n = 0; n < 2; ++n) _Pragma("unroll") for (int k = 0; k < 2; ++k) dst[n][k] = *(const PG8_LAS bf16x8*)(lds + PG8_SB(b, h) + boff + n * 2048 + k * 1024); } while (0)
#define PG8_MMA(ai, bj, At, Bt) do { __builtin_amdgcn_s_setprio(1); _Pragma("unroll") for (int m = 0; m < 4; ++m) _Pragma("unroll") for (int n = 0; n < 2; ++n) _Pragma("unroll") for (int k = 0; k < 2; ++k) \
        acc[ai][bj][m][n] = __builtin_amdgcn_mfma_f32_16x16x32_bf16(Bt[n][k], At[m][k], acc[ai][bj][m][n], 0, 0, 0); __builtin_amdgcn_s_setprio(0); } while (0)
#define PG8_WAIT_V(n) asm volatile("s_waitcnt vmcnt(" #n ")" ::: "memory")
#define PG8_WAIT_L(n) asm volatile("s_waitcnt lgkmcnt(" #n ")" ::: "memory")
#define PG8_BAR __builtin_amdgcn_s_barrier()
#define PG8_SCHED __builtin_amdgcn_sched_barrier(0)
    Unit cur, nxt; int ui = 0;
    if (!S.next(0, cur)) return;
    f32x4 acc[2][2][4][2];
#pragma unroll
    for (int a = 0; a < 2; ++a)
#pragma unroll
        for (int b = 0; b < 2; ++b)
#pragma unroll
            for (int m = 0; m < 4; ++m)
#pragma unroll
                for (int n = 0; n < 2; ++n) acc[a][b][m][n] = (f32x4){0.f, 0.f, 0.f, 0.f};
    bf16x8 At[4][2], B0[2][2], B1[2][2];
    const char* cA = (const char*)g.A + (size_t)cur.pm * tA + S.a_off(cur); const char* cB = (const char*)g.Bt + (size_t)S.b_tile(cur) * tB + S.b_off(cur);
    S.a_ready(cur);
    if constexpr (SP2) {
        PG8_STAGE(PG8_SB(0, 0), cB, voffB); PG8_STAGE(PG8_SB(0, 1), cB + hB, voffB); PG8_STAGE(PG8_SA(0, 0), cA, voffA); PG8_STAGE(PG8_SA(0, 1), cA + hA, voffA);
        if (wr == 1) PG8_BAR;
        PG8_WAIT_V(2); PG8_BAR;
        PG8_STAGE(PG8_SB(1, 0), cB + kstep, voffB); PG8_STAGE(PG8_SA(1, 0), cA + kstep, voffA); PG8_STAGE(PG8_SB(1, 1), cB + hB + kstep, voffB);
        PG8_WAIT_V(6); PG8_BAR;
    } else {
        PG8_STAGE(PG8_SB(0, 0), cB, voffB); PG8_STAGE(PG8_SA(0, 0), cA, voffA); PG8_STAGE(PG8_SB(0, 1), cB + hB, voffB); PG8_STAGE(PG8_SA(0, 1), cA + hA, voffA);
        if (wr == 1) PG8_BAR;
        PG8_WAIT_V(4); PG8_BAR;
        PG8_STAGE(PG8_SB(1, 0), cB + kstep, voffB); PG8_STAGE(PG8_SA(1, 0), cA + kstep, voffA); PG8_STAGE(PG8_SB(1, 1), cB + hB + kstep, voffB);
        PG8_WAIT_V(6); PG8_BAR;
    }
    for (;;) {
        const bool has_next = S.next(ui + 1, nxt);
        const char* nA = has_next ? (const char*)g.A + (size_t)nxt.pm * tA + S.a_off(nxt) : cA; const char* nB = has_next ? (const char*)g.Bt + (size_t)S.b_tile(nxt) * tB + S.b_off(nxt) : cB;
        for (int t = 0; t < nt; t += 2) {
            const bool last = (t == nt - 2);
            const char* a1 = cA + (size_t)(t + 1) * kstep;
            const char* a2 = last ? nA : cA + (size_t)(t + 2) * kstep; const char* b2 = last ? nB : cB + (size_t)(t + 2) * kstep;
            const char* a3 = a2 + kstep; const char* b3 = b2 + kstep;
            if (last && has_next) S.a_ready(nxt);
            if constexpr (SP2) {
            PG8_LDB(B0, 0, 0); PG8_LDB(B1, 0, 1); PG8_SCHED; PG8_LDA(At, 0, 0); PG8_STAGE(PG8_SA(1, 1), a1 + hA, voffA);
            PG8_WAIT_V(8); PG8_WAIT_L(0); PG8_BAR; PG8_MMA(0, 0, At, B0); PG8_MMA(0, 1, At, B1); PG8_BAR; PG8_SCHED;
            PG8_LDA(At, 0, 1); PG8_STAGE(PG8_SB(0, 0), b2, voffB); PG8_STAGE(PG8_SB(0, 1), b2 + hB, voffB); PG8_STAGE(PG8_SA(0, 0), a2, voffA);
            PG8_WAIT_V(8); PG8_WAIT_L(0); PG8_BAR; PG8_MMA(1, 0, At, B0); PG8_MMA(1, 1, At, B1); PG8_BAR; PG8_SCHED;
            PG8_LDB(B0, 1, 0); PG8_LDB(B1, 1, 1); PG8_SCHED; PG8_LDA(At, 1, 0); PG8_STAGE(PG8_SA(0, 1), a2 + hA, voffA);
            PG8_WAIT_V(8); PG8_WAIT_L(0); PG8_BAR; PG8_MMA(0, 0, At, B0); PG8_MMA(0, 1, At, B1); PG8_BAR; PG8_SCHED;
            PG8_LDA(At, 1, 1); PG8_STAGE(PG8_SB(1, 0), b3, voffB); PG8_STAGE(PG8_SB(1, 1), b3 + hB, voffB); PG8_STAGE(PG8_SA(1, 0), a3, voffA);
            PG8_WAIT_V(8); PG8_WAIT_L(0); PG8_BAR; PG8_MMA(1, 0, At, B0); PG8_MMA(1, 1, At, B1); PG8_BAR; PG8_SCHED;
            } else {
            PG8_LDB(B0, 0, 0); PG8_SCHED; PG8_LDA(At, 0, 0); PG8_STAGE(PG8_SA(1, 1), a1 + hA, voffA);
            PG8_WAIT_L(8); PG8_BAR; PG8_WAIT_L(0); PG8_MMA(0, 0, At, B0); PG8_BAR; PG8_SCHED;
            PG8_LDB(B1, 0, 1); PG8_STAGE(PG8_SB(0, 0), b2, voffB);
            PG8_BAR; PG8_WAIT_L(0); PG8_MMA(0, 1, At, B1); PG8_BAR;
            PG8_LDA(At, 0, 1); PG8_STAGE(PG8_SA(0, 0), a2, voffA);
            PG8_BAR; PG8_WAIT_L(0); PG8_MMA(1, 0, At, B0); PG8_BAR; PG8_SCHED;
            PG8_STAGE(PG8_SB(0, 1), b2 + hB, voffB);
            PG8_WAIT_V(6); PG8_BAR; PG8_MMA(1, 1, At, B1); PG8_BAR;
            PG8_LDB(B0, 1, 0); PG8_SCHED; PG8_LDA(At, 1, 0); PG8_STAGE(PG8_SA(0, 1), a2 + hA, voffA);
            PG8_WAIT_L(8); PG8_BAR; PG8_WAIT_L(0); PG8_MMA(0, 0, At, B0); PG8_BAR; PG8_SCHED;
            PG8_LDB(B1, 1, 1); PG8_STAGE(PG8_SB(1, 0), b3, voffB);
            PG8_BAR; PG8_WAIT_L(0); PG8_MMA(0, 1, At, B1); PG8_BAR;
            PG8_LDA(At, 1, 1); PG8_STAGE(PG8_SA(1, 0), a3, voffA);
            PG8_BAR; PG8_WAIT_L(0); PG8_MMA(1, 0, At, B0); PG8_BAR; PG8_SCHED;
            PG8_STAGE(PG8_SB(1, 1), b3 + hB, voffB);
            PG8_WAIT_V(6); PG8_BAR; PG8_MMA(1, 1, At, B1); PG8_BAR;
            }
        }
        if constexpr (ALIGN_EPI) { if (wr == 0) PG8_BAR; }
        if constexpr (!Epi::AFTER_DRAIN) { E(acc, cur, wr, wc, fr, fq); S.done(cur); }
        if (!has_next) break;
#pragma unroll
        for (int a = 0; a < 2; ++a)
#pragma unroll
            for (int b = 0; b < 2; ++b)
#pragma unroll
                for (int m = 0; m < 4; ++m)
#pragma unroll
                    for (int n = 0; n < 2; ++n) acc[a][b][m][n] = (f32x4){0.f, 0.f, 0.f, 0.f};
        cur = nxt; cA = nA; cB = nB; ++ui;
        if constexpr (ALIGN_EPI) { if (wr == 1) PG8_BAR; }
    }
    PG8_WAIT_V(0);
    if constexpr (!ALIGN_EPI) { if (wr == 0) PG8_BAR; }
    PG8_BAR;
    if constexpr (Epi::AFTER_DRAIN) { E.fused(acc, cur, wr, wc, fr, fq, lds, wid, lane); S.done(cur); }
#undef PG8_SA
#undef PG8_SB
#undef PG8_STAGE
#undef PG8_LDA
#undef PG8_LDB
#undef PG8_MMA
#undef PG8_WAIT_V
#undef PG8_WAIT_L
#undef PG8_BAR
#undef PG8_SCHED
}
}
#include <hip/hip_bf16.h>
#include <cmath>
namespace attn_body {
using bf16=__hip_bfloat16;
using bf16x8=__attribute__((ext_vector_type(8)))short;
using s16x4=__attribute__((ext_vector_type(4)))short;
using f32x16=__attribute__((ext_vector_type(16)))float;
using u32x4=__attribute__((ext_vector_type(4)))unsigned;
constexpr int SEQ=8192,D=64,DM=14592,DO=1024;
constexpr int NW=8,QBLK=32,QB=QBLK*NW,KVBLK=64,NQB=SEQ/QB;
constexpr int ATTN_UNIT_ROWS=QB;
__device__ __forceinline__ int crow(int r,int hi){return (r&3)+8*(r>>2)+4*hi;}
#define SBAR() __builtin_amdgcn_sched_barrier(0)
__device__ __forceinline__ void cmask(f32x16&p0,f32x16&p1,int jb,int qrel,int hi){
  const float NEG=-INFINITY; int kb=64*jb+4*hi;
  #pragma unroll
  for(int r=0;r<16;++r){int kv=kb+(r&3)+8*(r>>2); if(kv>qrel)p0[r]=NEG; if(kv+32>qrel)p1[r]=NEG;}
}

constexpr int NSLOT=3, SLOTB=8192;
constexpr int LDS_K=0, LDS_V=NSLOT*SLOTB, LDS_WS=2*NSLOT*SLOTB, LDS_OST=LDS_WS+NW*64*4, LDS_BYTES=LDS_OST+NW*4096;
constexpr float C2=0.125f*1.4426950408889634f;
__device__ __forceinline__ void glds16(const void*sbase,unsigned voff,unsigned lds_dst){unsigned keep;
  asm volatile("s_mov_b32 %0, m0\n\ts_mov_b32 m0, %3\n\ts_nop 0\n\tglobal_load_lds_dwordx4 %1, %2\n\ts_mov_b32 m0, %0":"=&s"(keep):"v"(voff),"s"(sbase),"s"(lds_dst):"memory");}
__device__ __forceinline__ float max3f(float a,float b,float c){float r;asm("v_max3_f32 %0, %1, %2, %3":"=v"(r):"v"(a),"v"(b),"v"(c));return r;}
__device__ __forceinline__ float max2f(float a,float b){float r;asm("v_max_f32_e32 %0, %1, %2":"=v"(r):"v"(a),"v"(b));return r;}
__device__ __forceinline__ float fadd_s(float a,float b){float r;asm("v_add_f32_e32 %0, %1, %2":"=v"(r):"v"(a),"v"(b));return r;}
__device__ __forceinline__ float fsub_s(float a,float b){float r;asm("v_sub_f32_e32 %0, %1, %2":"=v"(r):"v"(a),"v"(b));return r;}
typedef float f32x2_t __attribute__((ext_vector_type(2))); typedef __bf16 bf16x2_t __attribute__((ext_vector_type(2)));
__device__ __forceinline__ unsigned cvtpk_s(float lo,float hi){f32x2_t v={lo,hi};bf16x2_t b=__builtin_convertvector(v,bf16x2_t);return __builtin_bit_cast(unsigned,b);}
#define WAIT_BAR(N) asm volatile("s_waitcnt vmcnt(" #N ") lgkmcnt(0)\n\ts_barrier":::"memory")

__device__ __forceinline__ void qkt(f32x16&p0,f32x16&p1,const char*Kslot,const bf16x8*qr,const f32x16&negm,int r32,int hi){
  const char*kb=Kslot+hi*1024+r32*16;
  #pragma unroll
  for(int d0=0;d0<4;++d0){
    const bf16x8 b0=*reinterpret_cast<const bf16x8*>(kb+d0*2048);
    const bf16x8 b1=*reinterpret_cast<const bf16x8*>(kb+d0*2048+512);
    if(d0==0){p0=__builtin_amdgcn_mfma_f32_32x32x16_bf16(b0,qr[0],negm,0,0,0);p1=__builtin_amdgcn_mfma_f32_32x32x16_bf16(b1,qr[0],negm,0,0,0);}
    else{p0=__builtin_amdgcn_mfma_f32_32x32x16_bf16(b0,qr[d0],p0,0,0,0);p1=__builtin_amdgcn_mfma_f32_32x32x16_bf16(b1,qr[d0],p1,0,0,0);}}
}
typedef __attribute__((address_space(3))) const char* lds_cptr;
typedef short v4i16_t __attribute__((ext_vector_type(4)));
__device__ __forceinline__ void kload8(bf16x8*kf,lds_cptr kp){
  kf[0]=*(const __attribute__((address_space(3))) bf16x8*)(kp);      kf[1]=*(const __attribute__((address_space(3))) bf16x8*)(kp+512);
  kf[2]=*(const __attribute__((address_space(3))) bf16x8*)(kp+2048); kf[3]=*(const __attribute__((address_space(3))) bf16x8*)(kp+2560);
  kf[4]=*(const __attribute__((address_space(3))) bf16x8*)(kp+4096); kf[5]=*(const __attribute__((address_space(3))) bf16x8*)(kp+4608);
  kf[6]=*(const __attribute__((address_space(3))) bf16x8*)(kp+6144); kf[7]=*(const __attribute__((address_space(3))) bf16x8*)(kp+6656);
}
__device__ __forceinline__ void kload2(bf16x8*kf,lds_cptr kp,int j){ kf[2*j]=*(const __attribute__((address_space(3))) bf16x8*)(kp+j*2048); kf[2*j+1]=*(const __attribute__((address_space(3))) bf16x8*)(kp+j*2048+512); }
__device__ __forceinline__ s16x4 vtr(lds_cptr p){ return __builtin_bit_cast(s16x4,__builtin_amdgcn_ds_read_tr16_b64_v4i16((__attribute__((address_space(3))) v4i16_t*)p)); }
__device__ __forceinline__ float rowmax(const f32x16&p0,const f32x16&p1){
  float a=max3f(p0[0],p0[1],p1[0]),b=max3f(p0[2],p0[3],p1[1]);a=max3f(a,p1[2],p1[3]);
  #pragma unroll
  for(int r=4;r<16;r+=4){a=max3f(a,p0[r],p0[r+1]);b=max3f(b,p0[r+2],p0[r+3]);a=max3f(a,p1[r],p1[r+1]);b=max3f(b,p1[r+2],p1[r+3]);}
  const float m=max2f(a,b);
  auto rr=__builtin_amdgcn_permlane32_swap(__float_as_uint(m),__float_as_uint(m),false,false);
  return max2f(__uint_as_float(rr[0]),__uint_as_float(rr[1]));
}
__device__ __forceinline__ void pv(f32x16*o,int vb,bf16x8 pa0,bf16x8 pa1,bf16x8 pa2,bf16x8 pa3){
  #pragma unroll
  for(int d0=0;d0<2;++d0){s16x4 lo[4],hi[4];
    #pragma unroll
    for(int ks=0;ks<4;++ks){
      asm volatile("ds_read_b64_tr_b16 %0,%1 offset:%c2":"=&v"(lo[ks]):"v"(vb),"i"(d0*4096+ks*1024):"memory");
      asm volatile("ds_read_b64_tr_b16 %0,%1 offset:%c2":"=&v"(hi[ks]):"v"(vb),"i"(d0*4096+ks*1024+512):"memory");}
    asm volatile("s_waitcnt lgkmcnt(0)":::"memory");SBAR();
    #define PK(k) (bf16x8){lo[k][0],lo[k][1],lo[k][2],lo[k][3],hi[k][0],hi[k][1],hi[k][2],hi[k][3]}
    o[d0]=__builtin_amdgcn_mfma_f32_32x32x16_bf16(pa0,PK(0),o[d0],0,0,0);
    o[d0]=__builtin_amdgcn_mfma_f32_32x32x16_bf16(pa1,PK(1),o[d0],0,0,0);
    o[d0]=__builtin_amdgcn_mfma_f32_32x32x16_bf16(pa2,PK(2),o[d0],0,0,0);
    o[d0]=__builtin_amdgcn_mfma_f32_32x32x16_bf16(pa3,PK(3),o[d0],0,0,0);
    #undef PK
  }
}

#ifndef ATTN_STORE16
#define ATTN_STORE16(p,v) (*(u32x4*)(p)=(v))
#endif
template<int THRL> __device__ __forceinline__ void attn_unit(int qc,int kc,int vc,int oc,int qb,const bf16*Q,const bf16*__restrict__ K,const bf16*__restrict__ V,bf16*O,char*shm,const int tid){
  const int lane=tid&63,r32=lane&31,hi=lane>>5; const int wid=__builtin_amdgcn_readfirstlane(tid>>6);
  const long rowbase=0; const int q0=qb*QB;
  const bf16*Qw=Q+(rowbase+q0+wid*QBLK)*DM+qc;
  const bf16*Kh=K+rowbase*DM+kc,*Vh=V+rowbase*DM+vc;
  const unsigned lds0=(unsigned)(uintptr_t)shm;
  float*wsf=(float*)(shm+LDS_WS)+wid*64;
  const unsigned koff=(unsigned)(lane*DM+wid*8)*2u;
  const unsigned voff=(unsigned)((16*(wid&3)+(lane>>2))*DM+(wid>>2)*32+(lane&3)*8)*2u;
  const unsigned kdst=lds0+LDS_K+wid*1024, vdst=lds0+LDS_V+wid*1024;
  #define DMA_K(t,slot) glds16((const char*)Kh+(size_t)(t)*(KVBLK*DM*2),koff,(unsigned)__builtin_amdgcn_readfirstlane(kdst+(slot)))
  #define DMA_V(t,slot) glds16((const char*)Vh+(size_t)(t)*(KVBLK*DM*2),voff,(unsigned)__builtin_amdgcn_readfirstlane(vdst+(slot)))
  const int vb0=(int)(lds0+LDS_V)+((lane>>4)&1)*32+(lane&3)*8+(4*hi+((lane&15)>>2))*64;
  const char*Kbase=shm+LDS_K; bf16x8 kf[8];
  const lds_cptr shm3=(lds_cptr)shm; const lds_cptr kp0=shm3+LDS_K+hi*1024+r32*16; const lds_cptr vp0=shm3+LDS_V+((lane>>4)&1)*32+(lane&3)*8+(4*hi+((lane&15)>>2))*64;
  const int NT=(q0+QB)/KVBLK;
  DMA_K(0,0);DMA_V(0,0);DMA_K(1,SLOTB);
  bf16x8 qr[4];
  #pragma unroll
  for(int d0=0;d0<4;++d0)qr[d0]=*reinterpret_cast<const bf16x8*>(&Qw[(long)r32*DM+d0*16+hi*8]);
  float mhat=0.f,l_reg=0.f;f32x16 o[2];o[0]=f32x16{};o[1]=f32x16{};f32x16 negm=f32x16{};asm volatile("":"+v"(negm));
  const int qrel=wid*QBLK+r32;
  #define CMASK(P0,P1,t) do{int jb_=(t)-(NT-4); if(jb_>=0)cmask(P0,P1,jb_,qrel,hi);}while(0)
  bool resc=false;
  #define START(P0,P1) do{ const float rm=rowmax(P0,P1); resc=false; \
    { const float dl=rm; mhat=fadd_s(mhat,dl); \
      _Pragma("unroll") for(int r=0;r<16;++r){P0[r]=fsub_s(P0[r],dl);P1[r]=fsub_s(P1[r],dl);} \
      _Pragma("unroll") for(int r=0;r<16;++r)negm[r]=-mhat; asm volatile("":"+v"(negm)); } \
    _Pragma("unroll") for(int r=0;r<16;++r)P0[r]=__builtin_amdgcn_exp2f(P0[r]); }while(0)
  #define RESC() do{ if(resc){ asm volatile("s_waitcnt lgkmcnt(0)":::"memory"); \
      _Pragma("unroll") for(int d_=0;d_<2;++d_) _Pragma("unroll") for(int r=0;r<16;++r)o[d_][r]*=wsf[crow(r,hi)]; } }while(0)
  f32x16 pA0,pA1,pB0,pB1;
  int sl_prev=0,sl_cur=0,sl_next=SLOTB;
  #define ROT() do{sl_prev=sl_cur;sl_cur=sl_next;sl_next=(sl_next==(NSLOT-1)*SLOTB)?0:sl_next+SLOTB;}while(0)
  DMA_K(2,2*SLOTB);
  WAIT_BAR(3);
  qkt(pA0,pA1,Kbase,qr,negm,r32,hi);asm volatile("s_nop 15\n\ts_nop 7":"+v"(pA0),"+v"(pA1));CMASK(pA0,pA1,0);
  START(pA0,pA1);
  _Pragma("unroll") for(int r=0;r<16;++r)pA1[r]=__builtin_amdgcn_exp2f(pA1[r]);
  WAIT_BAR(0);
  DMA_K(3,0);DMA_V(1,SLOTB);
  ROT();
  kload8(kf,kp0+sl_cur);
  WAIT_BAR(2);
  s16x4 vlo[8],vhi[8]; u32x4 pw0,pw1,pw2,pw3;
  #define PKW(P,B) cvtpk_s(P[B],P[B+1])
  #define PAF(k) __builtin_bit_cast(bf16x8,pw##k)
  #define VFR(i) (bf16x8){vlo[i][0],vlo[i][1],vlo[i][2],vlo[i][3],vhi[i][0],vhi[i][1],vhi[i][2],vhi[i][3]}
  #define PIN(x) asm volatile("":"+v"(x))
  #define MX3(a,b,c) __builtin_fmaxf(__builtin_fmaxf((a),(b)),(c))
  #define GAPA(MF,A0,A1,A2,A3,W0,W1,PW) do{ MF; sacc+=A0; sacc+=A1; sacc+=A2; sacc+=A3; PIN(sacc); W0; W1; PIN(PW); SBAR(); }while(0)
  #define EX(v) __builtin_amdgcn_exp2f(v)
  #define GAPB(MF,X,B) do{ MF; X[B]=EX(X[B]); X[B+1]=EX(X[B+1]); X[B+2]=EX(X[B+2]); X[B+3]=EX(X[B+3]); PIN(X); SBAR(); }while(0)
  #define VRD(i) do{ vlo[i]=vtr(vp_+(((i)>>2)*4096+((i)&3)*1024)); vhi[i]=vtr(vp_+(((i)>>2)*4096+((i)&3)*1024+512)); }while(0)
  #define KRD(G,j) do{ if(G){ kload2(kf,kp0+sl_next,j); SBAR(); } }while(0)
  #define STEP(C0,C1,P0,P1,t,GK,GV,GL) do{ SBAR(); \
    const lds_cptr vp_=vp0+sl_prev; \
    VRD(0); SBAR(); float sacc=(P0[0]+P0[1]); \
    GAPA(C0=__builtin_amdgcn_mfma_f32_32x32x16_bf16(kf[0],qr[0],negm,0,0,0), P0[2],P0[3],P0[4],P0[5],     pw0[0]=PKW(P0,0), pw0[1]=PKW(P0,2), pw0); \
    VRD(4); SBAR(); GAPA(C1=__builtin_amdgcn_mfma_f32_32x32x16_bf16(kf[1],qr[0],negm,0,0,0), P0[6],P0[7],P0[8],P0[9],     pw0[2]=PKW(P0,4), pw0[3]=PKW(P0,6), pw0); \
    VRD(1); SBAR(); GAPA(C0=__builtin_amdgcn_mfma_f32_32x32x16_bf16(kf[2],qr[1],C0,0,0,0),   P0[10],P0[11],P0[12],P0[13], pw1[0]=PKW(P0,8), pw1[1]=PKW(P0,10), pw1); \
    VRD(5); SBAR(); GAPA(C1=__builtin_amdgcn_mfma_f32_32x32x16_bf16(kf[3],qr[1],C1,0,0,0),   P0[14],P0[15],P1[0],P1[1],   pw1[2]=PKW(P0,12),pw1[3]=PKW(P0,14), pw1); \
    VRD(2); SBAR(); GAPA(C0=__builtin_amdgcn_mfma_f32_32x32x16_bf16(kf[4],qr[2],C0,0,0,0),   P1[2],P1[3],P1[4],P1[5],     pw2[0]=PKW(P1,0), pw2[1]=PKW(P1,2), pw2); \
    VRD(6); SBAR(); GAPA(C1=__builtin_amdgcn_mfma_f32_32x32x16_bf16(kf[5],qr[2],C1,0,0,0),   P1[6],P1[7],P1[8],P1[9],     pw2[2]=PKW(P1,4), pw2[3]=PKW(P1,6), pw2); \
    VRD(3); SBAR(); GAPA(C0=__builtin_amdgcn_mfma_f32_32x32x16_bf16(kf[6],qr[3],C0,0,0,0),   P1[10],P1[11],P1[12],P1[13], pw3[0]=PKW(P1,8), pw3[1]=PKW(P1,10), pw3); \
    VRD(7); SBAR(); GAPA(C1=__builtin_amdgcn_mfma_f32_32x32x16_bf16(kf[7],qr[3],C1,0,0,0),   P1[14],P1[15],0.f,0.f,       pw3[2]=PKW(P1,12),pw3[3]=PKW(P1,14), pw3); \
    l_reg+=sacc; \
    if(GK){DMA_K((t)+3,sl_cur);} if(GV){DMA_V((t)+1,sl_next);} \
    CMASK(C0,C1,t); \
    { float a=MX3(C0[0],C0[1],C1[0]),b=MX3(C0[2],C0[3],C1[1]); a=MX3(a,C1[2],C1[3]); \
      _Pragma("unroll") for(int r=4;r<16;r+=4){a=MX3(a,C0[r],C0[r+1]);b=MX3(b,C0[r+2],C0[r+3]);a=MX3(a,C1[r],C1[r+1]);b=MX3(b,C1[r+2],C1[r+3]);} \
      float rm=__builtin_fmaxf(a,b); { auto rr=__builtin_amdgcn_permlane32_swap(__float_as_uint(rm),__float_as_uint(rm),false,false); rm=__builtin_fmaxf(__uint_as_float(rr[0]),__uint_as_float(rr[1])); } \
      resc=false; \
      if(__builtin_expect(__any(rm>(float)THRL),0)){ const float dl=__builtin_fmaxf(rm,0.f); mhat+=dl; \
        _Pragma("unroll") for(int r=0;r<16;++r){C0[r]-=dl;C1[r]-=dl;} \
        _Pragma("unroll") for(int r=0;r<16;++r)negm[r]=-mhat; asm volatile("":"+v"(negm)); \
        const float f=__builtin_amdgcn_exp2f(-dl); l_reg*=f; if(hi==0)wsf[r32]=f; resc=true; } } \
    SBAR(); \
    GAPB(o[0]=__builtin_amdgcn_mfma_f32_32x32x16_bf16(PAF(0),VFR(0),o[0],0,0,0), C0,0); \
    GAPB(o[1]=__builtin_amdgcn_mfma_f32_32x32x16_bf16(PAF(0),VFR(4),o[1],0,0,0), C0,4); \
    KRD(GL,0); GAPB(o[0]=__builtin_amdgcn_mfma_f32_32x32x16_bf16(PAF(1),VFR(1),o[0],0,0,0), C0,8); \
    KRD(GL,1); GAPB(o[1]=__builtin_amdgcn_mfma_f32_32x32x16_bf16(PAF(1),VFR(5),o[1],0,0,0), C0,12); \
    KRD(GL,2); GAPB(o[0]=__builtin_amdgcn_mfma_f32_32x32x16_bf16(PAF(2),VFR(2),o[0],0,0,0), C1,0); \
    KRD(GL,3); GAPB(o[1]=__builtin_amdgcn_mfma_f32_32x32x16_bf16(PAF(2),VFR(6),o[1],0,0,0), C1,4); \
    GAPB(o[0]=__builtin_amdgcn_mfma_f32_32x32x16_bf16(PAF(3),VFR(3),o[0],0,0,0), C1,8); \
    GAPB(o[1]=__builtin_amdgcn_mfma_f32_32x32x16_bf16(PAF(3),VFR(7),o[1],0,0,0), C1,12); \
    }while(0)
  int t=1;
  #undef CMASK
  #define CMASK(P0,P1,t) do{}while(0)
  for(;t+5<NT;t+=2){
    STEP(pB0,pB1,pA0,pA1,t,true,true,true);     WAIT_BAR(2); RESC(); ROT();
    STEP(pA0,pA1,pB0,pB1,t+1,true,true,true);   WAIT_BAR(2); RESC(); ROT();
  }
  #undef CMASK
  #define CMASK(P0,P1,t) do{int jb_=(t)-(NT-4); if(jb_>=0)cmask(P0,P1,jb_,qrel,hi);}while(0)
  #define ENDW(tt) do{ if((tt)+3<NT){WAIT_BAR(2);} else if((tt)+2<NT){WAIT_BAR(1);} else {WAIT_BAR(0);} }while(0)
  for(;t+1<NT;t+=2){
    STEP(pB0,pB1,pA0,pA1,t,(t+3<NT),(t+1<NT),(t+1<NT));       ENDW(t);   RESC(); ROT();
    STEP(pA0,pA1,pB0,pB1,t+1,(t+4<NT),(t+2<NT),(t+2<NT));     ENDW(t+1); RESC(); ROT();
  }
  STEP(pB0,pB1,pA0,pA1,NT-1,false,false,false); RESC();
  { float sacc=pB0[0]+pB0[1]; _Pragma("unroll") for(int r=2;r<16;++r)sacc+=pB0[r]; _Pragma("unroll") for(int r=0;r<16;++r)sacc+=pB1[r]; l_reg+=sacc;
    pw0=(u32x4){PKW(pB0,0),PKW(pB0,2),PKW(pB0,4),PKW(pB0,6)};pw1=(u32x4){PKW(pB0,8),PKW(pB0,10),PKW(pB0,12),PKW(pB0,14)};pw2=(u32x4){PKW(pB1,0),PKW(pB1,2),PKW(pB1,4),PKW(pB1,6)};pw3=(u32x4){PKW(pB1,8),PKW(pB1,10),PKW(pB1,12),PKW(pB1,14)};
    SBAR(); pv(o,vb0+sl_cur,PAF(0),PAF(1),PAF(2),PAF(3)); }
  #undef PKW
  #undef PAF
  #undef VFR
  #undef PIN
  #undef MX3
  #undef GAPA
  #undef GAPB
  #undef EX
  #undef VRD
  #undef KRD
  #undef STEP
  #undef ENDW
  {auto rr=__builtin_amdgcn_permlane32_swap(__float_as_uint(l_reg),__float_as_uint(l_reg),false,false);l_reg=__uint_as_float(rr[0])+__uint_as_float(rr[1]);}
  if(hi==0)wsf[32+r32]=l_reg;asm volatile("s_waitcnt lgkmcnt(0)":::"memory");
  float rli[16];
  #pragma unroll
  for(int r=0;r<16;++r)rli[r]=__builtin_amdgcn_rcpf(wsf[32+crow(r,hi)]);
  bf16*Ow=O+(rowbase+q0+wid*QBLK)*DO+oc;
  { bf16*stg=(bf16*)(shm+LDS_OST)+wid*2048;
    #pragma unroll
    for(int r=0;r<16;++r){const int orow=crow(r,hi);
      #pragma unroll
      for(int d0=0;d0<2;++d0)stg[orow*64+d0*32+r32]=__float2bfloat16(o[d0][r]*rli[r]);}
    asm volatile("s_waitcnt lgkmcnt(0)":::"memory");
    #pragma unroll
    for(int i=0;i<4;++i){const int row=i*8+(lane>>3),ch=lane&7; const u32x4 v=*(const u32x4*)(stg+row*64+ch*8); ATTN_STORE16(Ow+(long)row*DO+ch*8,v);} }
  asm volatile("s_waitcnt lgkmcnt(0)\n\ts_barrier":::"memory");
  #undef DMA_K
  #undef DMA_V
  #undef CMASK
  #undef START
  #undef RESC
  #undef ROT
}
constexpr int ATTN_LDS_BYTES=LDS_BYTES;
struct AttnTensors { const bf16* Q; const bf16* K; const bf16* V; bf16* O0; bf16* O1; };
struct AttnUnit { int bh; int qb; };
struct StaticOrder {
  int vcu;
  __device__ __forceinline__ explicit StaticOrder(int grid_,int block):vcu((grid_%8==0)?(block%8)*(grid_/8)+block/8:block),grid(grid_){}
  int grid;
  __device__ __forceinline__ bool next(int i,AttnUnit&u)const{ const int v=vcu+(i>>2)*grid; if(v>=256)return false; const int s=v&7,j=i&3; u.bh=v>>3; u.qb=(j==0)?s:(j==1)?15-s:(j==2)?16+s:31-s; return true; }
  __device__ __forceinline__ void a_ready(const AttnUnit&)const{}
  __device__ __forceinline__ void done(const AttnUnit&)const{}
};
template<class Sched,int THRL=8> __device__ __forceinline__ void attn_phase(char*lds,const AttnTensors&T,const Sched&S,const int tid){
  AttnUnit u;
  for(int i=0;S.next(i,u);++i){ S.a_ready(u); const int h=u.bh>>2,m=(u.bh>>1)&1,vh=u.bh&1; attn_unit<THRL>((2*h+m)*64,1024+(2*h+m)*64,2048+h*128+vh*64,h*128+vh*64,u.qb,T.Q,T.K,T.V,m?T.O1:T.O0,lds,tid); S.done(u); }
}
#undef SBAR
#undef WAIT_BAR
}
#define GAS __attribute__((address_space(1)))
#define LAS __attribute__((address_space(3)))
typedef unsigned short bf16;
typedef unsigned v4u __attribute__((ext_vector_type(4)));
typedef float f32x4 __attribute__((ext_vector_type(4)));
typedef short bf16x8 __attribute__((ext_vector_type(8)));
typedef GAS unsigned gu32;
typedef GAS unsigned long long gu64;
#define RLX_AGENT __ATOMIC_RELAXED, __HIP_MEMORY_SCOPE_AGENT
#define LDS_WAIT() asm volatile("s_waitcnt lgkmcnt(0)" ::: "memory")
#define VM_WAIT() asm volatile("s_waitcnt vmcnt(0)" ::: "memory")
__device__ __forceinline__ unsigned long long rt() { return __builtin_amdgcn_s_memrealtime(); }
typedef float pk_f32x2_t __attribute__((ext_vector_type(2))); typedef __bf16 pk_bf16x2_t __attribute__((ext_vector_type(2)));
__device__ __forceinline__ unsigned pk2(float lo, float hi) { const pk_f32x2_t v = {lo, hi}; return __builtin_bit_cast(unsigned, __builtin_convertvector(v, pk_bf16x2_t)); }
__device__ __forceinline__ unsigned f2bf(float f) { return pk2(f, 0.f) & 0xffffu; }

#define XB_TMO      128
#define XB_XCNT(j)  (256  + 64 * (j))
#define XB_XSUB(j)  (1280 + 64 * (j))
#define XB_XGEN(j)  (2304 + 64 * (j))
#define XB_TOP      3328
#define XB_TOPGEN   3392
#define XCD_BAR_WORDS 3456
#define XB_SPIN_CAP (1u << 18)

__device__ __forceinline__ unsigned xb_ld(unsigned* p)              { return __hip_atomic_load(p, __ATOMIC_RELAXED, __HIP_MEMORY_SCOPE_AGENT); }
__device__ __forceinline__ unsigned xb_add(unsigned* p, unsigned v) { return __hip_atomic_fetch_add(p, v, __ATOMIC_RELAXED, __HIP_MEMORY_SCOPE_AGENT); }
__device__ __forceinline__ unsigned xb_xcc_id() { return (unsigned)__builtin_amdgcn_s_getreg((3 << 11) | 20) & 0xFu; }
#define XB_SPIN(cond, bar) do { unsigned _sp = 0; while (cond) { __builtin_amdgcn_s_sleep(1); \
    if ((++_sp & 255u) == 0u) { if (xb_ld(&(bar)[XB_TMO])) break; if (_sp > XB_SPIN_CAP) { atomicAdd(&(bar)[XB_TMO], 1u); break; } } } } while (0)

struct XcdBarrier {
    unsigned* bar; unsigned x;
    volatile LAS unsigned* st;
};

__device__ __forceinline__ XcdBarrier xcd_barrier_post(unsigned* bar, volatile LAS unsigned* st) {
    XcdBarrier b; b.bar = bar; b.x = xb_xcc_id(); b.st = st;
    if (threadIdx.x == 0) (void)xb_add(&bar[XB_XCNT(b.x)], 1u);
    return b;
}
__device__ __forceinline__ void xcd_barrier_complete(unsigned* bar, unsigned x, unsigned& nloc, unsigned& nx) {
    const unsigned G = gridDim.x * gridDim.y * gridDim.z;
    unsigned sum, cnt, mine, sp = 0u;
    for (;;) {
        sum = 0u; cnt = 0u; mine = 0u;
#pragma unroll
        for (unsigned j = 0; j < 16; ++j) { const unsigned c = xb_ld(&bar[XB_XCNT(j)]); sum += c; cnt += (c > 0u) ? 1u : 0u; mine = (j == x) ? c : mine; }
        if (sum == G) break;
        __builtin_amdgcn_s_sleep(1);
        if ((++sp & 255u) == 0u) { if (xb_ld(&bar[XB_TMO])) break; if (sp > XB_SPIN_CAP) { atomicAdd(&bar[XB_TMO], 1u); break; } }
    }
    nloc = mine > 0u ? mine : 1u; nx = cnt > 0u ? cnt : 1u;
}

__device__ __forceinline__ void xcd_barrier(const XcdBarrier& b, const bool leader_thread) {
    asm volatile("s_waitcnt vmcnt(0)" ::: "memory");
    __syncthreads();
    if (leader_thread) {
        unsigned* bar = b.bar;
        __builtin_amdgcn_s_waitcnt(0);
        unsigned nloc = b.st[0], nx = b.st[1];
        if (nloc == 0u) { xcd_barrier_complete(bar, b.x, nloc, nx); b.st[0] = nloc; b.st[1] = nx; }
        const unsigned old = xb_add(&bar[XB_XSUB(b.x)], 1u);
        const unsigned gen = old / nloc;
        if (old + 1u == (gen + 1u) * nloc) {
            __builtin_amdgcn_fence(__ATOMIC_RELEASE, "agent");
            asm volatile("s_waitcnt vmcnt(0)" ::: "memory");
            const unsigned og = xb_add(&bar[XB_TOP], 1u);
            const unsigned tg = og / nx;
            if (og + 1u == (tg + 1u) * nx) xb_add(&bar[XB_TOPGEN], 1u);
            else XB_SPIN(xb_ld(&bar[XB_TOPGEN]) == tg, bar);
            __builtin_amdgcn_fence(__ATOMIC_ACQUIRE, "agent");
            xb_add(&bar[XB_XGEN(b.x)], 1u);
            asm volatile("s_waitcnt vmcnt(0)" ::: "memory");
        } else {
            XB_SPIN(xb_ld(&bar[XB_XGEN(b.x)]) == gen, bar);
            __builtin_amdgcn_fence(__ATOMIC_ACQUIRE, "agent");
            asm volatile("s_waitcnt vmcnt(0)" ::: "memory");
        }
    }
    __syncthreads();
}

constexpr int SEQ = 8192, DM = 4096, DIN = 13392, LDP = 14592, DFF = 16384, BW = 2048;
constexpr int C_QA = 0, C_KA = 1024, C_VA = 2048, C_RB = 3072, C_KB = 5120, C_VB = 7168, C_QC = 9216, C_KC = 10240, C_VC = 11264, C_QI = 12288, C_KI = 13312, C_WI = 13376;
constexpr int C_LWH = 13392, C_LWS = 13488, C_LAH = 13584, C_LAS = 13680, C_LGH = 13776, C_LGS = 14032, C_LVH = 14288, C_LVS = 14352;
constexpr float RMS_EPS = 1e-6f, GN_EPS = 64e-5f;
constexpr float QA_SCALE = 0.125f * 1.4426950408889634f;
constexpr float QC_SCALE = 0.08838834764831845f * 1.4426950408889634f;

enum { I_X = 0, I_NMG, I_WIN, I_LQ1, I_LK1, I_LQ2, I_LK2, I_SUBLN, I_MURKV, I_MUWAG, I_W0, I_W1, I_W2, I_A0, I_A1, I_A2, I_G1, I_G2, I_KK, I_KA, I_RK, I_LNW, I_LNB,
       I_VMU, I_V0, I_V1, I_V2, I_WOUT, I_NFG, I_WUP, I_WDN, I_NFIN, N_INPUTS };

constexpr size_t MiB = 1u << 20;
constexpr size_t WS_CTL = 0, CTL_ZERO_BYTES = 1 * MiB;
constexpr size_t SZ_WIN = (size_t)LDP * DM * 2, SZ_WOUT = (size_t)DM * DM * 2, SZ_WFF = (size_t)DFF * DM * 2, SZ_BT2 = (size_t)8192 * 256 * 2;
constexpr size_t WS_WIN = 2 * MiB;
constexpr size_t WS_WOUT = WS_WIN + SZ_WIN;
constexpr size_t WS_WUP = WS_WOUT + SZ_WOUT;
constexpr size_t WS_WDN = WS_WUP + SZ_WFF;
constexpr size_t WS_BT2 = WS_WDN + SZ_WFF;
constexpr size_t SZ_SB = (size_t)SEQ * BW * 4;
constexpr size_t WS_VF = WS_BT2 + SZ_BT2;
constexpr size_t WS_H = WS_VF + SZ_SB;
constexpr size_t WS_MIX = WS_H + (size_t)SEQ * DM * 2;
constexpr size_t WS_P = WS_MIX + (size_t)SEQ * DM * 2;
constexpr size_t WS_AP = WS_P + (size_t)SEQ * LDP * 2;
constexpr size_t WS_Z = WS_AP + (size_t)SEQ * 1024 * 2;
constexpr size_t WS_ZB = WS_Z + (size_t)SEQ * 2048 * 4;
constexpr size_t WS_U = WS_Z;
constexpr int SREC = 6 * 64 * 4;
constexpr size_t WS_XS = WS_Z + (size_t)SEQ * 8192 * 4;
constexpr size_t WS_BON = WS_XS + (size_t)32 * SEQ * SREC;
constexpr size_t WS_Y = WS_BON + (size_t)SEQ * 32 * 4;
constexpr size_t WS_O0 = WS_Y + SZ_SB, WS_O1 = WS_O0 + (size_t)SEQ * 1024 * 2;
constexpr size_t WS_SC = WS_O1 + (size_t)SEQ * 1024 * 2;
constexpr size_t WS_BM = WS_SC + (size_t)SEQ * SEQ * 4;
constexpr size_t WS_KF = WS_BM + (size_t)SEQ * 256 * 4;
constexpr size_t WS_VFR = WS_KF + (size_t)16 * MiB;
constexpr size_t WS_KIF = WS_VFR + (size_t)16 * MiB;
constexpr size_t WS_END = WS_KIF + (size_t)1 * MiB;
static_assert(WS_END <= 2040 * MiB && (size_t)SEQ * DFF * 2 <= (size_t)SEQ * 8192 * 4, "d_ws map must fit the 2 GiB workspace");
constexpr int CW_TMO = 0, CW_CODE = 1, CW_LAM = 16;
constexpr int CW_BAR = 4096;
constexpr int CW_RDY = 16384;
constexpr int CW_PREP = 32768;
constexpr int CW_SS = 65536;
constexpr int CW_AQ = 12288;
constexpr int CW_QUEUE = 8192;

constexpr int RING_OFF = 0, RING_BYTES = 131072;
constexpr int LDSCTL_OFF = RING_BYTES, MISC_OFF = LDSCTL_OFF + 320;
constexpr int LDS_BYTES = 147456;
constexpr int NWAVES = 8;

__device__ __forceinline__ float bf2f(unsigned short b) { return __uint_as_float(((unsigned)b) << 16); }
__device__ __forceinline__ float bflo(unsigned w) { return __uint_as_float(w << 16); }
__device__ __forceinline__ float bfhi(unsigned w) { return __uint_as_float(w & 0xffff0000u); }
#define DPPF(v, ctrl) __builtin_bit_cast(float, __builtin_amdgcn_update_dpp(0, __builtin_bit_cast(int, (v)), (ctrl), 0xF, 0xF, false))
#define DPPF_ROWS(old, v, ctrl, rows) __builtin_bit_cast(float, __builtin_amdgcn_update_dpp(__builtin_bit_cast(int, (old)), __builtin_bit_cast(int, (v)), (ctrl), (rows), 0xF, false))
__device__ __forceinline__ float dpp_sum16(float v) {
    v += DPPF(v, 0xB1);
    v += DPPF(v, 0x4E);
    v += DPPF(v, 0x141);
    v += DPPF(v, 0x140);
    return v;
}
__device__ __forceinline__ float dpp_max16(float v) {
    v = fmaxf(v, DPPF(v, 0xB1)); v = fmaxf(v, DPPF(v, 0x4E)); v = fmaxf(v, DPPF(v, 0x141)); v = fmaxf(v, DPPF(v, 0x140));
    return v;
}
__device__ __forceinline__ float wave_sum(float v) {
    v = dpp_sum16(v);
    v += DPPF_ROWS(0.f, v, 0x142, 0xA);
    v += DPPF_ROWS(0.f, v, 0x143, 0xC);
    return __builtin_bit_cast(float, __builtin_amdgcn_readlane(__builtin_bit_cast(int, v), 63));
}
__device__ __forceinline__ float wave_max(float v) {
    v = dpp_max16(v);
    v = fmaxf(v, DPPF_ROWS(v, v, 0x142, 0xA));
    v = fmaxf(v, DPPF_ROWS(v, v, 0x143, 0xC));
    return __builtin_bit_cast(float, __builtin_amdgcn_readlane(__builtin_bit_cast(int, v), 63));
}
__device__ __forceinline__ float swap32_sum(float v) {
    auto rr = __builtin_amdgcn_permlane32_swap(__float_as_uint(v), __float_as_uint(v), false, false);
    return __uint_as_float(rr[0]) + __uint_as_float(rr[1]);
}
__device__ __forceinline__ unsigned bperm_u32(unsigned v, int src_lane) { return (unsigned)__builtin_amdgcn_ds_bpermute(src_lane << 2, (int)v); }
__device__ __forceinline__ float sigmoidf_(float x) { return 1.0f / (1.0f + __expf(-x)); }

__device__ __forceinline__ void transpose_item(const float* W, int N, bf16* WT, int ldk, int row_off, const float* ks, int mode, LAS float* scr, int item, int lane) {
    const int nblk = (N + 31) >> 5, kb = item / nblk, nb = item - kb * nblk, k0 = 64 * kb, n0 = 32 * nb;
    const int n_r = n0 + (lane & 31);
#pragma unroll
    for (int i = 0; i < 32; ++i) { const int kk = 2 * i + (lane >> 5); float v = 0.f;
        if (n_r < N) v = W[(size_t)(k0 + kk) * N + n_r];
        scr[kk * 33 + (lane & 31)] = v; }
    LDS_WAIT(); asm volatile("" ::: "memory");
    const int c = lane & 7;
    float f[8];
#pragma unroll
    for (int j = 0; j < 8; ++j) f[j] = 1.f;
    if (mode) { const f32x4 fa = *(const GAS f32x4*)(ks + k0 + 8 * c), fb = *(const GAS f32x4*)(ks + k0 + 8 * c + 4);
#pragma unroll
        for (int j = 0; j < 4; ++j) { f[j] = (mode == 1) ? (1.f - fa[j]) : fa[j]; f[4 + j] = (mode == 1) ? (1.f - fb[j]) : fb[j]; } }
#pragma unroll
    for (int j = 0; j < 4; ++j) { const int n = (lane >> 3) + 8 * j; const LAS float* s = scr + (8 * c) * 33 + n;
        v4u o; o.x = pk2(s[0 * 33] * f[0], s[1 * 33] * f[1]); o.y = pk2(s[2 * 33] * f[2], s[3 * 33] * f[3]); o.z = pk2(s[4 * 33] * f[4], s[5 * 33] * f[5]); o.w = pk2(s[6 * 33] * f[6], s[7 * 33] * f[7]);
        if (n0 + n < N) *(GAS v4u*)(WT + (size_t)(row_off + n0 + n) * ldk + k0 + 8 * c) = o; }
    LDS_WAIT(); asm volatile("" ::: "memory");
}

template <int OFF> __device__ __forceinline__ unsigned long long karg64() {
    auto kp = __builtin_amdgcn_kernarg_segment_ptr(); unsigned long long v;
    asm volatile("s_load_dwordx2 %0, %1, %2\n\ts_waitcnt lgkmcnt(0)" : "=s"(v) : "s"(kp), "n"(OFF) : "memory");
    return v;
}
template <int IDX_> __device__ __forceinline__ const float* inp() { return (const float*)(const GAS float*)karg64<IDX_ * 8>(); }
#define ARG_OUT ((float*)(GAS float*)karg64<N_INPUTS * 8>())
#define ARG_WS ((unsigned char*)(GAS unsigned char*)karg64<N_INPUTS * 8 + 8>())
struct Ctx { int tid, lane, wave, G, bx, vcu, gw, NGW, l; unsigned char* ws; };
__device__ __forceinline__ Ctx ctx_make(int wave, int layer = 0) {
    Ctx c; int ln; asm volatile("v_mbcnt_lo_u32_b32 %0, -1, 0\n\tv_mbcnt_hi_u32_b32 %0, -1, %0" : "=v"(ln)); int g = gridDim.x, b = blockIdx.x; asm volatile("" : "+s"(g), "+s"(b), "+s"(wave));
    c.tid = wave * 64 + ln; c.lane = ln; c.wave = wave; c.G = g; c.bx = b;
    c.vcu = (g % 8 == 0) ? (b % 8) * (g / 8) + b / 8 : b; c.gw = c.vcu * NWAVES + c.wave; c.NGW = g * NWAVES; c.ws = ARG_WS; asm volatile("" : "+s"(layer)); c.l = layer; return c;
}

constexpr int IT_IN = (DM / 64) * ((DIN + 31) / 32), IT_L96 = (DM / 64) * 3, IT_L256 = (DM / 64) * 8, IT_L64 = (DM / 64) * 2;
constexpr int IT_OUT = (DM / 64) * (DM / 32), IT_UP = (DM / 64) * (DFF / 32), IT_DN = (DFF / 64) * (DM / 32);
constexpr int IT_PRO = IT_IN + 4 * IT_L96 + 2 * IT_L256 + 2 * IT_L64;
constexpr int IT_LATE = IT_OUT + IT_UP + IT_DN, CONV_PER_ITEM = 128, N_CONV_BIG = 448, CONV_PER_SMALL = 32, N_CONV_ITEMS = N_CONV_BIG + (IT_LATE - N_CONV_BIG * CONV_PER_ITEM) / CONV_PER_SMALL;
static_assert((IT_LATE - N_CONV_BIG * CONV_PER_ITEM) % CONV_PER_SMALL == 0 && IT_LATE > N_CONV_BIG * CONV_PER_ITEM, "conversion items");
__device__ __forceinline__ void conv_late_item(unsigned char* ws, const int l, int r, LAS float* scr, int lane) {
    if (r < IT_OUT) { transpose_item(inp<I_WOUT>() + (size_t)l * DM * DM, DM, (bf16*)(ws + WS_WOUT), DM, 0, nullptr, 0, scr, r, lane); return; } r -= IT_OUT;
    if (r < IT_UP) { transpose_item(inp<I_WUP>() + (size_t)l * DM * DFF, DFF, (bf16*)(ws + WS_WUP), DM, 0, inp<I_NFG>() + (size_t)l * DM, 2, scr, r, lane); return; } r -= IT_UP;
    transpose_item(inp<I_WDN>() + (size_t)l * DFF * DM, DM, (bf16*)(ws + WS_WDN), DFF, 0, nullptr, 0, scr, r, lane);
}
__device__ __forceinline__ void layer_prologue(unsigned char* ws, gu32* ctl, LAS unsigned char* lds, const int l, int gw, int NGW, int wave, int lane) {
    LAS float* scr = (LAS float*)(lds + RING_OFF + wave * 16384);
    for (int it = gw; it < IT_PRO; it += NGW) {
        int r = it;
        bf16* Wi = (bf16*)(ws + WS_WIN);
        const float* mu = inp<I_MUWAG>() + (size_t)l * 3 * DM;
        if (r < IT_IN) { transpose_item(inp<I_WIN>() + (size_t)l * DM * DIN, DIN, Wi, DM, 0, nullptr, 0, scr, r, lane); continue; } r -= IT_IN;
        if (r < IT_L96) { transpose_item(inp<I_W1>() + (size_t)l * DM * 96, 96, Wi, DM, C_LWH, mu, 1, scr, r, lane); continue; } r -= IT_L96;
        if (r < IT_L96) { transpose_item(inp<I_W1>() + (size_t)l * DM * 96, 96, Wi, DM, C_LWS, mu, 2, scr, r, lane); continue; } r -= IT_L96;
        if (r < IT_L96) { transpose_item(inp<I_A1>() + (size_t)l * DM * 96, 96, Wi, DM, C_LAH, mu + DM, 1, scr, r, lane); continue; } r -= IT_L96;
        if (r < IT_L96) { transpose_item(inp<I_A1>() + (size_t)l * DM * 96, 96, Wi, DM, C_LAS, mu + DM, 2, scr, r, lane); continue; } r -= IT_L96;
        if (r < IT_L256) { transpose_item(inp<I_G1>() + (size_t)l * DM * 256, 256, Wi, DM, C_LGH, mu + 2 * DM, 1, scr, r, lane); continue; } r -= IT_L256;
        if (r < IT_L256) { transpose_item(inp<I_G1>() + (size_t)l * DM * 256, 256, Wi, DM, C_LGS, mu + 2 * DM, 2, scr, r, lane); continue; } r -= IT_L256;
        if (r < IT_L64) { if (l == 1) transpose_item(inp<I_V1>(), 64, Wi, DM, C_LVH, inp<I_VMU>(), 1, scr, r, lane); continue; } r -= IT_L64;
        if (l == 1) transpose_item(inp<I_V1>(), 64, Wi, DM, C_LVS, inp<I_VMU>(), 2, scr, r, lane);
    }
    for (int i = gw * 64 + lane; i < 8192 * 32; i += NGW * 64) {
        const int n = i >> 5, k8 = i & 31, grp = n >> 11, c = n & 2047;
        const float* src; int rank;
        if (grp == 0) { src = inp<I_W2>() + (size_t)l * 96 * BW; rank = 96; }
        else if (grp == 1) { src = inp<I_A2>() + (size_t)l * 96 * BW; rank = 96; }
        else if (grp == 2) { src = inp<I_G2>() + (size_t)l * 256 * BW; rank = 256; }
        else { src = inp<I_V2>(); rank = (l == 1) ? 64 : 0; }
        float v[8];
#pragma unroll
        for (int e = 0; e < 8; ++e) { const int k = 8 * k8 + e; v[e] = (k < rank) ? src[(size_t)k * BW + c] : 0.f; }
        v4u o; o.x = pk2(v[0], v[1]); o.y = pk2(v[2], v[3]); o.z = pk2(v[4], v[5]); o.w = pk2(v[6], v[7]);
        *(GAS v4u*)((bf16*)(ws + WS_BT2) + (size_t)n * 256 + 8 * k8) = o;
    }
    if (gw == 0) {
        const float a = wave_sum(inp<I_LQ1>()[l * 64 + lane] * inp<I_LK1>()[l * 64 + lane]), b = wave_sum(inp<I_LQ2>()[l * 64 + lane] * inp<I_LK2>()[l * 64 + lane]);
        const float lam_init = 0.8f - 0.6f * expf(-0.3f * (float)l);
        if (lane == 0) __hip_atomic_store(ctl + CW_LAM + l, __float_as_uint(expf(a) - expf(b) + lam_init), RLX_AGENT); }
}

__device__ __forceinline__ void rmsnorm_rows_bf16(const float* src, const float* g, bf16* dst, int gw, int NGW, int lane) {
    for (int m = gw; m < SEQ; m += NGW) {
        const GAS f32x4* xr = (const GAS f32x4*)(src + (size_t)m * DM) + lane; const GAS f32x4* gr = (const GAS f32x4*)g + lane;
        f32x4 v[16]; float s = 0.f;
#pragma unroll
        for (int j = 0; j < 16; ++j) { v[j] = xr[64 * j]; s += (v[j].x * v[j].x + v[j].y * v[j].y) + (v[j].z * v[j].z + v[j].w * v[j].w); }
        const float rstd = 1.0f / sqrtf(wave_sum(s) * (1.f / DM) + RMS_EPS);
        GAS unsigned long long* o8 = (GAS unsigned long long*)(dst + (size_t)m * DM) + lane;
#pragma unroll
        for (int j = 0; j < 16; ++j) { const f32x4 gv = gr[64 * j];
            o8[64 * j] = (unsigned long long)pk2(v[j].x * rstd * gv.x, v[j].y * rstd * gv.y) | ((unsigned long long)pk2(v[j].z * rstd * gv.z, v[j].w * rstd * gv.w) << 32); }
    }
}
__device__ __forceinline__ void rmsnorm_rows_f32_inplace(float* x, const float* g, int gw, int NGW, int lane) {
    for (int m = gw; m < SEQ; m += NGW) {
        GAS f32x4* xr = (GAS f32x4*)(x + (size_t)m * DM) + lane; const GAS f32x4* gr = (const GAS f32x4*)g + lane;
        f32x4 v[16]; float s = 0.f;
#pragma unroll
        for (int j = 0; j < 16; ++j) { v[j] = xr[64 * j]; s += (v[j].x * v[j].x + v[j].y * v[j].y) + (v[j].z * v[j].z + v[j].w * v[j].w); }
        const float rstd = 1.0f / sqrtf(wave_sum(s) * (1.f / DM) + RMS_EPS);
#pragma unroll
        for (int j = 0; j < 16; ++j) { const f32x4 gv = gr[64 * j]; xr[64 * j] = v[j] * rstd * gv; }
    }
}

__device__ __forceinline__ void lora_prep(const bf16* P, bf16* AP, const float* PART, int layer, int gw, int NGW, int lane) {
    for (int t = gw; t < SEQ; t += NGW) {
        const bf16* cur = P + (size_t)t * LDP; const bf16* prv = cur - LDP;
#pragma unroll
        for (int k = 0; k < 16; ++k) { const int grp = k >> 2, i = lane + 64 * (k & 3);
            const int rank = (grp == 2) ? 256 : (grp == 3 ? ((layer == 1) ? 64 : 0) : 96);
            const int ch = (grp == 0) ? C_LWH : (grp == 1) ? C_LAH : (grp == 2) ? C_LGH : C_LVH, cs = (grp == 0) ? C_LWS : (grp == 1) ? C_LAS : (grp == 2) ? C_LGS : C_LVS;
            float v = 0.f;
            if (grp == 3) {
                if (i < rank) {
                    const float* pc = PART + (size_t)t * 2048 + (C_LVH + i - 14336); const float* pp = PART + (size_t)(t > 0 ? t - 1 : 0) * 2048 + (C_LVS + i - 14336);
                    float sc = 0.f, sp = 0.f;
#pragma unroll
                    for (int s = 0; s < 8; ++s) { sp += pp[s * 256]; if (C_LVH + i >= 14336) sc += pc[s * 256]; }
                    if (C_LVH + i < 14336) sc = bf2f(cur[C_LVH + i]);
                    v = sc + ((t > 0) ? sp : 0.f); }
            } else if (i < rank) { v = bf2f(cur[ch + i]); if (t > 0) v += bf2f(prv[cs + i]);
                if (grp == 0) v = tanhf(v); else if (grp == 2) v = sigmoidf_(v); }
            AP[(size_t)t * 1024 + grp * 256 + i] = (bf16)f2bf(v); }
    }
}

__device__ __forceinline__ void rwkv_prep(unsigned char* ws, int layer, int gw, int NGW, int lane) {
    const bf16* P = (const bf16*)(ws + WS_P); const float* ZW = (const float*)(ws + WS_Z); const bf16* ZB = (const bf16*)(ws + WS_ZB);
    unsigned char* XS = ws + WS_XS; float* BON = (float*)(ws + WS_BON);
    float* VF = (float*)(ws + WS_VF);
    const int head = gw & 31, c = head * 64 + lane, nch = NGW >> 5, ch = gw >> 5;
    if (nch == 0 || ch >= nch) return;
    const int tper = (SEQ + nch - 1) / nch, tb = ch * tper, te = (tb + tper < SEQ) ? tb + tper : SEQ;
    const float* mu = inp<I_MURKV>() + (size_t)layer * 3 * BW;
    const float mu_r = mu[c], mu_k = mu[BW + c], mu_v = mu[2 * BW + c];
    const float w0 = inp<I_W0>()[layer * BW + c], a0 = inp<I_A0>()[layer * BW + c], kkw = inp<I_KK>()[layer * BW + c], kaw = inp<I_KA>()[layer * BW + c], rkw = inp<I_RK>()[layer * BW + c];
    const float v0 = (layer == 1) ? inp<I_V0>()[c] : 0.f;
    float rp = 0.f, kp = 0.f, vp = 0.f;
    if (tb > 0 && tb < SEQ) { const bf16* prv = P + (size_t)(tb - 1) * LDP; rp = bf2f(prv[C_RB + c]); kp = bf2f(prv[C_KB + c]); vp = bf2f(prv[C_VB + c]); }
#pragma unroll 4
    for (int t = tb; t < te; ++t) {
        const bf16* cur = P + (size_t)t * LDP;
        const float r0 = bf2f(cur[C_RB + c]), k0 = bf2f(cur[C_KB + c]), v0r = bf2f(cur[C_VB + c]);
        const bf16* zb = ZB + (size_t)t * 6144;
        const float zw = ZW[(size_t)t * 2048 + c], za = bf2f(zb[c]);
        float zv = 0.f, vf = 0.f; if (layer == 1) { zv = bf2f(zb[2 * BW + c]); vf = VF[(size_t)t * BW + c]; }
        const float r = r0 + (rp - r0) * mu_r, k = k0 + (kp - k0) * mu_k; float v = v0r + (vp - v0r) * mu_v;
        rp = r0; kp = k0; vp = v0r;
        const float decay = __expf(-0.6065306597126334f * sigmoidf_(w0 + zw));
        const float a = sigmoidf_(a0 + za);
        if (layer == 0) VF[(size_t)t * BW + c] = v; else v += (vf - v) * sigmoidf_(v0 + zv);
        float kk = k * kkw;
        const float nrm = sqrtf(wave_sum(kk * kk));
        kk = kk / fmaxf(nrm, 1e-12f);
        const float kn = k * (1.0f + (a - 1.0f) * kaw);
        float* rec = (float*)(XS + ((size_t)head * SEQ + t) * SREC) + lane;
        rec[0] = decay; rec[64] = r; rec[128] = kn; rec[192] = -kk; rec[256] = kk * a; rec[320] = v;
        const float bon = wave_sum(r * kn * rkw);
        if (lane == 0) BON[t * 32 + head] = bon;
    }
}

typedef unsigned short us4 __attribute__((ext_vector_type(4)));
__device__ __forceinline__ void st16_sc1(void* p, const f32x4 v) { asm volatile("global_store_dwordx4 %0, %1, off sc1\n\ts_nop 1" :: "v"((GAS void*)p), "v"(v) : "memory"); }
__device__ __forceinline__ void rwkv_prep_item(unsigned char* ws, int layer, int pi, int wave, int lane) {
    const bf16* P = (const bf16*)(ws + WS_P); const float* ZW = (const float*)(ws + WS_Z); const bf16* ZB = (const bf16*)(ws + WS_ZB);
    unsigned char* XS = ws + WS_XS; float* BON = (float*)(ws + WS_BON); float* VF = (float*)(ws + WS_VF);
    const int head = (pi & 3) * 8 + wave, tb = (pi >> 2) * 32, kq = lane & 15, c4 = head * 64 + 4 * kq;
    const float* mu = inp<I_MURKV>() + (size_t)layer * 3 * BW;
    const f32x4 mu_r = *(const GAS f32x4*)(mu + c4), mu_k = *(const GAS f32x4*)(mu + BW + c4), mu_v = *(const GAS f32x4*)(mu + 2 * BW + c4);
    const f32x4 w0 = *(const GAS f32x4*)(inp<I_W0>() + layer * BW + c4), a0 = *(const GAS f32x4*)(inp<I_A0>() + layer * BW + c4), kkw = *(const GAS f32x4*)(inp<I_KK>() + layer * BW + c4),
                kaw = *(const GAS f32x4*)(inp<I_KA>() + layer * BW + c4), rkw = *(const GAS f32x4*)(inp<I_RK>() + layer * BW + c4);
    f32x4 v0 = (f32x4){0.f, 0.f, 0.f, 0.f}; if (layer == 1) v0 = *(const GAS f32x4*)(inp<I_V0>() + c4);
#pragma unroll 2
    for (int p = 0; p < 8; ++p) {
        const int t = tb + 4 * p + (lane >> 4);
        const bf16* cur = P + (size_t)t * LDP + c4; const bf16* prv = cur - (t > 0 ? LDP : 0);
        const us4 r0b = *(const GAS us4*)(cur + C_RB), k0b = *(const GAS us4*)(cur + C_KB), v0b = *(const GAS us4*)(cur + C_VB);
        const us4 rpb = *(const GAS us4*)(prv + C_RB), kpb = *(const GAS us4*)(prv + C_KB), vpb = *(const GAS us4*)(prv + C_VB);
        const bf16* zb = ZB + (size_t)t * 6144 + c4;
        const f32x4 zw = *(const GAS f32x4*)(ZW + (size_t)t * 2048 + c4); const us4 zab = *(const GAS us4*)zb;
        us4 zvb = (us4){0, 0, 0, 0}; f32x4 vf = (f32x4){0.f, 0.f, 0.f, 0.f};
        if (layer == 1) { zvb = *(const GAS us4*)(zb + 2 * BW); vf = *(const GAS f32x4*)(VF + (size_t)t * BW + c4); }
        const float pm = (t > 0) ? 1.f : 0.f;
        f32x4 dec, r, kn, kk, kb, v; float n2 = 0.f, bon = 0.f;
#pragma unroll
        for (int j = 0; j < 4; ++j) {
            const float r0 = bf2f(r0b[j]), k0 = bf2f(k0b[j]), v0r = bf2f(v0b[j]);
            const float rp = pm * bf2f(rpb[j]), kp = pm * bf2f(kpb[j]), vp = pm * bf2f(vpb[j]);
            const float rr = r0 + (rp - r0) * mu_r[j], k = k0 + (kp - k0) * mu_k[j]; float vv = v0r + (vp - v0r) * mu_v[j];
            dec[j] = __expf(-0.6065306597126334f * sigmoidf_(w0[j] + zw[j]));
            const float a = sigmoidf_(a0[j] + bf2f(zab[j]));
            if (layer == 1) vv += (vf[j] - vv) * sigmoidf_(v0[j] + bf2f(zvb[j]));
            const float q = k * kkw[j];
            n2 += q * q;
            kk[j] = q; kb[j] = a;
            kn[j] = k * (1.0f + (a - 1.0f) * kaw[j]);
            bon += rr * kn[j] * rkw[j];
            r[j] = rr; v[j] = vv;
        }
        n2 = dpp_sum16(n2); bon = dpp_sum16(bon);
        const float inv = 1.0f / fmaxf(sqrtf(n2), 1e-12f);
        f32x4 nk;
#pragma unroll
        for (int j = 0; j < 4; ++j) { const float q = kk[j] * inv; nk[j] = -q; kb[j] = q * kb[j]; }
        if (layer == 0) *(GAS f32x4*)(VF + (size_t)t * BW + c4) = v;
        unsigned char* rec = XS + ((size_t)head * SEQ + t) * SREC + kq * 16;
        st16_sc1(rec, dec); st16_sc1(rec + 256, r); st16_sc1(rec + 512, kn); st16_sc1(rec + 768, nk); st16_sc1(rec + 1024, kb); st16_sc1(rec + 1280, v);
        if (kq == 0) BON[t * 32 + head] = bon;
    }
}

constexpr int SCH = 32, SCHB = SCH * SREC;
typedef float f32x2 __attribute__((ext_vector_type(2)));
struct ScanIn { f32x4 w, r, k, a, b; f32x2 v; };
__device__ __forceinline__ f32x2 lo2(const f32x4& x) { return (f32x2){x.x, x.y}; }
__device__ __forceinline__ f32x2 hi2(const f32x4& x) { return (f32x2){x.z, x.w}; }
__device__ __forceinline__ void scan_unit(unsigned char* ws, int layer, int unit, int wave, int lane, LAS unsigned char* lds) {
    const int head = unit >> 1, half = unit & 1, row = half * 32 + (wave & 3) * 8 + (lane >> 4) * 2, kq = lane & 15;
    const unsigned char* src = ws + WS_XS + (size_t)head * SEQ * SREC + (size_t)wave * 6144 + lane * 16;
    float* py = (float*)(ws + WS_Y) + head * 64 + row;
    f32x2 S0 = (f32x2){0.f, 0.f}, S1 = (f32x2){0.f, 0.f}, T0 = (f32x2){0.f, 0.f}, T1 = (f32x2){0.f, 0.f};
    const unsigned rdo = (unsigned)kq * 16u, rdv = 1280u + (unsigned)row * 4u;
    const bool ev0 = (lane & 1) == 0, ev1 = (lane & 2) == 0;
#define SCAN_DMA(c, buf) do { _Pragma("unroll") for (int p_ = 0; p_ < 6; ++p_) \
        __builtin_amdgcn_global_load_lds((const unsigned*)(src + (size_t)(c) * SCHB + p_ * 1024), (LAS unsigned*)(lds + (buf) * SCHB + wave * 6144 + p_ * 1024), 16, 0, 16); } while (0)
#define SCAN_LOAD(X, base) do { _Pragma("unroll") for (int i_ = 0; i_ < 4; ++i_) { const LAS unsigned char* q_ = (base) + i_ * SREC; \
        X[i_].w = *(const LAS f32x4*)(q_ + rdo); X[i_].r = *(const LAS f32x4*)(q_ + rdo + 256); X[i_].k = *(const LAS f32x4*)(q_ + rdo + 512); X[i_].a = *(const LAS f32x4*)(q_ + rdo + 768); X[i_].b = *(const LAS f32x4*)(q_ + rdo + 1024); \
        X[i_].v = *(const LAS f32x2*)(q_ + rdv); } } while (0)
#define SCAN_STEP(X, ANEXT, ROUT) do { \
          \
        const float p1_ = ev0 ? sap : sbp, q1_ = ev0 ? sbp : sap, p2_ = ev0 ? ypp : zpp, q2_ = ev0 ? zpp : ypp; \
        const float r1_ = p1_ + DPPF(q1_, 0xB1), r2_ = p2_ + DPPF(q2_, 0xB1); \
        const float p3_ = ev1 ? r1_ : r2_, q3_ = ev1 ? r2_ : r1_; \
        float rr_ = p3_ + DPPF(q3_, 0x4E); \
        rr_ += DPPF(rr_, 0x124); rr_ += DPPF(rr_, 0x128);                   \
        const float sa_ = __builtin_bit_cast(float, __builtin_amdgcn_mov_dpp(__builtin_bit_cast(int, rr_), 0x00, 0xF, 0xF, false)), sb_ = __builtin_bit_cast(float, __builtin_amdgcn_mov_dpp(__builtin_bit_cast(int, rr_), 0x55, 0xF, 0xF, false));     \
        ROUT = rr_;                                                          \
        { const f32x2 kv0 = lo2(X.k) * X.v.x, kv1 = hi2(X.k) * X.v.x; \
          const f32x2 t0_ = __builtin_elementwise_fma(lo2(X.b), (f32x2){sa_, sa_}, kv0), t1_ = __builtin_elementwise_fma(hi2(X.b), (f32x2){sa_, sa_}, kv1); \
          S0 = __builtin_elementwise_fma(S0, lo2(X.w), t0_); S1 = __builtin_elementwise_fma(S1, hi2(X.w), t1_); } \
        { const f32x2 kv0 = lo2(X.k) * X.v.y, kv1 = hi2(X.k) * X.v.y; \
          const f32x2 t0_ = __builtin_elementwise_fma(lo2(X.b), (f32x2){sb_, sb_}, kv0), t1_ = __builtin_elementwise_fma(hi2(X.b), (f32x2){sb_, sb_}, kv1); \
          T0 = __builtin_elementwise_fma(T0, lo2(X.w), t0_); T1 = __builtin_elementwise_fma(T1, hi2(X.w), t1_); } \
        { const f32x2 u_ = __builtin_elementwise_fma(S1, hi2(ANEXT), S0 * lo2(ANEXT)); sap = u_.x + u_.y; } \
        { const f32x2 u_ = __builtin_elementwise_fma(T1, hi2(ANEXT), T0 * lo2(ANEXT)); sbp = u_.x + u_.y; } \
        { const f32x2 u_ = __builtin_elementwise_fma(S1, hi2(X.r), S0 * lo2(X.r)); ypp = u_.x + u_.y; } \
        { const f32x2 u_ = __builtin_elementwise_fma(T1, hi2(X.r), T0 * lo2(X.r)); zpp = u_.x + u_.y; } } while (0)
#define SCAN_STEPS(X, AN4, t0) do { float r0_, r1x_, r2x_, r3_; \
        SCAN_STEP(X[0], X[1].a, r0_); SCAN_STEP(X[1], X[2].a, r1x_); SCAN_STEP(X[2], X[3].a, r2x_); SCAN_STEP(X[3], AN4, r3_); \
        const int qd_ = kq >> 2; const float ys_ = (qd_ == 0) ? r0_ : (qd_ == 1) ? r1x_ : (qd_ == 2) ? r2x_ : r3_; const int ts_ = (t0) - 1 + qd_; \
        if ((kq & 2) && ts_ >= 0) py[(size_t)ts_ * BW + (kq & 1)] = ys_; } while (0)
    const gu32* flg = (const gu32*)(ws + WS_CTL) + CW_PREP + 1024 * layer + (head >> 3);
#define SCAN_FRAW(c) __hip_atomic_load(flg + 4 * (c), RLX_AGENT)
#define SCAN_FLAG(c) ((unsigned)__builtin_amdgcn_readfirstlane((int)SCAN_FRAW(c)))
#define SCAN_WAIT(c, f) do { unsigned f_ = (f), sp_ = 0u; while (f_ == 0u) { __builtin_amdgcn_s_sleep(1); f_ = SCAN_FLAG(c); if (++sp_ > (1u << 24)) break; } } while (0)
    SCAN_WAIT(0, 0u);
    SCAN_DMA(0, 0);
    unsigned fnext = SCAN_FRAW(1);
    __syncthreads();
    float sap = 0.f, ypp = 0.f, sbp = 0.f, zpp = 0.f;
    for (int c = 0; c < SEQ / SCH; ++c) {
        const int cur = c & 1;
        if (c + 1 < SEQ / SCH) { SCAN_WAIT(c + 1, (unsigned)__builtin_amdgcn_readfirstlane((int)fnext)); SCAN_DMA(c + 1, cur ^ 1); fnext = SCAN_FRAW(c + 2 < SEQ / SCH ? c + 2 : c + 1); }
        if (wave < 4) {
            const LAS unsigned char* cb = lds + cur * SCHB;
            ScanIn A[4], B[4];
            SCAN_LOAD(A, cb);
#pragma unroll
            for (int s = 0; s < SCH; s += 8) {
                SCAN_LOAD(B, cb + (s + 4) * SREC);
                SCAN_STEPS(A, B[0].a, c * SCH + s);
                if (s + 8 < SCH) { SCAN_LOAD(A, cb + (s + 8) * SREC); SCAN_STEPS(B, A[0].a, c * SCH + s + 4); }
                else { SCAN_STEPS(B, B[3].a, c * SCH + s + 4); }
            }
        }
        if (wave < 4) { asm volatile("s_waitcnt vmcnt(9) lgkmcnt(0)" ::: "memory"); __builtin_amdgcn_s_barrier(); asm volatile("" ::: "memory"); }
        else __syncthreads();
        if (c + 1 < SEQ / SCH && wave < 4) {
            const f32x4 an = *(const LAS f32x4*)(lds + (cur ^ 1) * SCHB + rdo + 768);
            { const f32x2 u_ = __builtin_elementwise_fma(S1, hi2(an), S0 * lo2(an)); sap = u_.x + u_.y; }
            { const f32x2 u_ = __builtin_elementwise_fma(T1, hi2(an), T0 * lo2(an)); sbp = u_.x + u_.y; }
        }
    }
    if (wave < 4) {
        float yp_ = ypp, zp_ = zpp;
        yp_ += DPPF(yp_, 0xB1); zp_ += DPPF(zp_, 0xB1); yp_ += DPPF(yp_, 0x4E); zp_ += DPPF(zp_, 0x4E); yp_ += DPPF(yp_, 0x141); zp_ += DPPF(zp_, 0x141); yp_ += DPPF(yp_, 0x140); zp_ += DPPF(zp_, 0x140);
        if (kq == 0) { f32x2 o; o.x = yp_; o.y = zp_; *(GAS f32x2*)(py + (size_t)(SEQ - 1) * BW) = o; }
    }
#undef SCAN_DMA
#undef SCAN_FLAG
#undef SCAN_FRAW
#undef SCAN_WAIT
#undef SCAN_LOAD
#undef SCAN_STEP
#undef SCAN_STEPS
}

__device__ __forceinline__ float relu0(float x) { return __builtin_amdgcn_fmed3f(x, 0.f, __builtin_inff()); }
__device__ __forceinline__ void idx_scores_quad(const bf16* P, const bf16* KIF, float* Sc, int t0, int lane) {
    typedef float f32x16 __attribute__((ext_vector_type(16)));
    const int r = lane & 31, hh = lane >> 5;
    bf16x8 af[2][4]; float wq[2][16];
#pragma unroll
    for (int a = 0; a < 2; ++a) {
        const bf16* qrow = P + (size_t)(t0 + 2 * a + (r >> 4)) * LDP + C_QI + (r & 15) * 64 + hh * 8;
#pragma unroll
        for (int ks = 0; ks < 4; ++ks) af[a][ks] = *(const GAS bf16x8*)(qrow + ks * 16);
#pragma unroll
        for (int i = 0; i < 16; ++i) { const int head = (i & 3) + 8 * ((i >> 2) & 1) + 4 * hh; wq[a][i] = bf2f(P[(size_t)(t0 + 2 * a + (i >> 3)) * LDP + C_WI + head]); }
    }
    const int nkt = (t0 + 3) / 32 + 1;
    const bf16* kp = KIF + (size_t)lane * 8;
    float* sp0 = Sc + (size_t)(t0 + hh) * SEQ + r; float* sp1 = Sc + (size_t)(t0 + 2 + hh) * SEQ + r;
#define IDX_LOAD(X, kt_) do { const bf16* k_ = kp + (size_t)((kt_) < nkt ? (kt_) : nkt - 1) * 2048; _Pragma("unroll") for (int ks = 0; ks < 4; ++ks) X[ks] = *(const GAS bf16x8*)(k_ + ks * 512); } while (0)
#define IDX_TILE(X, kt_) do { _Pragma("unroll") for (int a = 0; a < 2; ++a) { f32x16 acc; \
            _Pragma("unroll") for (int i = 0; i < 16; ++i) acc[i] = 0.f; \
            _Pragma("unroll") for (int ks = 0; ks < 4; ++ks) acc = __builtin_amdgcn_mfma_f32_32x32x16_bf16(af[a][ks], X[ks], acc, 0, 0, 0); \
            float s0 = 0.f, s1 = 0.f; \
            _Pragma("unroll") for (int i = 0; i < 8; ++i) { s0 += wq[a][i] * relu0(acc[i]); s1 += wq[a][8 + i] * relu0(acc[8 + i]); } \
            s0 = swap32_sum(s0); s1 = swap32_sum(s1); \
            (a ? sp1 : sp0)[(kt_) * 32] = hh ? s1 : s0; } } while (0)
    bf16x8 fa[4], fb[4];
    IDX_LOAD(fa, 0);
#pragma unroll 1
    for (int kt = 0; kt < nkt; kt += 2) {
        IDX_LOAD(fb, kt + 1);
        IDX_TILE(fa, kt);
        if (kt + 1 < nkt) { IDX_LOAD(fa, kt + 2); IDX_TILE(fb, kt + 1); }
    }
#undef IDX_LOAD
#undef IDX_TILE
}

__device__ __forceinline__ unsigned f2key(float f) { const unsigned u = __float_as_uint(f); return (u & 0x80000000u) ? ~u : (u | 0x80000000u); }
__device__ __forceinline__ void topk_row(const float* sc, int L, unsigned* out, LAS unsigned* hist, int lane) {
    unsigned prefix = 0u, himask = 0u; int kneed = 256;
    for (int pass = 0; pass < 4; ++pass) {
        const int shift = 24 - 8 * pass;
#pragma unroll
        for (int b = 0; b < 4; ++b) hist[lane + 64 * b] = 0u;
        LDS_WAIT(); asm volatile("" ::: "memory");
        for (int i0 = lane; i0 < L; i0 += 1024) { float v[16];
#pragma unroll
            for (int j = 0; j < 16; ++j) v[j] = (i0 + 64 * j < L) ? sc[i0 + 64 * j] : 0.f;
#pragma unroll
            for (int j = 0; j < 16; ++j) { const unsigned u = f2key(v[j]); if (i0 + 64 * j < L && (u & himask) == prefix) __hip_atomic_fetch_add(&hist[(u >> shift) & 255u], 1u, __ATOMIC_RELAXED, __HIP_MEMORY_SCOPE_WORKGROUP); } }
        LDS_WAIT(); asm volatile("" ::: "memory");
        unsigned c[4];
#pragma unroll
        for (int j = 0; j < 4; ++j) c[j] = hist[4 * lane + j];
        const unsigned tot = (c[0] + c[1]) + (c[2] + c[3]);
        unsigned inc = tot;
#pragma unroll
        for (int o = 1; o < 64; o <<= 1) { const unsigned v = bperm_u32(inc, (lane + o) & 63); if (lane + o < 64) inc += v; }
        unsigned cum = inc - tot; bool found = false; unsigned d = 0u, gt = 0u;
#pragma unroll
        for (int j = 3; j >= 0; --j) { if (!found && cum < (unsigned)kneed && (unsigned)kneed <= cum + c[j]) { found = true; d = 4u * lane + j; gt = cum; } cum += c[j]; }
        const unsigned long long m = __ballot(found);
        const int src = m ? (int)__builtin_ctzll(m) : 0;
        d = (unsigned)__builtin_amdgcn_readlane((int)d, src); gt = (unsigned)__builtin_amdgcn_readlane((int)gt, src);
        prefix |= d << shift; himask |= 0xFFu << shift; kneed -= (int)gt;
        LDS_WAIT(); asm volatile("" ::: "memory");
    }
    int eqtaken = 0;
    const unsigned long long lt = (1ull << lane) - 1ull;
    for (int base0 = 0; base0 < L; base0 += 1024) { float v[16];
#pragma unroll
        for (int j = 0; j < 16; ++j) v[j] = (base0 + 64 * j + lane < L) ? sc[base0 + 64 * j + lane] : 0.f;
#pragma unroll
        for (int j = 0; j < 16; ++j) { const int base = base0 + 64 * j; if (base < L) {
            const int i = base + lane; const bool valid = i < L; const unsigned u = f2key(v[j]);
            const bool gtm = valid && u > prefix, eqm = valid && u == prefix;
            const unsigned long long meq = __ballot(eqm);
            const bool take = gtm || (eqm && (eqtaken + __popcll(meq & lt) < kneed));
            const unsigned long long mt = __ballot(take);
            if (lane < 2) __hip_atomic_store((gu32*)out + (base >> 5) + lane, (unsigned)(mt >> (32 * lane)), RLX_AGENT);
            eqtaken += __popcll(meq); } }
    }
    const int wdone = ((L + 63) >> 6) << 1;
#pragma unroll
    for (int w = lane; w < 256; w += 64) if (w >= wdone) __hip_atomic_store((gu32*)out + w, 0u, RLX_AGENT);
}
__device__ __forceinline__ void causal_bm_row(int t, unsigned* out, int lane) {
#pragma unroll
    for (int w = lane; w < 256; w += 64) { const int lo_ = 32 * w; __hip_atomic_store((gu32*)out + w, (t >= lo_ + 31) ? 0xffffffffu : (t < lo_ ? 0u : ((2u << (t - lo_)) - 1u)), RLX_AGENT); }
}

__device__ __forceinline__ void dsa_attn_wave(const bf16* P, const unsigned* BM, const bf16* KF, const bf16* VF, bf16* mix, int t0, int h, LAS unsigned char* kst, LAS float* wsf, int lane) {
    typedef float f32x16 __attribute__((ext_vector_type(16)));
    const int r32 = lane & 31, hi = lane >> 5;
    bf16x8 qf[8];
    { const bf16* qrow = P + (size_t)(t0 + r32) * LDP + C_QC + h * 128 + hi * 8;
#pragma unroll
      for (int ks = 0; ks < 8; ++ks) qf[ks] = *(const GAS bf16x8*)(qrow + ks * 16); }
    f32x16 o[4];
#pragma unroll
    for (int db = 0; db < 4; ++db)
#pragma unroll
        for (int i = 0; i < 16; ++i) o[db][i] = 0.f;
    float lsum = 0.f;
    const unsigned* bmrow = BM + (size_t)(t0 + r32) * 256;
    const bf16* kbase = KF + (size_t)h * 256 * 8 * 512 + lane * 8;
    const bf16* vbase = VF + (size_t)h * 128 * 16 * 512 + lane * 8;
    const int nkt = (t0 + 31) / 64 + 1;
#define DSA_KDMA(kt_) do { _Pragma("unroll") for (int f_ = 0; f_ < 16; ++f_) \
        __builtin_amdgcn_global_load_lds((const unsigned*)(kbase + (size_t)((kt_) * 16 + f_) * 512), (LAS unsigned*)(kst + f_ * 1024), 16, 0, 0); } while (0)
    DSA_KDMA(0);
#pragma unroll 1
    for (int kt = 0; kt < nkt; ++kt) {
        bf16x8 kf[16];
        asm volatile("s_waitcnt vmcnt(0)" ::: "memory");
#pragma unroll
        for (int f = 0; f < 16; ++f) kf[f] = *(const LAS bf16x8*)(kst + f * 1024 + lane * 16);
        const unsigned m0 = bmrow[2 * kt] >> (4 * hi), m1 = bmrow[2 * kt + 1] >> (4 * hi);
        asm volatile("s_waitcnt lgkmcnt(0)" ::: "memory");
        if (kt + 1 < nkt) DSA_KDMA(kt + 1);
        f32x16 p[2];
#pragma unroll
        for (int kb = 0; kb < 2; ++kb) {
#pragma unroll
            for (int i = 0; i < 16; ++i) p[kb][i] = 0.f;
#pragma unroll
            for (int ks = 0; ks < 8; ++ks) p[kb] = __builtin_amdgcn_mfma_f32_32x32x16_bf16(kf[kb * 8 + ks], qf[ks], p[kb], 0, 0, 0);
        }
        bf16x8 vf[16];
        { const bf16* vrow = vbase + (size_t)(kt * 16) * 512;
#pragma unroll
          for (int f = 0; f < 16; ++f) vf[f] = *(const GAS bf16x8*)(vrow + f * 512); }
#pragma unroll
        for (int i = 0; i < 16; ++i) { const int kk = (i & 3) + 8 * (i >> 2);
            const float e0 = __builtin_amdgcn_exp2f(fminf(p[0][i], 60.f)), e1 = __builtin_amdgcn_exp2f(fminf(p[1][i], 60.f));
            p[0][i] = __uint_as_float(__float_as_uint(e0) & (unsigned)__builtin_amdgcn_sbfe((int)m0, kk, 1)); p[1][i] = __uint_as_float(__float_as_uint(e1) & (unsigned)__builtin_amdgcn_sbfe((int)m1, kk, 1)); lsum += p[0][i] + p[1][i]; }
        bf16x8 pa[4];
#pragma unroll
        for (int s = 0; s < 4; ++s) { v4u w;
#pragma unroll
            for (int j = 0; j < 4; ++j) w[j] = pk2(p[s >> 1][8 * (s & 1) + 2 * j], p[s >> 1][8 * (s & 1) + 2 * j + 1]);
            pa[s] = __builtin_bit_cast(bf16x8, w); }
#pragma unroll
        for (int db = 0; db < 4; ++db)
#pragma unroll
            for (int s = 0; s < 4; ++s) o[db] = __builtin_amdgcn_mfma_f32_32x32x16_bf16(pa[s], vf[s * 4 + db], o[db], 0, 0, 0);
    }
#undef DSA_KDMA
    lsum = swap32_sum(lsum);
    if (hi == 0) wsf[r32] = lsum;
    LDS_WAIT(); asm volatile("" ::: "memory");
    bf16* orow = mix + (size_t)t0 * DM + 3072 + h * 128 + r32;
#pragma unroll
    for (int i = 0; i < 16; ++i) { const int q = (i & 3) + 8 * (i >> 2) + 4 * hi; const float inv = 1.0f / wsf[q];
#pragma unroll
        for (int db = 0; db < 4; ++db) orow[(size_t)q * DM + 32 * db] = (bf16)f2bf(o[db][i] * inv); }
    LDS_WAIT(); asm volatile("" ::: "memory");
}
__device__ __forceinline__ void dsa_attn_unit(const bf16* P, const unsigned* BM, const bf16* KF, const bf16* VF, bf16* mix, int qb, int h, LAS unsigned char* stage, LAS float* wsf, int wave, int lane) {
    typedef float f32x16 __attribute__((ext_vector_type(16)));
    const int r32 = lane & 31, hi = lane >> 5, t0 = 256 * qb + 32 * wave;
    bf16x8 qf[8];
    { const bf16* qrow = P + (size_t)(t0 + r32) * LDP + C_QC + h * 128 + hi * 8;
#pragma unroll
      for (int ks = 0; ks < 8; ++ks) qf[ks] = *(const GAS bf16x8*)(qrow + ks * 16); }
    f32x16 o[4];
#pragma unroll
    for (int db = 0; db < 4; ++db)
#pragma unroll
        for (int i = 0; i < 16; ++i) o[db][i] = 0.f;
    float lsum = 0.f;
    const unsigned* bmrow = BM + (size_t)(t0 + r32) * 256;
    const bf16* kbase = KF + (size_t)h * 256 * 8 * 512 + lane * 8;
    const bf16* vbase = VF + (size_t)h * 128 * 16 * 512 + lane * 8;
    const int nkt = 4 * qb + 4;
#define DSA_DMA(kt_, buf_) do { _Pragma("unroll") for (int f_ = 0; f_ < 2; ++f_) { \
        __builtin_amdgcn_global_load_lds((const unsigned*)(kbase + (size_t)((kt_) * 16 + 2 * wave + f_) * 512), (LAS unsigned*)(stage + (buf_) * 32768 + (2 * wave + f_) * 1024), 16, 0, 0); \
        __builtin_amdgcn_global_load_lds((const unsigned*)(vbase + (size_t)((kt_) * 16 + 2 * wave + f_) * 512), (LAS unsigned*)(stage + (buf_) * 32768 + 16384 + (2 * wave + f_) * 1024), 16, 0, 0); } } while (0)
    DSA_DMA(0, 0);
    __syncthreads();
#pragma unroll 1
    for (int kt = 0; kt < nkt; ++kt) {
        const LAS unsigned char* sb = stage + (kt & 1) * 32768 + lane * 16;
        if (kt + 1 < nkt) DSA_DMA(kt + 1, (kt + 1) & 1);
        const unsigned m0 = bmrow[2 * kt] >> (4 * hi), m1 = bmrow[2 * kt + 1] >> (4 * hi);
        f32x16 p[2];
#pragma unroll
        for (int kb = 0; kb < 2; ++kb) {
#pragma unroll
            for (int i = 0; i < 16; ++i) p[kb][i] = 0.f;
#pragma unroll
            for (int ks = 0; ks < 8; ++ks) p[kb] = __builtin_amdgcn_mfma_f32_32x32x16_bf16(*(const LAS bf16x8*)(sb + (kb * 8 + ks) * 1024), qf[ks], p[kb], 0, 0, 0);
        }
#pragma unroll
        for (int i = 0; i < 16; ++i) { const int kk = (i & 3) + 8 * (i >> 2);
            const float e0 = __builtin_amdgcn_exp2f(fminf(p[0][i], 60.f)), e1 = __builtin_amdgcn_exp2f(fminf(p[1][i], 60.f));
            p[0][i] = __uint_as_float(__float_as_uint(e0) & (unsigned)__builtin_amdgcn_sbfe((int)m0, kk, 1)); p[1][i] = __uint_as_float(__float_as_uint(e1) & (unsigned)__builtin_amdgcn_sbfe((int)m1, kk, 1)); lsum += p[0][i] + p[1][i]; }
        bf16x8 pa[4];
#pragma unroll
        for (int s = 0; s < 4; ++s) { v4u w;
#pragma unroll
            for (int j = 0; j < 4; ++j) w[j] = pk2(p[s >> 1][8 * (s & 1) + 2 * j], p[s >> 1][8 * (s & 1) + 2 * j + 1]);
            pa[s] = __builtin_bit_cast(bf16x8, w); }
#pragma unroll
        for (int db = 0; db < 4; ++db)
#pragma unroll
            for (int s = 0; s < 4; ++s) o[db] = __builtin_amdgcn_mfma_f32_32x32x16_bf16(pa[s], *(const LAS bf16x8*)(sb + 16384 + (s * 4 + db) * 1024), o[db], 0, 0, 0);
        __syncthreads();
    }
#undef DSA_DMA
    lsum = swap32_sum(lsum);
    if (hi == 0) wsf[r32] = lsum;
    LDS_WAIT(); asm volatile("" ::: "memory");
    bf16* orow = mix + (size_t)t0 * DM + 3072 + h * 128 + r32;
#pragma unroll
    for (int i = 0; i < 16; ++i) { const int q = (i & 3) + 8 * (i >> 2) + 4 * hi; const float inv = 1.0f / wsf[q];
#pragma unroll
        for (int db = 0; db < 4; ++db) orow[(size_t)q * DM + 32 * db] = (bf16)f2bf(o[db][i] * inv); }
    LDS_WAIT(); asm volatile("" ::: "memory");
}
__device__ __forceinline__ void dsa_pretile(const bf16* P, unsigned char* ws, int gw, int NGW, int lane) {
    const int r32 = lane & 31, hi = lane >> 5;
    bf16* KF = (bf16*)(ws + WS_KF); bf16* VF = (bf16*)(ws + WS_VFR); bf16* KIF = (bf16*)(ws + WS_KIF);
    for (int it = gw; it < 2048 + 1024 + 256; it += NGW) {
        if (it < 2048) {
            const int h = it >> 8, kb = it & 255; const bf16* src = P + (size_t)(32 * kb + r32) * LDP + C_KC + h * 128 + 8 * hi;
#pragma unroll
            for (int ks = 0; ks < 8; ++ks) *(GAS v4u*)(KF + ((size_t)((h * 256 + kb) * 8 + ks) * 64 + lane) * 8) = *(const GAS v4u*)(src + 16 * ks);
        } else if (it < 3072) {
            const int h = (it - 2048) >> 7, kt = (it - 2048) & 127; const bf16* src = P + (size_t)(64 * kt + 4 * hi) * LDP + C_VC + h * 128 + r32;
#pragma unroll
            for (int s = 0; s < 4; ++s)
#pragma unroll
                for (int db = 0; db < 4; ++db) { const bf16* q_ = src + (size_t)(16 * s) * LDP + 32 * db; unsigned short e[8];
#pragma unroll
                    for (int j = 0; j < 8; ++j) e[j] = q_[(size_t)(8 * (j >> 2) + (j & 3)) * LDP];
                    v4u o; o.x = e[0] | ((unsigned)e[1] << 16); o.y = e[2] | ((unsigned)e[3] << 16); o.z = e[4] | ((unsigned)e[5] << 16); o.w = e[6] | ((unsigned)e[7] << 16);
                    *(GAS v4u*)(VF + ((size_t)((h * 128 + kt) * 16 + s * 4 + db) * 64 + lane) * 8) = o; }
        } else {
            const int kb = it - 3072; const bf16* src = P + (size_t)(32 * kb + r32) * LDP + C_KI + 8 * hi;
#pragma unroll
            for (int ks = 0; ks < 4; ++ks) *(GAS v4u*)(KIF + ((size_t)(kb * 4 + ks) * 64 + lane) * 8) = *(const GAS v4u*)(src + 16 * ks);
        }
    }
}

__device__ __forceinline__ void finalize_mix(unsigned char* ws, gu32* ctl, int layer, int gw, int NGW, int lane) {
    const bf16* O0 = (const bf16*)(ws + WS_O0); const bf16* O1 = (const bf16*)(ws + WS_O1); bf16* mix = (bf16*)(ws + WS_MIX);
    const int nch = NGW / 40, j = gw % 40, ch = gw / 40;
    if (nch == 0 || ch >= nch) return;
    const int tper = (((SEQ + nch - 1) / nch) + 3) & ~3, tb = ch * tper, te = (tb + tper < SEQ) ? tb + tper : SEQ;
    const int kq = lane & 15, tj = lane >> 4;
    if (j < 8) {
        const float lam = __uint_as_float(__hip_atomic_load(ctl + CW_LAM + layer, RLX_AGENT));
        const float lam_init = 0.8f - 0.6f * expf(-0.3f * (float)layer);
        const float* gp = inp<I_SUBLN>() + layer * 128 + 8 * kq;
        const f32x4 ga = *(const GAS f32x4*)gp * (1.0f - lam_init), gb = *(const GAS f32x4*)(gp + 4) * (1.0f - lam_init);
#pragma unroll 2
        for (int t0 = tb; t0 < te; t0 += 4) {
            const int t = t0 + tj;
            const size_t o = (size_t)t * 1024 + j * 128 + 8 * kq;
            const v4u a = *(const GAS v4u*)(O0 + o), b = *(const GAS v4u*)(O1 + o);
            float x[8];
            x[0] = bflo(a.x) - lam * bflo(b.x); x[1] = bfhi(a.x) - lam * bfhi(b.x); x[2] = bflo(a.y) - lam * bflo(b.y); x[3] = bfhi(a.y) - lam * bfhi(b.y);
            x[4] = bflo(a.z) - lam * bflo(b.z); x[5] = bfhi(a.z) - lam * bfhi(b.z); x[6] = bflo(a.w) - lam * bflo(b.w); x[7] = bfhi(a.w) - lam * bfhi(b.w);
            float ss = 0.f;
#pragma unroll
            for (int i = 0; i < 8; ++i) ss += x[i] * x[i];
            const float rs = 1.0f / sqrtf(dpp_sum16(ss) * (1.f / 128.f) + RMS_EPS);
            v4u w; w.x = pk2(x[0] * rs * ga[0], x[1] * rs * ga[1]); w.y = pk2(x[2] * rs * ga[2], x[3] * rs * ga[3]); w.z = pk2(x[4] * rs * gb[0], x[5] * rs * gb[1]); w.w = pk2(x[6] * rs * gb[2], x[7] * rs * gb[3]);
            *(GAS v4u*)(mix + (size_t)t * DM + j * 128 + 8 * kq) = w;
        }
    } else {
        const float* Y = (const float*)(ws + WS_Y); const float* BON = (const float*)(ws + WS_BON); const unsigned char* XS = ws + WS_XS; const bf16* ZB = (const bf16*)(ws + WS_ZB);
        const int head = j - 8, c4 = head * 64 + 4 * kq;
        const f32x4 lnw = *(const GAS f32x4*)(inp<I_LNW>() + layer * BW + c4), lnb = *(const GAS f32x4*)(inp<I_LNB>() + layer * BW + c4);
#pragma unroll 2
        for (int t0 = tb; t0 < te; t0 += 4) {
            const int t = t0 + tj;
            const f32x4 y = *(const GAS f32x4*)(Y + (size_t)t * BW + c4);
            const us4 g = *(const GAS us4*)(ZB + (size_t)t * 6144 + BW + c4);
            const f32x4 v = *(const GAS f32x4*)(XS + ((size_t)head * SEQ + t) * SREC + 1280 + kq * 16);
            const float bon = BON[t * 32 + head];
            const float mean = dpp_sum16((y[0] + y[1]) + (y[2] + y[3])) * (1.f / 64.f);
            const f32x4 d = y - mean;
            const float var = dpp_sum16((d[0] * d[0] + d[1] * d[1]) + (d[2] * d[2] + d[3] * d[3])) * (1.f / 64.f);
            const float rs = 1.0f / sqrtf(var + GN_EPS);
            float o[4];
#pragma unroll
            for (int i = 0; i < 4; ++i) o[i] = (d[i] * rs * lnw[i] + lnb[i] + bon * v[i]) * bf2f(g[i]);
            typedef unsigned u32x2_t __attribute__((ext_vector_type(2)));
            u32x2_t w; w.x = pk2(o[0], o[1]); w.y = pk2(o[2], o[3]);
            *(GAS u32x2_t*)(mix + (size_t)t * DM + 1024 + c4) = w;
        }
    }
}

constexpr int NPL = 15, NSCAN = 64;
constexpr int PH_FINAL = 2 * NPL, N_PHASES = PH_FINAL + 1;
struct Args { const float* in[N_INPUTS]; float* out; unsigned char* ws; int ph_lo, ph_hi; };
static_assert(sizeof(Args) == N_INPUTS * 8 + 24, "kernarg layout: in[i] at 8*i, out, ws, ph_lo, ph_hi");
__device__ __forceinline__ XcdBarrier bar_make(unsigned char* ws, volatile LAS unsigned* misc) { XcdBarrier b; b.bar = (unsigned*)(ws + WS_CTL) + CW_BAR; b.x = xb_xcc_id(); b.st = misc + 8; return b; }

extern __shared__ __attribute__((aligned(16))) unsigned char lds_[];
#define IN(k) (lo <= (k) && (k) < hi)
#define SEAM(k) do { if (IN(k) && IN((k) + 1)) { const Ctx cb_ = ctx_make(wave0); xcd_barrier(bar_make(cb_.ws, MISC), cb_.tid == 0); } } while (0)
#define WSP(T, off) ((T*)(c.ws + (off)))
#define SEAM5(k) do { if (IN(k) && IN((k) + 5)) { const Ctx cb_ = ctx_make(wave0); xcd_barrier(bar_make(cb_.ws, MISC), cb_.tid == 0); } } while (0)
#ifndef PROBE_PH
#define PROBE_PH 0
#define PROBE_REP 1
#endif
#ifndef REP_SCAN
#define REP_SCAN 1
#define REP_DSA 1
#define REP_ATT 1
#define REP_CONV 1
#endif
#define REPEAT(k) for (int rep_ = 0; rep_ < ((L == 0 && ((PROBE_PH >> (k)) & 1)) ? PROBE_REP : 1); ++rep_)
template <int L> __device__ __forceinline__ void layer_phases(const int lo, const int hi, const int wave0) {
    LAS unsigned char* lds = (LAS unsigned char*)lds_;
    volatile LAS unsigned* MISC = (volatile LAS unsigned*)(lds + MISC_OFF);
    constexpr int pb = L * NPL;
        if (IN(pb + 0)) REPEAT(0) { const Ctx c = ctx_make(wave0, L); layer_prologue(c.ws, (gu32*)(c.ws + WS_CTL), lds, c.l, c.gw, c.NGW, c.wave, c.lane);
            rmsnorm_rows_bf16(c.l == 0 ? inp<I_X>() : ARG_OUT, inp<I_NMG>() + (size_t)c.l * DM, WSP(bf16, WS_H), c.gw, c.NGW, c.lane); SEAM(pb + 0); }
        if (IN(pb + 1)) REPEAT(1) { const Ctx c = ctx_make(wave0, L);
            constexpr int NP = 14336;
            pg8::Gemm g{WSP(bf16, WS_H), WSP(bf16, WS_WIN), SEQ, NP, DM, DM, DM}; pg8::StaticOrder S; S.init(SEQ, NP, c.G, c.bx);
            pg8::EpiBf16x<0> E{WSP(bf16, WS_P), LDP, QA_SCALE, 4, QC_SCALE, C_QC / 256, C_QC / 256 + 4};
            pg8::gemm_phase<pg8::EpiBf16x<0>, pg8::StaticOrder, true, true>(lds + RING_OFF, g, S, E, c.tid);
            if (L == 1) {
                const Ctx c2 = ctx_make(wave0, L);
                pg8::Gemm g2{(const pg8::bf16_t*)(c2.ws + WS_H), (const pg8::bf16_t*)(c2.ws + WS_WIN) + (size_t)NP * DM, SEQ, 256, DM / 8, DM, DM}; pg8::SplitKOrder S2; S2.init(SEQ, 8, DM / 8, c2.G, c2.bx);
                pg8::EpiF32x E2{(float*)(c2.ws + WS_Y), 2048, nullptr};
                pg8::gemm_phase<pg8::EpiF32x, pg8::SplitKOrder, true, true>(lds + RING_OFF, g2, S2, E2, c2.tid);
            }
            SEAM(pb + 1);
        }
        if (IN(pb + 2)) REPEAT(2) { const Ctx c = ctx_make(wave0, L); lora_prep(WSP(bf16, WS_P), WSP(bf16, WS_AP), WSP(float, WS_Y), c.l, c.gw, c.NGW, c.lane);
            dsa_pretile(WSP(bf16, WS_P), c.ws, c.gw, c.NGW, c.lane);
            SEAM(pb + 2); }
        if (IN(pb + 3)) REPEAT(3) { const Ctx c = ctx_make(wave0, L);
            const int N2 = (c.l == 0) ? 6144 : 8192;
            pg8::Gemm g{WSP(bf16, WS_AP), WSP(bf16, WS_BT2), SEQ, N2, 256, 1024, 256}; pg8::LoraOrder S; S.init(SEQ, N2, c.G, c.bx);
            pg8::EpiLora E{WSP(float, WS_Z), WSP(bf16, WS_ZB)};
            pg8::gemm_phase<pg8::EpiLora, pg8::LoraOrder, true, true>(lds + RING_OFF, g, S, E, c.tid);
            SEAM(pb + 3);
        }
        if (IN(pb + 5)) REPEAT(5) {
            for (;;) {
                const Ctx c = ctx_make(wave0, L);
                volatile LAS unsigned* qslot = MISC + 16;
                if (c.tid == 0) qslot[0] = __hip_atomic_fetch_add((gu32*)(c.ws + WS_CTL) + CW_QUEUE + 64 * L + 16 * rep_, 1u, RLX_AGENT);
                __syncthreads();
                int item = (int)qslot[0];
                __syncthreads();
                constexpr int NPREP = 1024, NPREP0 = 256;
                if (item >= NPREP + NSCAN + 1536 + N_CONV_ITEMS) break;
                { int pi = -1;
                  if (item < NPREP0) pi = item; else if (item < NPREP0 + NSCAN) item -= NPREP0; else if (item < NPREP + NSCAN) pi = item - NSCAN; else item -= NPREP;
#if defined(PROBE_SKIP)
                  if (rep_ == 1) { const int cls = (pi >= 0) ? 0 : (item < NSCAN) ? 1 : (item < NSCAN + 256) ? 2 : (item < NSCAN + 1280) ? 3 : (item < NSCAN + 1536) ? 4 : 5; if ((PROBE_SKIP >> cls) & 1) continue; }
#endif
                  if (pi >= 0) {
                      rwkv_prep_item(c.ws, c.l, pi, c.wave, c.lane);
                      asm volatile("s_waitcnt vmcnt(0)" ::: "memory");
                      __syncthreads();
                      if (c.tid == 0) __hip_atomic_store((gu32*)(c.ws + WS_CTL) + CW_PREP + 1024 * L + pi, 1u, RLX_AGENT);
                      continue; } }
                if (item < NSCAN) scan_unit(c.ws, c.l, item, c.wave, c.lane, lds + RING_OFF);
                else if (item < NSCAN + 256) {
                    const int t0 = 32 * (NSCAN + 255 - item);
                    idx_scores_quad(WSP(bf16, WS_P), WSP(bf16, WS_KIF), WSP(float, WS_SC), t0 + 4 * c.wave, c.lane);
                    __syncthreads();
                    { LAS unsigned* hist = (LAS unsigned*)(lds + RING_OFF + c.wave * 16384);
#pragma unroll 1
                      for (int i = 0; i < 4; ++i) { const int row = t0 + 4 * c.wave + i; unsigned* bm = WSP(unsigned, WS_BM) + (size_t)row * 256;
                          if (row >= 256) topk_row(WSP(float, WS_SC) + (size_t)row * SEQ, row + 1, bm, hist, c.lane); else causal_bm_row(row, bm, c.lane); } }
                    asm volatile("s_waitcnt vmcnt(0)" ::: "memory");
                    __syncthreads();
                    if (c.tid == 0) __hip_atomic_fetch_add((gu32*)(c.ws + WS_CTL) + CW_RDY + 64 * (32 * L + (t0 >> 8)), 1u, RLX_AGENT);
                } else if (item >= NSCAN + 1536) {
                    LAS float* scr = (LAS float*)(lds + RING_OFF + c.wave * 16384);
                    const int ci = item - NSCAN - 1536;
                    const int per = (ci < N_CONV_BIG) ? CONV_PER_ITEM / NWAVES : CONV_PER_SMALL / NWAVES;
                    const int r0 = (ci < N_CONV_BIG) ? ci * CONV_PER_ITEM : N_CONV_BIG * CONV_PER_ITEM + (ci - N_CONV_BIG) * CONV_PER_SMALL;
#pragma unroll 1
                    for (int i = 0; i < per; ++i) conv_late_item(c.ws, c.l, r0 + c.wave * per + i, scr, c.lane);
                } else if (item >= NSCAN + 1280) {
                    { const Ctx c2 = ctx_make(wave0, L);
                      if (c2.tid == 0) { const unsigned x0 = xb_xcc_id() & 7u; unsigned got = 0u;
                          for (unsigned kx = 0; kx < 8u; ++kx) { const unsigned xx = (x0 + kx) & 7u;
                              const unsigned v = __hip_atomic_fetch_add((gu32*)(c2.ws + WS_CTL) + CW_AQ + 64 * (16 + 8 * L + xx), 1u, RLX_AGENT);
                              if (v < 32u) { got = xx * 32u + v; break; } }
                          qslot[1] = got; }
                      __syncthreads(); }
                    const int u = (int)qslot[1];
                    __syncthreads();
                    const int h = u >> 5, qb = 31 - (u & 31);
                    if (c.wave == 0) { gu32* rdy = (gu32*)(c.ws + WS_CTL) + CW_RDY + 64 * (32 * L + qb); gu32* tmo = (gu32*)(c.ws + WS_CTL) + CW_TMO; unsigned sp = 0u;
                        while ((unsigned)__builtin_amdgcn_readfirstlane(__hip_atomic_load(rdy, RLX_AGENT)) < 8u) { __builtin_amdgcn_s_sleep(2);
                            if ((++sp & 255u) == 0u) { if (__builtin_amdgcn_readfirstlane(__hip_atomic_load(tmo, RLX_AGENT)) != 0u) break; if (sp > (1u << 22)) { if (c.lane == 0) __hip_atomic_store(tmo, 1u, RLX_AGENT); break; } } }
                        __builtin_amdgcn_fence(__ATOMIC_ACQUIRE, "agent");
                        asm volatile("s_waitcnt vmcnt(0)" ::: "memory"); }
                    __syncthreads();
                    dsa_attn_unit(WSP(bf16, WS_P), WSP(unsigned, WS_BM), WSP(bf16, WS_KF), WSP(bf16, WS_VFR), WSP(bf16, WS_MIX), qb, h, lds + RING_OFF, (LAS float*)(lds + MISC_OFF + 1024 + c.wave * 256), c.wave, c.lane);
                } else {
                    { const Ctx c2 = ctx_make(wave0, L);
                      if (c2.tid == 0) { const unsigned x0 = xb_xcc_id() & 7u; unsigned got = 0u;
                          for (unsigned kx = 0; kx < 8u; ++kx) { const unsigned xx = (x0 + kx) & 7u;
                              const unsigned v = __hip_atomic_fetch_add((gu32*)(c2.ws + WS_CTL) + CW_AQ + 64 * (8 * L + xx), 1u, RLX_AGENT);
                              if (v < 128u) { got = xx * 128u + v; break; } }
                          qslot[1] = got; }
                      __syncthreads(); }
                    const int a = (int)qslot[1];
                    __syncthreads();
                    const int h = a >> 7, qb = 31 - ((a & 127) >> 2), m = (a >> 1) & 1, vh = a & 1;
                    attn_body::attn_unit<8>((2 * h + m) * 64, 1024 + (2 * h + m) * 64, 2048 + h * 128 + vh * 64, h * 128 + vh * 64, qb, WSP(const attn_body::bf16, WS_P), WSP(const attn_body::bf16, WS_P), WSP(const attn_body::bf16, WS_P),
                                            WSP(attn_body::bf16, m ? WS_O1 : WS_O0), (char*)lds_ + RING_OFF, c.tid);
                }
            }
#if defined(PROBE_UNIT)
            if (L == 0 && blockIdx.x == 0) { const Ctx c = ctx_make(wave0, L); const int t0 = 8160;
                if (PROBE_UNIT == 1 || PROBE_UNIT == 2) idx_scores_quad(WSP(bf16, WS_P), WSP(bf16, WS_KIF), WSP(float, WS_SC), t0 + 4 * c.wave, c.lane);
                __syncthreads();
                if (PROBE_UNIT == 1 || PROBE_UNIT == 3) { LAS unsigned* hist = (LAS unsigned*)(lds + RING_OFF + c.wave * 16384);
#pragma unroll 1
                    for (int i = 0; i < 4; ++i) { const int row = t0 + 4 * c.wave + i; topk_row(WSP(float, WS_SC) + (size_t)row * SEQ, row + 1, WSP(unsigned, WS_BM) + (size_t)row * 256, hist, c.lane); } }
                __syncthreads();
                if (PROBE_UNIT == 1 || PROBE_UNIT == 4) dsa_attn_wave(WSP(bf16, WS_P), WSP(unsigned, WS_BM), WSP(bf16, WS_KF), WSP(bf16, WS_VFR), WSP(bf16, WS_MIX), t0, c.wave, lds + RING_OFF + c.wave * 16384, (LAS float*)(lds + MISC_OFF + 1024 + c.wave * 256), c.lane);
                if (PROBE_UNIT == 5) scan_unit(c.ws, c.l, 0, c.wave, c.lane, lds + RING_OFF);
            }
#endif
            SEAM5(pb + 5);
        }
        if (IN(pb + 10)) REPEAT(10) { const Ctx c = ctx_make(wave0, L); finalize_mix(c.ws, (gu32*)(c.ws + WS_CTL), c.l, c.gw, c.NGW, c.lane); SEAM(pb + 10); }
        if (IN(pb + 11)) REPEAT(11) { const Ctx c = ctx_make(wave0, L);
            pg8::Gemm g{WSP(bf16, WS_MIX), WSP(bf16, WS_WOUT), SEQ, DM, DM, DM, DM}; pg8::StaticOrder S; S.init(SEQ, DM, c.G, c.bx);
            float* out = ARG_OUT; pg8::EpiF32xN E{out, DM, c.l == 0 ? inp<I_X>() : out, WSP(bf16, WS_H), (unsigned long long*)((gu32*)(c.ws + WS_CTL) + CW_SS + 16384 * L)};
            pg8::gemm_phase<pg8::EpiF32xN, pg8::StaticOrder, true, true>(lds + RING_OFF, g, S, E, c.tid);
            SEAM(pb + 11);
        }
        if (IN(pb + 13)) REPEAT(13) { const Ctx c = ctx_make(wave0, L);
            pg8::Gemm g{WSP(bf16, WS_H), WSP(bf16, WS_WUP), SEQ, DFF, DM, DM, DM}; pg8::StaticOrder S; S.init(SEQ, DFF, c.G, c.bx);
            pg8::EpiUpN E{WSP(bf16, WS_U), DFF, (const unsigned long long*)((gu32*)(c.ws + WS_CTL) + CW_SS + 16384 * L), 1.f / DM, RMS_EPS};
            pg8::gemm_phase<pg8::EpiUpN, pg8::StaticOrder, true, true>(lds + RING_OFF, g, S, E, c.tid);
            SEAM(pb + 13);
        }
        if (IN(pb + 14)) REPEAT(14) { const Ctx c = ctx_make(wave0, L);
            pg8::Gemm g{WSP(bf16, WS_U), WSP(bf16, WS_WDN), SEQ, DM, DFF, DFF, DFF}; pg8::StaticOrder S; S.init(SEQ, DM, c.G, c.bx);
            float* out = ARG_OUT; pg8::EpiF32x E{out, DM, out};
            pg8::gemm_phase<pg8::EpiF32x, pg8::StaticOrder, true, true>(lds + RING_OFF, g, S, E, c.tid);
            SEAM(pb + 14);
        }
    }
__global__ void __launch_bounds__(NWAVES * 64, 2) mk_fwd(Args args) {
    LAS unsigned char* lds = (LAS unsigned char*)lds_;
    volatile LAS unsigned* MISC = (volatile LAS unsigned*)(lds + MISC_OFF);
    for (int u = threadIdx.x; u < (LDS_BYTES - LDSCTL_OFF) / 4; u += NWAVES * 64) ((LAS unsigned*)(lds + LDSCTL_OFF))[u] = 0u;
    __syncthreads();
    const int lo = args.ph_lo, hi = args.ph_hi, wave0 = __builtin_amdgcn_readfirstlane((int)threadIdx.x >> 6);
    if (hi - lo > 1) (void)xcd_barrier_post((unsigned*)(ARG_WS + WS_CTL) + CW_BAR, MISC + 8);

    layer_phases<0>(lo, hi, wave0);
    layer_phases<1>(lo, hi, wave0);
    if (IN(PH_FINAL)) { const Ctx c = ctx_make(wave0); rmsnorm_rows_f32_inplace(ARG_OUT, inp<I_NFIN>(), c.gw, c.NGW, c.lane); }
#undef IN
#undef SEAM
#undef WSP
}

extern "C" void kernel_launch(void* const* d_in, const int* in_sizes, int n_in, void* d_out, int out_size, void* d_ws, size_t ws_size, hipStream_t stream) {
    static int grid = 0;
    if (grid == 0) {
        if (n_in != N_INPUTS || in_sizes[0] != SEQ * DM || out_size != SEQ * DM || ws_size < WS_END) {
            fprintf(stderr, "kernel_launch: unexpected shapes: n_in %d in0 %d out %d ws %zu (need %zu)\n", n_in, n_in > 0 ? in_sizes[0] : -1, out_size, ws_size, (size_t)WS_END); _exit(77); }
        int dev = 0, cus = 0;
        if (hipGetDevice(&dev) != hipSuccess || hipDeviceGetAttribute(&cus, hipDeviceAttributeMultiprocessorCount, dev) != hipSuccess) { grid = -1; return; }
        if (hipFuncSetAttribute((const void*)mk_fwd, hipFuncAttributeMaxDynamicSharedMemorySize, LDS_BYTES) != hipSuccess) { fprintf(stderr, "kernel_launch: hipFuncSetAttribute failed\n"); grid = -1; return; }
        (void)hipGetLastError();
        grid = cus;
    }
    if (grid < 0) return;
    if (hipMemsetAsync((char*)d_ws + WS_CTL, 0, CTL_ZERO_BYTES, stream) != hipSuccess) return;
    Args a{};
    for (int i = 0; i < N_INPUTS; ++i) a.in[i] = (const float*)d_in[i];
    a.out = (float*)d_out; a.ws = (unsigned char*)d_ws;
#ifndef MK_ONE_LAUNCH
#ifndef MK_MAXPH
#define MK_MAXPH N_PHASES
#endif
    for (int ph = 0; ph < MK_MAXPH; ++ph) { a.ph_lo = ph; a.ph_hi = ph + 1;
        hipLaunchKernelGGL(mk_fwd, dim3(grid), dim3(NWAVES * 64), LDS_BYTES, stream, a); }
#else
    a.ph_lo = 0; a.ph_hi = N_PHASES;
    hipLaunchKernelGGL(mk_fwd, dim3(grid), dim3(NWAVES * 64), LDS_BYTES, stream, a);
#endif
}
```

```cpp
#define MK_ONE_LAUNCH 1
#include <hip/hip_runtime.h>
#include <hip/hip_bf16.h>
#include <cstdio>
#include <cstdint>
#include <cmath>
#include <unistd.h>
namespace pg8 {
#define PG8_LAS __attribute__((address_space(3)))
typedef unsigned short bf16_t;
typedef short bf16x8 __attribute__((ext_vector_type(8)));
typedef float f32x4 __attribute__((ext_vector_type(4)));
typedef unsigned u32x4 __attribute__((ext_vector_type(4)));
constexpr int BM = 256, BK = 64, HALF = 128, HTB = HALF * BK * 2  , STAGE_BYTES = 8 * HTB, NXCD = 8, WGM = 8;

__host__ __device__ __forceinline__ int lds_byte(int r, int c) { const int st = (r >> 4) * 2 + (c >> 5), rr = r & 15, cc = c & 31, ob = rr * 64 + cc * 2; return st * 1024 + (ob ^ (((ob >> 9) & 1) << 5)); }
__host__ __device__ __forceinline__ void stage_rc(int b, int& R, int& C) { const int st = b / 1024, sb = b % 1024, swz = sb ^ (((sb >> 9) & 1) << 5); R = (st >> 1) * 16 + swz / 64; C = (st & 1) * 32 + (swz % 64) / 2; }
__host__ __device__ __forceinline__ int perm32(int rho) { const int n = rho >> 4, i = rho & 15; return 8 * (i >> 2) + 4 * n + (i & 3); }

struct Unit { int pm, pn; };
struct Gemm { const bf16_t* A; const bf16_t* Bt; int M, N, K, lda, ldb; };

struct StaticOrder {
    int nM, nN, nwg, G, c;
    __host__ __device__ void init(int M, int N, int G_, int c_) { nM = M / BM; nN = N / BM; nwg = nM * nN; G = G_; c = c_; }
    __host__ __device__ bool next(int i, Unit& u) const {
        const long L = (long)i * G + c; if (L >= nwg) return false;
        int wgid = (int)L; { const int q = nwg / NXCD, r = nwg % NXCD, xcd = wgid % NXCD, off = wgid / NXCD; wgid = (xcd < r ? xcd * (q + 1) : r * (q + 1) + (xcd - r) * q) + off; }
        const int nig = WGM * nN, gid = wgid / nig, fm = gid * WGM, gsz = (nM - fm) < WGM ? (nM - fm) : WGM;
        u.pm = fm + ((wgid % nig) % gsz); u.pn = (wgid % nig) / gsz; return true;
    }
    __device__ __forceinline__ void a_ready(const Unit&) const {}
    __device__ __forceinline__ size_t a_off(const Unit&) const { return 0; }
    __device__ __forceinline__ int b_tile(const Unit& u) const { return u.pn; }
    __device__ __forceinline__ size_t b_off(const Unit&) const { return 0; }
    __device__ __forceinline__ void done(const Unit&) const {}
};
struct SplitKOrder {
    int nM, NS, G, c; size_t wbytes;
    __host__ __device__ void init(int M, int ns, int kwin, int G_, int c_) { nM = M / BM; NS = ns; G = G_; c = c_; wbytes = (size_t)kwin * 2; }
    __host__ __device__ bool next(int i, Unit& u) const { const long L = (long)i * G + c; if (L >= (long)nM * NS) return false; u.pm = (int)(L / NS); u.pn = (int)(L % NS); return true; }
    __device__ __forceinline__ void a_ready(const Unit&) const {}
    __device__ __forceinline__ size_t a_off(const Unit& u) const { return (size_t)u.pn * wbytes; }
    __device__ __forceinline__ int b_tile(const Unit&) const { return 0; }
    __device__ __forceinline__ size_t b_off(const Unit& u) const { return (size_t)u.pn * wbytes; }
    __device__ __forceinline__ void done(const Unit&) const {}
};


__device__ __forceinline__ unsigned cvt_pk_bf16(float lo, float hi) { unsigned r; asm volatile("v_cvt_pk_bf16_f32 %0, %1, %2" : "=v"(r) : "v"(lo), "v"(hi)); return r; }
template <int MODE> struct EpiBf16x {
    static constexpr bool PERM = true, AFTER_DRAIN = false;
    bf16_t* O; int ldc; float sc; int nsc; float sc2; int lo2, hi2;
    __device__ __forceinline__ void operator()(const f32x4 (&acc)[2][2][4][2], const Unit& u, int wr, int wc, int fr, int fq) const {
        const int row0 = u.pm * BM + wr * 64 + fr, col0 = u.pn * BM + wc * 32 + 8 * fq;
        const float s = (MODE == 0) ? ((u.pn < nsc) ? sc : ((u.pn >= lo2 && u.pn < hi2) ? sc2 : 1.f)) : 1.f;
#pragma unroll
        for (int ai = 0; ai < 2; ++ai)
#pragma unroll
            for (int m = 0; m < 4; ++m) { bf16_t* rowp = O + (size_t)(row0 + ai * HALF + m * 16) * ldc + col0;
#pragma unroll
                for (int bj = 0; bj < 2; ++bj) { f32x4 v0 = acc[ai][bj][m][0], v1 = acc[ai][bj][m][1];
                    if (MODE == 0) { v0 = v0 * s; v1 = v1 * s; }
                    if (MODE == 1) {
#pragma unroll
                        for (int j = 0; j < 4; ++j) { const float a = fmaxf(v0[j], 0.f), b = fmaxf(v1[j], 0.f); v0[j] = a * a; v1[j] = b * b; } }
                    u32x4 w; w.x = cvt_pk_bf16(v0[0], v0[1]); w.y = cvt_pk_bf16(v0[2], v0[3]); w.z = cvt_pk_bf16(v1[0], v1[1]); w.w = cvt_pk_bf16(v1[2], v1[3]);
                    *(u32x4*)(rowp + bj * HALF) = w; } }
    }
};
struct EpiF32x {
    static constexpr bool PERM = false, AFTER_DRAIN = false;
    float* C; int ldc; const float* base;
    __device__ __forceinline__ void operator()(const f32x4 (&acc)[2][2][4][2], const Unit& u, int wr, int wc, int fr, int fq) const {
        const int row0 = u.pm * BM + wr * 64 + fr, col0 = u.pn * BM + wc * 32 + 4 * fq;
#pragma unroll
        for (int ai = 0; ai < 2; ++ai)
#pragma unroll
            for (int m = 0; m < 4; ++m) { const size_t off = (size_t)(row0 + ai * HALF + m * 16) * ldc + col0;
#pragma unroll
                for (int bj = 0; bj < 2; ++bj)
#pragma unroll
                    for (int n = 0; n < 2; ++n) { f32x4 v = acc[ai][bj][m][n]; if (base) v = v + *(const f32x4*)(base + off + bj * HALF + n * 16); *(f32x4*)(C + off + bj * HALF + n * 16) = v; }
                asm volatile("" ::: "memory"); }
    }
};

__device__ __forceinline__ float xor16_sum(float v) { auto rr = __builtin_amdgcn_permlane16_swap(__float_as_uint(v), __float_as_uint(v), false, false); return __uint_as_float(rr[0]) + __uint_as_float(rr[1]); }
__device__ __forceinline__ float xor32_sum(float v) { auto rr = __builtin_amdgcn_permlane32_swap(__float_as_uint(v), __float_as_uint(v), false, false); return __uint_as_float(rr[0]) + __uint_as_float(rr[1]); }
struct EpiF32xN {
    static constexpr bool PERM = true, AFTER_DRAIN = false;
    float* C; int ldc; const float* base; bf16_t* XB; unsigned long long* SS;
    __device__ __forceinline__ void operator()(const f32x4 (&acc)[2][2][4][2], const Unit& u, int wr, int wc, int fr, int fq) const {
        const int row0 = u.pm * BM + wr * 64 + fr, col0 = u.pn * BM + wc * 32 + 8 * fq;
#pragma unroll
        for (int ai = 0; ai < 2; ++ai)
#pragma unroll
            for (int m = 0; m < 4; ++m) { const int row = row0 + ai * HALF + m * 16; const size_t off = (size_t)row * ldc + col0; float s = 0.f;
#pragma unroll
                for (int bj = 0; bj < 2; ++bj) { f32x4 v0 = acc[ai][bj][m][0], v1 = acc[ai][bj][m][1];
                    v0 = v0 + *(const f32x4*)(base + off + bj * HALF); v1 = v1 + *(const f32x4*)(base + off + bj * HALF + 4);
                    *(f32x4*)(C + off + bj * HALF) = v0; *(f32x4*)(C + off + bj * HALF + 4) = v1;
                    s += (v0[0] * v0[0] + v0[1] * v0[1]) + (v0[2] * v0[2] + v0[3] * v0[3]) + (v1[0] * v1[0] + v1[1] * v1[1]) + (v1[2] * v1[2] + v1[3] * v1[3]);
                    u32x4 w; w.x = cvt_pk_bf16(v0[0], v0[1]); w.y = cvt_pk_bf16(v0[2], v0[3]); w.z = cvt_pk_bf16(v1[0], v1[1]); w.w = cvt_pk_bf16(v1[2], v1[3]);
                    *(u32x4*)(XB + off + bj * HALF) = w; }
                s = xor16_sum(s); s = xor32_sum(s);
                if (fq == 0) __hip_atomic_fetch_add(SS + row, (unsigned long long)(s * 16777216.f), __ATOMIC_RELAXED, __HIP_MEMORY_SCOPE_AGENT);
                asm volatile("" ::: "memory"); }
    }
};
struct EpiUpN {
    static constexpr bool PERM = true, AFTER_DRAIN = false;
    bf16_t* O; int ldc; const unsigned long long* SS; float inv_n, eps;
    __device__ __forceinline__ void operator()(const f32x4 (&acc)[2][2][4][2], const Unit& u, int wr, int wc, int fr, int fq) const {
        const int row0 = u.pm * BM + wr * 64 + fr, col0 = u.pn * BM + wc * 32 + 8 * fq;
#pragma unroll
        for (int ai = 0; ai < 2; ++ai)
#pragma unroll
            for (int m = 0; m < 4; ++m) { const int row = row0 + ai * HALF + m * 16; bf16_t* rowp = O + (size_t)row * ldc + col0;
                const float rstd = 1.0f / sqrtf((float)SS[row] * (inv_n * (1.f / 16777216.f)) + eps);
#pragma unroll
                for (int bj = 0; bj < 2; ++bj) { f32x4 v0 = acc[ai][bj][m][0] * rstd, v1 = acc[ai][bj][m][1] * rstd;
#pragma unroll
                    for (int j = 0; j < 4; ++j) { const float a = fmaxf(v0[j], 0.f), b = fmaxf(v1[j], 0.f); v0[j] = a * a; v1[j] = b * b; }
                    u32x4 w; w.x = cvt_pk_bf16(v0[0], v0[1]); w.y = cvt_pk_bf16(v0[2], v0[3]); w.z = cvt_pk_bf16(v1[0], v1[1]); w.w = cvt_pk_bf16(v1[2], v1[3]);
                    *(u32x4*)(rowp + bj * HALF) = w; } }
    }
};

struct EpiLora {
    static constexpr bool PERM = true, AFTER_DRAIN = false;
    float* ZW; bf16_t* ZB;
    __device__ __forceinline__ void operator()(const f32x4 (&acc)[2][2][4][2], const Unit& u, int wr, int wc, int fr, int fq) const {
        const int row0 = u.pm * BM + wr * 64 + fr, col0 = u.pn * BM + wc * 32 + 8 * fq;
        if (u.pn < 8) {
#pragma unroll
            for (int ai = 0; ai < 2; ++ai)
#pragma unroll
                for (int m = 0; m < 4; ++m) { float* rowp = ZW + (size_t)(row0 + ai * HALF + m * 16) * 2048 + col0;
#pragma unroll
                    for (int bj = 0; bj < 2; ++bj) { *(f32x4*)(rowp + bj * HALF) = acc[ai][bj][m][0]; *(f32x4*)(rowp + bj * HALF + 4) = acc[ai][bj][m][1]; }
                    asm volatile("" ::: "memory"); }
        } else {
#pragma unroll
            for (int ai = 0; ai < 2; ++ai)
#pragma unroll
                for (int m = 0; m < 4; ++m) { bf16_t* rowp = ZB + (size_t)(row0 + ai * HALF + m * 16) * 6144 + (col0 - 2048);
#pragma unroll
                    for (int bj = 0; bj < 2; ++bj) { const f32x4 v0 = acc[ai][bj][m][0], v1 = acc[ai][bj][m][1];
                        u32x4 w; w.x = cvt_pk_bf16(v0[0], v0[1]); w.y = cvt_pk_bf16(v0[2], v0[3]); w.z = cvt_pk_bf16(v1[0], v1[1]); w.w = cvt_pk_bf16(v1[2], v1[3]);
                        *(u32x4*)(rowp + bj * HALF) = w; }
                    asm volatile("" ::: "memory"); }
        }
    }
};
struct LoraOrder : StaticOrder {
    __device__ __forceinline__ size_t a_off(const Unit& u) const { return (size_t)(u.pn >> 3) * 256 * 2; }
};
template <class Epi, class Sched, bool ALIGN_EPI = false, bool SP2 = false>
__device__ __forceinline__ void gemm_phase(PG8_LAS unsigned char* lds, const Gemm g, const Sched& S, const Epi& E, const int tid) {
    const int wid = __builtin_amdgcn_readfirstlane(tid >> 6), lane = tid & 63, wr = wid >> 2, wc = wid & 3, fr = lane & 15, fq = lane >> 4;
    const int K = g.K, nt = K / BK;
    unsigned voffA[2], voffB[2];
#pragma unroll
    for (int i = 0; i < 2; ++i) { int R, C; stage_rc(tid * 16 + i * 8192, R, C); const int Rb = Epi::PERM ? ((R & ~31) + perm32(R & 31)) : R;
        voffA[i] = (unsigned)(R * g.lda + C) * 2u; voffB[i] = (unsigned)(Rb * g.ldb + C) * 2u; }
    const size_t kstep = (size_t)(BK * 2);
    const size_t hA = (size_t)HALF * g.lda * 2, hB = (size_t)HALF * g.ldb * 2;
    const size_t tA = 2 * hA, tB = 2 * hB;
    const unsigned ldsw = (unsigned)wid * 1024u;
    const int aoff = lds_byte(wr * 64 + fr, fq * 8), boff = lds_byte(wc * 32 + fr, fq * 8);
#define PG8_SA(b, h) (((b) * 2 + (h)) * HTB)
#define PG8_SB(b, h) ((4 + (b) * 2 + (h)) * HTB)
#define PG8_STAGE(bufoff, gbase, voff) do { _Pragma("unroll") for (int _i = 0; _i < 2; ++_i) \
        __builtin_amdgcn_global_load_lds((const unsigned*)((const char*)(gbase) + (voff)[_i]), (PG8_LAS unsigned*)(lds + (bufoff) + ldsw + _i * 8192), 16, 0, 0); } while (0)
#define PG8_LDA(dst, b, h) do { _Pragma("unroll") for (int m = 0; m < 4; ++m) _Pragma("unroll") for (int k = 0; k < 2; ++k) dst[m][k] = *(const PG8_LAS bf16x8*)(lds + PG8_SA(b, h) + aoff + m * 2048 + k * 1024); } while (0)
#define PG8_LDB(dst, b, h) do { _Pragma("unroll") for (int n = 0; n < 2; ++n) _Pragma("unroll") for (int k = 0; k < 2; ++k) dst[n][k] = *(const PG8_LAS bf16x8*)(lds + PG8_SB(b, h) + boff + n * 2048 + k * 1024); } while (0)
#define PG8_MMA(ai, bj, At, Bt) do { __builtin_amdgcn_s_setprio(1); _Pragma("unroll") for (int m = 0; m < 4; ++m) _Pragma("unroll") for (int n = 0; n < 2; ++n) _Pragma("unroll") for (int k = 0; k < 2; ++k) \
        acc[ai][bj][m][n] = __builtin_amdgcn_mfma_f32_16x16x32_bf16(Bt[n][k], At[m][k], acc[ai][bj][m][n], 0, 0, 0); __builtin_amdgcn_s_setprio(0); } while (0)
#define PG8_WAIT_V(n) asm volatile("s_waitcnt vmcnt(" #n ")" ::: "memory")
#define PG8_WAIT_L(n) asm volatile("s_waitcnt lgkmcnt(" #n ")" ::: "memory")
#define PG8_BAR __builtin_amdgcn_s_barrier()
#define PG8_SCHED __builtin_amdgcn_sched_barrier(0)
    Unit cur, nxt; int ui = 0;
    if (!S.next(0, cur)) return;
    f32x4 acc[2][2][4][2];
#pragma unroll
    for (int a = 0; a < 2; ++a)
#pragma unroll
        for (int b = 0; b < 2; ++b)
#pragma unroll
            for (int m = 0; m < 4; ++m)
#pragma unroll
                for (int n = 0; n < 2; ++n) acc[a][b][m][n] = (f32x4){0.f, 0.f, 0.f, 0.f};
    bf16x8 At[4][2], B0[2][2], B1[2][2];
    const char* cA = (const char*)g.A + (size_t)cur.pm * tA + S.a_off(cur); const char* cB = (const char*)g.Bt + (size_t)S.b_tile(cur) * tB + S.b_off(cur);
    S.a_ready(cur);
    if constexpr (SP2) {
        PG8_STAGE(PG8_SB(0, 0), cB, voffB); PG8_STAGE(PG8_SB(0, 1), cB + hB, voffB); PG8_STAGE(PG8_SA(0, 0), cA, voffA); PG8_STAGE(PG8_SA(0, 1), cA + hA, voffA);
        if (wr == 1) PG8_BAR;
        PG8_WAIT_V(2); PG8_BAR;
        PG8_STAGE(PG8_SB(1, 0), cB + kstep, voffB); PG8_STAGE(PG8_SA(1, 0), cA + kstep, voffA); PG8_STAGE(PG8_SB(1, 1), cB + hB + kstep, voffB);
        PG8_WAIT_V(6); PG8_BAR;
    } else {
        PG8_STAGE(PG8_SB(0, 0), cB, voffB); PG8_STAGE(PG8_SA(0, 0), cA, voffA); PG8_STAGE(PG8_SB(0, 1), cB + hB, voffB); PG8_STAGE(PG8_SA(0, 1), cA + hA, voffA);
        if (wr == 1) PG8_BAR;
        PG8_WAIT_V(4); PG8_BAR;
        PG8_STAGE(PG8_SB(1, 0), cB + kstep, voffB); PG8_STAGE(PG8_SA(1, 0), cA + kstep, voffA); PG8_STAGE(PG8_SB(1, 1), cB + hB + kstep, voffB);
        PG8_WAIT_V(6); PG8_BAR;
    }
    for (;;) {
        const bool has_next = S.next(ui + 1, nxt);
        const char* nA = has_next ? (const char*)g.A + (size_t)nxt.pm * tA + S.a_off(nxt) : cA; const char* nB = has_next ? (const char*)g.Bt + (size_t)S.b_tile(nxt) * tB + S.b_off(nxt) : cB;
        for (int t = 0; t < nt; t += 2) {
            const bool last = (t == nt - 2);
            const char* a1 = cA + (size_t)(t + 1) * kstep;
            const char* a2 = last ? nA : cA + (size_t)(t + 2) * kstep; const char* b2 = last ? nB : cB + (size_t)(t + 2) * kstep;
            const char* a3 = a2 + kstep; const char* b3 = b2 + kstep;
            if (last && has_next) S.a_ready(nxt);
            if constexpr (SP2) {
            PG8_LDB(B0, 0, 0); PG8_LDB(B1, 0, 1); PG8_SCHED; PG8_LDA(At, 0, 0); PG8_STAGE(PG8_SA(1, 1), a1 + hA, voffA);
            PG8_WAIT_V(8); PG8_WAIT_L(0); PG8_BAR; PG8_MMA(0, 0, At, B0); PG8_MMA(0, 1, At, B1); PG8_BAR; PG8_SCHED;
            PG8_LDA(At, 0, 1); PG8_STAGE(PG8_SB(0, 0), b2, voffB); PG8_STAGE(PG8_SB(0, 1), b2 + hB, voffB); PG8_STAGE(PG8_SA(0, 0), a2, voffA);
            PG8_WAIT_V(8); PG8_WAIT_L(0); PG8_BAR; PG8_MMA(1, 0, At, B0); PG8_MMA(1, 1, At, B1); PG8_BAR; PG8_SCHED;
            PG8_LDB(B0, 1, 0); PG8_LDB(B1, 1, 1); PG8_SCHED; PG8_LDA(At, 1, 0); PG8_STAGE(PG8_SA(0, 1), a2 + hA, voffA);
            PG8_WAIT_V(8); PG8_WAIT_L(0); PG8_BAR; PG8_MMA(0, 0, At, B0); PG8_MMA(0, 1, At, B1); PG8_BAR; PG8_SCHED;
            PG8_LDA(At, 1, 1); PG8_STAGE(PG8_SB(1, 0), b3, voffB); PG8_STAGE(PG8_SB(1, 1), b3 + hB, voffB); PG8_STAGE(PG8_SA(1, 0), a3, voffA);
            PG8_WAIT_V(8); PG8_WAIT_L(0); PG8_BAR; PG8_MMA(1, 0, At, B0); PG8_MMA(1, 1, At, B1); PG8_BAR; PG8_SCHED;
            } else {
            PG8_LDB(B0, 0, 0); PG8_SCHED; PG8_LDA(At, 0, 0); PG8_STAGE(PG8_SA(1, 1), a1 + hA, voffA);
            PG8_WAIT_L(8); PG8_BAR; PG8_WAIT_L(0); PG8_MMA(0, 0, At, B0); PG8_BAR; PG8_SCHED;
            PG8_LDB(B1, 0, 1); PG8_STAGE(PG8_SB(0, 0), b2, voffB);
            PG8_BAR; PG8_WAIT_L(0); PG8_MMA(0, 1, At, B1); PG8_BAR;
            PG8_LDA(At, 0, 1); PG8_STAGE(PG8_SA(0, 0), a2, voffA);
            PG8_BAR; PG8_WAIT_L(0); PG8_MMA(1, 0, At, B0); PG8_BAR; PG8_SCHED;
            PG8_STAGE(PG8_SB(0, 1), b2 + hB, voffB);
            PG8_WAIT_V(6); PG8_BAR; PG8_MMA(1, 1, At, B1); PG8_BAR;
            PG8_LDB(B0, 1, 0); PG8_SCHED; PG8_LDA(At, 1, 0); PG8_STAGE(PG8_SA(0, 1), a2 + hA, voffA);
            PG8_WAIT_L(8); PG8_BAR; PG8_WAIT_L(0); PG8_MMA(0, 0, At, B0); PG8_BAR; PG8_SCHED;
            PG8_LDB(B1, 1, 1); PG8_STAGE(PG8_SB(1, 0), b3, voffB);
            PG8_BAR; PG8_WAIT_L(0); PG8_MMA(0, 1, At, B1); PG8_BAR;
            PG8_LDA(At, 1, 1); PG8_STAGE(PG8_SA(1, 0), a3, voffA);
            PG8_BAR; PG8_WAIT_L(0); PG8_MMA(1, 0, At, B0); PG8_BAR; PG8_SCHED;
            PG8_STAGE(PG8_SB(1, 1), b3 + hB, voffB);
            PG8_WAIT_V(6); PG8_BAR; PG8_MMA(1, 1, At, B1); PG8_BAR;
            }
        }
        if constexpr (ALIGN_EPI) { if (wr == 0) PG8_BAR; }
        if constexpr (!Epi::AFTER_DRAIN) { E(acc, cur, wr, wc, fr, fq); S.done(cur); }
        if (!has_next) break;
#pragma unroll
        for (int a = 0; a < 2; ++a)
#pragma unroll
            for (int b = 0; b < 2; ++b)
#pragma unroll
                for (int m = 0; m < 4; ++m)
#pragma unroll
                    for (int n = 0; n < 2; ++n) acc[a][b][m][n] = (f32x4){0.f, 0.f, 0.f, 0.f};
        cur = nxt; cA = nA; cB = nB; ++ui;
        if constexpr (ALIGN_EPI) { if (wr == 1) PG8_BAR; }
    }
    PG8_WAIT_V(0);
    if constexpr (!ALIGN_EPI) { if (wr == 0) PG8_BAR; }
    PG8_BAR;
    if constexpr (Epi::AFTER_DRAIN) { E.fused(acc, cur, wr, wc, fr, fq, lds, wid, lane); S.done(cur); }
#undef PG8_SA
#undef PG8_SB
#undef PG8_STAGE
#undef PG8_LDA
#undef PG8_LDB
#undef PG8_MMA
#undef PG8_WAIT_V
#undef PG8_WAIT_L
#undef PG8_BAR
#undef PG8_SCHED
}
}
#include <hip/hip_bf16.h>
#include <cmath>
namespace attn_body {
using bf16=__hip_bfloat16;
using bf16x8=__attribute__((ext_vector_type(8)))short;
using s16x4=__attribute__((ext_vector_type(4)))short;
using f32x16=__attribute__((ext_vector_type(16)))float;
using u32x4=__attribute__((ext_vector_type(4)))unsigned;
constexpr int SEQ=8192,D=64,DM=14592,DO=1024;
constexpr int NW=8,QBLK=32,QB=QBLK*NW,KVBLK=64,NQB=SEQ/QB;
constexpr int ATTN_UNIT_ROWS=QB;
__device__ __forceinline__ int crow(int r,int hi){return (r&3)+8*(r>>2)+4*hi;}
#define SBAR() __builtin_amdgcn_sched_barrier(0)
__device__ __forceinline__ void cmask(f32x16&p0,f32x16&p1,int jb,int qrel,int hi){
  const float NEG=-INFINITY; int kb=64*jb+4*hi;
  #pragma unroll
  for(int r=0;r<16;++r){int kv=kb+(r&3)+8*(r>>2); if(kv>qrel)p0[r]=NEG; if(kv+32>qrel)p1[r]=NEG;}
}

constexpr int NSLOT=3, SLOTB=8192;
constexpr int LDS_K=0, LDS_V=NSLOT*SLOTB, LDS_WS=2*NSLOT*SLOTB, LDS_OST=LDS_WS+NW*64*4, LDS_BYTES=LDS_OST+NW*4096;
constexpr float C2=0.125f*1.4426950408889634f;
__device__ __forceinline__ void glds16(const void*sbase,unsigned voff,unsigned lds_dst){unsigned keep;
  asm volatile("s_mov_b32 %0, m0\n\ts_mov_b32 m0, %3\n\ts_nop 0\n\tglobal_load_lds_dwordx4 %1, %2\n\ts_mov_b32 m0, %0":"=&s"(keep):"v"(voff),"s"(sbase),"s"(lds_dst):"memory");}
__device__ __forceinline__ float max3f(float a,float b,float c){float r;asm("v_max3_f32 %0, %1, %2, %3":"=v"(r):"v"(a),"v"(b),"v"(c));return r;}
__device__ __forceinline__ float max2f(float a,float b){float r;asm("v_max_f32_e32 %0, %1, %2":"=v"(r):"v"(a),"v"(b));return r;}
__device__ __forceinline__ float fadd_s(float a,float b){float r;asm("v_add_f32_e32 %0, %1, %2":"=v"(r):"v"(a),"v"(b));return r;}
__device__ __forceinline__ float fsub_s(float a,float b){float r;asm("v_sub_f32_e32 %0, %1, %2":"=v"(r):"v"(a),"v"(b));return r;}
typedef float f32x2_t __attribute__((ext_vector_type(2))); typedef __bf16 bf16x2_t __attribute__((ext_vector_type(2)));
__device__ __forceinline__ unsigned cvtpk_s(float lo,float hi){f32x2_t v={lo,hi};bf16x2_t b=__builtin_convertvector(v,bf16x2_t);return __builtin_bit_cast(unsigned,b);}
#define WAIT_BAR(N) asm volatile("s_waitcnt vmcnt(" #N ") lgkmcnt(0)\n\ts_barrier":::"memory")

__device__ __forceinline__ void qkt(f32x16&p0,f32x16&p1,const char*Kslot,const bf16x8*qr,const f32x16&negm,int r32,int hi){
  const char*kb=Kslot+hi*1024+r32*16;
  #pragma unroll
  for(int d0=0;d0<4;++d0){
    const bf16x8 b0=*reinterpret_cast<const bf16x8*>(kb+d0*2048);
    const bf16x8 b1=*reinterpret_cast<const bf16x8*>(kb+d0*2048+512);
    if(d0==0){p0=__builtin_amdgcn_mfma_f32_32x32x16_bf16(b0,qr[0],negm,0,0,0);p1=__builtin_amdgcn_mfma_f32_32x32x16_bf16(b1,qr[0],negm,0,0,0);}
    else{p0=__builtin_amdgcn_mfma_f32_32x32x16_bf16(b0,qr[d0],p0,0,0,0);p1=__builtin_amdgcn_mfma_f32_32x32x16_bf16(b1,qr[d0],p1,0,0,0);}}
}
typedef __attribute__((address_space(3))) const char* lds_cptr;
typedef short v4i16_t __attribute__((ext_vector_type(4)));
__device__ __forceinline__ void kload8(bf16x8*kf,lds_cptr kp){
  kf[0]=*(const __attribute__((address_space(3))) bf16x8*)(kp);      kf[1]=*(const __attribute__((address_space(3))) bf16x8*)(kp+512);
  kf[2]=*(const __attribute__((address_space(3))) bf16x8*)(kp+2048); kf[3]=*(const __attribute__((address_space(3))) bf16x8*)(kp+2560);
  kf[4]=*(const __attribute__((address_space(3))) bf16x8*)(kp+4096); kf[5]=*(const __attribute__((address_space(3))) bf16x8*)(kp+4608);
  kf[6]=*(const __attribute__((address_space(3))) bf16x8*)(kp+6144); kf[7]=*(const __attribute__((address_space(3))) bf16x8*)(kp+6656);
}
__device__ __forceinline__ void kload2(bf16x8*kf,lds_cptr kp,int j){ kf[2*j]=*(const __attribute__((address_space(3))) bf16x8*)(kp+j*2048); kf[2*j+1]=*(const __attribute__((address_space(3))) bf16x8*)(kp+j*2048+512); }
__device__ __forceinline__ s16x4 vtr(lds_cptr p){ return __builtin_bit_cast(s16x4,__builtin_amdgcn_ds_read_tr16_b64_v4i16((__attribute__((address_space(3))) v4i16_t*)p)); }
__device__ __forceinline__ float rowmax(const f32x16&p0,const f32x16&p1){
  float a=max3f(p0[0],p0[1],p1[0]),b=max3f(p0[2],p0[3],p1[1]);a=max3f(a,p1[2],p1[3]);
  #pragma unroll
  for(int r=4;r<16;r+=4){a=max3f(a,p0[r],p0[r+1]);b=max3f(b,p0[r+2],p0[r+3]);a=max3f(a,p1[r],p1[r+1]);b=max3f(b,p1[r+2],p1[r+3]);}
  const float m=max2f(a,b);
  auto rr=__builtin_amdgcn_permlane32_swap(__float_as_uint(m),__float_as_uint(m),false,false);
  return max2f(__uint_as_float(rr[0]),__uint_as_float(rr[1]));
}
__device__ __forceinline__ void pv(f32x16*o,int vb,bf16x8 pa0,bf16x8 pa1,bf16x8 pa2,bf16x8 pa3){
  #pragma unroll
  for(int d0=0;d0<2;++d0){s16x4 lo[4],hi[4];
    #pragma unroll
    for(int ks=0;ks<4;++ks){
      asm volatile("ds_read_b64_tr_b16 %0,%1 offset:%c2":"=&v"(lo[ks]):"v"(vb),"i"(d0*4096+ks*1024):"memory");
      asm volatile("ds_read_b64_tr_b16 %0,%1 offset:%c2":"=&v"(hi[ks]):"v"(vb),"i"(d0*4096+ks*1024+512):"memory");}
    asm volatile("s_waitcnt lgkmcnt(0)":::"memory");SBAR();
    #define PK(k) (bf16x8){lo[k][0],lo[k][1],lo[k][2],lo[k][3],hi[k][0],hi[k][1],hi[k][2],hi[k][3]}
    o[d0]=__builtin_amdgcn_mfma_f32_32x32x16_bf16(pa0,PK(0),o[d0],0,0,0);
    o[d0]=__builtin_amdgcn_mfma_f32_32x32x16_bf16(pa1,PK(1),o[d0],0,0,0);
    o[d0]=__builtin_amdgcn_mfma_f32_32x32x16_bf16(pa2,PK(2),o[d0],0,0,0);
    o[d0]=__builtin_amdgcn_mfma_f32_32x32x16_bf16(pa3,PK(3),o[d0],0,0,0);
    #undef PK
  }
}

#ifndef ATTN_STORE16
#define ATTN_STORE16(p,v) (*(u32x4*)(p)=(v))
#endif
template<int THRL> __device__ __forceinline__ void attn_unit(int qc,int kc,int vc,int oc,int qb,const bf16*Q,const bf16*__restrict__ K,const bf16*__restrict__ V,bf16*O,char*shm,const int tid){
  const int lane=tid&63,r32=lane&31,hi=lane>>5; const int wid=__builtin_amdgcn_readfirstlane(tid>>6);
  const long rowbase=0; const int q0=qb*QB;
  const bf16*Qw=Q+(rowbase+q0+wid*QBLK)*DM+qc;
  const bf16*Kh=K+rowbase*DM+kc,*Vh=V+rowbase*DM+vc;
  const unsigned lds0=(unsigned)(uintptr_t)shm;
  float*wsf=(float*)(shm+LDS_WS)+wid*64;
  const unsigned koff=(unsigned)(lane*DM+wid*8)*2u;
  const unsigned voff=(unsigned)((16*(wid&3)+(lane>>2))*DM+(wid>>2)*32+(lane&3)*8)*2u;
  const unsigned kdst=lds0+LDS_K+wid*1024, vdst=lds0+LDS_V+wid*1024;
  #define DMA_K(t,slot) glds16((const char*)Kh+(size_t)(t)*(KVBLK*DM*2),koff,(unsigned)__builtin_amdgcn_readfirstlane(kdst+(slot)))
  #define DMA_V(t,slot) glds16((const char*)Vh+(size_t)(t)*(KVBLK*DM*2),voff,(unsigned)__builtin_amdgcn_readfirstlane(vdst+(slot)))
  const int vb0=(int)(lds0+LDS_V)+((lane>>4)&1)*32+(lane&3)*8+(4*hi+((lane&15)>>2))*64;
  const char*Kbase=shm+LDS_K; bf16x8 kf[8];
  const lds_cptr shm3=(lds_cptr)shm; const lds_cptr kp0=shm3+LDS_K+hi*1024+r32*16; const lds_cptr vp0=shm3+LDS_V+((lane>>4)&1)*32+(lane&3)*8+(4*hi+((lane&15)>>2))*64;
  const int NT=(q0+QB)/KVBLK;
  DMA_K(0,0);DMA_V(0,0);DMA_K(1,SLOTB);
  bf16x8 qr[4];
  #pragma unroll
  for(int d0=0;d0<4;++d0)qr[d0]=*reinterpret_cast<const bf16x8*>(&Qw[(long)r32*DM+d0*16+hi*8]);
  float mhat=0.f,l_reg=0.f;f32x16 o[2];o[0]=f32x16{};o[1]=f32x16{};f32x16 negm=f32x16{};asm volatile("":"+v"(negm));
  const int qrel=wid*QBLK+r32;
  #define CMASK(P0,P1,t) do{int jb_=(t)-(NT-4); if(jb_>=0)cmask(P0,P1,jb_,qrel,hi);}while(0)
  bool resc=false;
  #define START(P0,P1) do{ const float rm=rowmax(P0,P1); resc=false; \
    { const float dl=rm; mhat=fadd_s(mhat,dl); \
      _Pragma("unroll") for(int r=0;r<16;++r){P0[r]=fsub_s(P0[r],dl);P1[r]=fsub_s(P1[r],dl);} \
      _Pragma("unroll") for(int r=0;r<16;++r)negm[r]=-mhat; asm volatile("":"+v"(negm)); } \
    _Pragma("unroll") for(int r=0;r<16;++r)P0[r]=__builtin_amdgcn_exp2f(P0[r]); }while(0)
  #define RESC() do{ if(resc){ asm volatile("s_waitcnt lgkmcnt(0)":::"memory"); \
      _Pragma("unroll") for(int d_=0;d_<2;++d_) _Pragma("unroll") for(int r=0;r<16;++r)o[d_][r]*=wsf[crow(r,hi)]; } }while(0)
  f32x16 pA0,pA1,pB0,pB1;
  int sl_prev=0,sl_cur=0,sl_next=SLOTB;
  #define ROT() do{sl_prev=sl_cur;sl_cur=sl_next;sl_next=(sl_next==(NSLOT-1)*SLOTB)?0:sl_next+SLOTB;}while(0)
  DMA_K(2,2*SLOTB);
  WAIT_BAR(3);
  qkt(pA0,pA1,Kbase,qr,negm,r32,hi);asm volatile("s_nop 15\n\ts_nop 7":"+v"(pA0),"+v"(pA1));CMASK(pA0,pA1,0);
  START(pA0,pA1);
  _Pragma("unroll") for(int r=0;r<16;++r)pA1[r]=__builtin_amdgcn_exp2f(pA1[r]);
  WAIT_BAR(0);
  DMA_K(3,0);DMA_V(1,SLOTB);
  ROT();
  kload8(kf,kp0+sl_cur);
  WAIT_BAR(2);
  s16x4 vlo[8],vhi[8]; u32x4 pw0,pw1,pw2,pw3;
  #define PKW(P,B) cvtpk_s(P[B],P[B+1])
  #define PAF(k) __builtin_bit_cast(bf16x8,pw##k)
  #define VFR(i) (bf16x8){vlo[i][0],vlo[i][1],vlo[i][2],vlo[i][3],vhi[i][0],vhi[i][1],vhi[i][2],vhi[i][3]}
  #define PIN(x) asm volatile("":"+v"(x))
  #define MX3(a,b,c) __builtin_fmaxf(__builtin_fmaxf((a),(b)),(c))
  #define GAPA(MF,A0,A1,A2,A3,W0,W1,PW) do{ MF; sacc+=A0; sacc+=A1; sacc+=A2; sacc+=A3; PIN(sacc); W0; W1; PIN(PW); SBAR(); }while(0)
  #define EX(v) __builtin_amdgcn_exp2f(v)
  #define GAPB(MF,X,B) do{ MF; X[B]=EX(X[B]); X[B+1]=EX(X[B+1]); X[B+2]=EX(X[B+2]); X[B+3]=EX(X[B+3]); PIN(X); SBAR(); }while(0)
  #define VRD(i) do{ vlo[i]=vtr(vp_+(((i)>>2)*4096+((i)&3)*1024)); vhi[i]=vtr(vp_+(((i)>>2)*4096+((i)&3)*1024+512)); }while(0)
  #define KRD(G,j) do{ if(G){ kload2(kf,kp0+sl_next,j); SBAR(); } }while(0)
  #define STEP(C0,C1,P0,P1,t,GK,GV,GL) do{ SBAR(); \
    const lds_cptr vp_=vp0+sl_prev; \
    VRD(0); SBAR(); float sacc=(P0[0]+P0[1]); \
    GAPA(C0=__builtin_amdgcn_mfma_f32_32x32x16_bf16(kf[0],qr[0],negm,0,0,0), P0[2],P0[3],P0[4],P0[5],     pw0[0]=PKW(P0,0), pw0[1]=PKW(P0,2), pw0); \
    VRD(4); SBAR(); GAPA(C1=__builtin_amdgcn_mfma_f32_32x32x16_bf16(kf[1],qr[0],negm,0,0,0), P0[6],P0[7],P0[8],P0[9],     pw0[2]=PKW(P0,4), pw0[3]=PKW(P0,6), pw0); \
    VRD(1); SBAR(); GAPA(C0=__builtin_amdgcn_mfma_f32_32x32x16_bf16(kf[2],qr[1],C0,0,0,0),   P0[10],P0[11],P0[12],P0[13], pw1[0]=PKW(P0,8), pw1[1]=PKW(P0,10), pw1); \
    VRD(5); SBAR(); GAPA(C1=__builtin_amdgcn_mfma_f32_32x32x16_bf16(kf[3],qr[1],C1,0,0,0),   P0[14],P0[15],P1[0],P1[1],   pw1[2]=PKW(P0,12),pw1[3]=PKW(P0,14), pw1); \
    VRD(2); SBAR(); GAPA(C0=__builtin_amdgcn_mfma_f32_32x32x16_bf16(kf[4],qr[2],C0,0,0,0),   P1[2],P1[3],P1[4],P1[5],     pw2[0]=PKW(P1,0), pw2[1]=PKW(P1,2), pw2); \
    VRD(6); SBAR(); GAPA(C1=__builtin_amdgcn_mfma_f32_32x32x16_bf16(kf[5],qr[2],C1,0,0,0),   P1[6],P1[7],P1[8],P1[9],     pw2[2]=PKW(P1,4), pw2[3]=PKW(P1,6), pw2); \
    VRD(3); SBAR(); GAPA(C0=__builtin_amdgcn_mfma_f32_32x32x16_bf16(kf[6],qr[3],C0,0,0,0),   P1[10],P1[11],P1[12],P1[13], pw3[0]=PKW(P1,8), pw3[1]=PKW(P1,10), pw3); \
    VRD(7); SBAR(); GAPA(C1=__builtin_amdgcn_mfma_f32_32x32x16_bf16(kf[7],qr[3],C1,0,0,0),   P1[14],P1[15],0.f,0.f,       pw3[2]=PKW(P1,12),pw3[3]=PKW(P1,14), pw3); \
    l_reg+=sacc; \
    if(GK){DMA_K((t)+3,sl_cur);} if(GV){DMA_V((t)+1,sl_next);} \
    CMASK(C0,C1,t); \
    { float a=MX3(C0[0],C0[1],C1[0]),b=MX3(C0[2],C0[3],C1[1]); a=MX3(a,C1[2],C1[3]); \
      _Pragma("unroll") for(int r=4;r<16;r+=4){a=MX3(a,C0[r],C0[r+1]);b=MX3(b,C0[r+2],C0[r+3]);a=MX3(a,C1[r],C1[r+1]);b=MX3(b,C1[r+2],C1[r+3]);} \
      float rm=__builtin_fmaxf(a,b); { auto rr=__builtin_amdgcn_permlane32_swap(__float_as_uint(rm),__float_as_uint(rm),false,false); rm=__builtin_fmaxf(__uint_as_float(rr[0]),__uint_as_float(rr[1])); } \
      resc=false; \
      if(__builtin_expect(__any(rm>(float)THRL),0)){ const float dl=__builtin_fmaxf(rm,0.f); mhat+=dl; \
        _Pragma("unroll") for(int r=0;r<16;++r){C0[r]-=dl;C1[r]-=dl;} \
        _Pragma("unroll") for(int r=0;r<16;++r)negm[r]=-mhat; asm volatile("":"+v"(negm)); \
        const float f=__builtin_amdgcn_exp2f(-dl); l_reg*=f; if(hi==0)wsf[r32]=f; resc=true; } } \
    SBAR(); \
    GAPB(o[0]=__builtin_amdgcn_mfma_f32_32x32x16_bf16(PAF(0),VFR(0),o[0],0,0,0), C0,0); \
    GAPB(o[1]=__builtin_amdgcn_mfma_f32_32x32x16_bf16(PAF(0),VFR(4),o[1],0,0,0), C0,4); \
    KRD(GL,0); GAPB(o[0]=__builtin_amdgcn_mfma_f32_32x32x16_bf16(PAF(1),VFR(1),o[0],0,0,0), C0,8); \
    KRD(GL,1); GAPB(o[1]=__builtin_amdgcn_mfma_f32_32x32x16_bf16(PAF(1),VFR(5),o[1],0,0,0), C0,12); \
    KRD(GL,2); GAPB(o[0]=__builtin_amdgcn_mfma_f32_32x32x16_bf16(PAF(2),VFR(2),o[0],0,0,0), C1,0); \
    KRD(GL,3); GAPB(o[1]=__builtin_amdgcn_mfma_f32_32x32x16_bf16(PAF(2),VFR(6),o[1],0,0,0), C1,4); \
    GAPB(o[0]=__builtin_amdgcn_mfma_f32_32x32x16_bf16(PAF(3),VFR(3),o[0],0,0,0), C1,8); \
    GAPB(o[1]=__builtin_amdgcn_mfma_f32_32x32x16_bf16(PAF(3),VFR(7),o[1],0,0,0), C1,12); \
    }while(0)
  int t=1;
  #undef CMASK
  #define CMASK(P0,P1,t) do{}while(0)
  for(;t+5<NT;t+=2){
    STEP(pB0,pB1,pA0,pA1,t,true,true,true);     WAIT_BAR(2); RESC(); ROT();
    STEP(pA0,pA1,pB0,pB1,t+1,true,true,true);   WAIT_BAR(2); RESC(); ROT();
  }
  #undef CMASK
  #define CMASK(P0,P1,t) do{int jb_=(t)-(NT-4); if(jb_>=0)cmask(P0,P1,jb_,qrel,hi);}while(0)
  #define ENDW(tt) do{ if((tt)+3<NT){WAIT_BAR(2);} else if((tt)+2<NT){WAIT_BAR(1);} else {WAIT_BAR(0);} }while(0)
  for(;t+1<NT;t+=2){
    STEP(pB0,pB1,pA0,pA1,t,(t+3<NT),(t+1<NT),(t+1<NT));       ENDW(t);   RESC(); ROT();
    STEP(pA0,pA1,pB0,pB1,t+1,(t+4<NT),(t+2<NT),(t+2<NT));     ENDW(t+1); RESC(); ROT();
  }
  STEP(pB0,pB1,pA0,pA1,NT-1,false,false,false); RESC();
  { float sacc=pB0[0]+pB0[1]; _Pragma("unroll") for(int r=2;r<16;++r)sacc+=pB0[r]; _Pragma("unroll") for(int r=0;r<16;++r)sacc+=pB1[r]; l_reg+=sacc;
    pw0=(u32x4){PKW(pB0,0),PKW(pB0,2),PKW(pB0,4),PKW(pB0,6)};pw1=(u32x4){PKW(pB0,8),PKW(pB0,10),PKW(pB0,12),PKW(pB0,14)};pw2=(u32x4){PKW(pB1,0),PKW(pB1,2),PKW(pB1,4),PKW(pB1,6)};pw3=(u32x4){PKW(pB1,8),PKW(pB1,10),PKW(pB1,12),PKW(pB1,14)};
    SBAR(); pv(o,vb0+sl_cur,PAF(0),PAF(1),PAF(2),PAF(3)); }
  #undef PKW
  #undef PAF
  #undef VFR
  #undef PIN
  #undef MX3
  #undef GAPA
  #undef GAPB
  #undef EX
  #undef VRD
  #undef KRD
  #undef STEP
  #undef ENDW
  {auto rr=__builtin_amdgcn_permlane32_swap(__float_as_uint(l_reg),__float_as_uint(l_reg),false,false);l_reg=__uint_as_float(rr[0])+__uint_as_float(rr[1]);}
  if(hi==0)wsf[32+r32]=l_reg;asm volatile("s_waitcnt lgkmcnt(0)":::"memory");
  float rli[16];
  #pragma unroll
  for(int r=0;r<16;++r)rli[r]=__builtin_amdgcn_rcpf(wsf[32+crow(r,hi)]);
  bf16*Ow=O+(rowbase+q0+wid*QBLK)*DO+oc;
  { bf16*stg=(bf16*)(shm+LDS_OST)+wid*2048;
    #pragma unroll
    for(int r=0;r<16;++r){const int orow=crow(r,hi);
      #pragma unroll
      for(int d0=0;d0<2;++d0)stg[orow*64+d0*32+r32]=__float2bfloat16(o[d0][r]*rli[r]);}
    asm volatile("s_waitcnt lgkmcnt(0)":::"memory");
    #pragma unroll
    for(int i=0;i<4;++i){const int row=i*8+(lane>>3),ch=lane&7; const u32x4 v=*(const u32x4*)(stg+row*64+ch*8); ATTN_STORE16(Ow+(long)row*DO+ch*8,v);} }
  asm volatile("s_waitcnt lgkmcnt(0)\n\ts_barrier":::"memory");
  #undef DMA_K
  #undef DMA_V
  #undef CMASK
  #undef START
  #undef RESC
  #undef ROT
}
constexpr int ATTN_LDS_BYTES=LDS_BYTES;
struct AttnTensors { const bf16* Q; const bf16* K; const bf16* V; bf16* O0; bf16* O1; };
struct AttnUnit { int bh; int qb; };
struct StaticOrder {
  int vcu;
  __device__ __forceinline__ explicit StaticOrder(int grid_,int block):vcu((grid_%8==0)?(block%8)*(grid_/8)+block/8:block),grid(grid_){}
  int grid;
  __device__ __forceinline__ bool next(int i,AttnUnit&u)const{ const int v=vcu+(i>>2)*grid; if(v>=256)return false; const int s=v&7,j=i&3; u.bh=v>>3; u.qb=(j==0)?s:(j==1)?15-s:(j==2)?16+s:31-s; return true; }
  __device__ __forceinline__ void a_ready(const AttnUnit&)const{}
  __device__ __forceinline__ void done(const AttnUnit&)const{}
};
template<class Sched,int THRL=8> __device__ __forceinline__ void attn_phase(char*lds,const AttnTensors&T,const Sched&S,const int tid){
  AttnUnit u;
  for(int i=0;S.next(i,u);++i){ S.a_ready(u); const int h=u.bh>>2,m=(u.bh>>1)&1,vh=u.bh&1; attn_unit<THRL>((2*h+m)*64,1024+(2*h+m)*64,2048+h*128+vh*64,h*128+vh*64,u.qb,T.Q,T.K,T.V,m?T.O1:T.O0,lds,tid); S.done(u); }
}
#undef SBAR
#undef WAIT_BAR
}
#define GAS __attribute__((address_space(1)))
#define LAS __attribute__((address_space(3)))
typedef unsigned short bf16;
typedef unsigned v4u __attribute__((ext_vector_type(4)));
typedef float f32x4 __attribute__((ext_vector_type(4)));
typedef short bf16x8 __attribute__((ext_vector_type(8)));
typedef GAS unsigned gu32;
typedef GAS unsigned long long gu64;
#define RLX_AGENT __ATOMIC_RELAXED, __HIP_MEMORY_SCOPE_AGENT
#define LDS_WAIT() asm volatile("s_waitcnt lgkmcnt(0)" ::: "memory")
#define VM_WAIT() asm volatile("s_waitcnt vmcnt(0)" ::: "memory")
__device__ __forceinline__ unsigned long long rt() { return __builtin_amdgcn_s_memrealtime(); }
typedef float pk_f32x2_t __attribute__((ext_vector_type(2))); typedef __bf16 pk_bf16x2_t __attribute__((ext_vector_type(2)));
__device__ __forceinline__ unsigned pk2(float lo, float hi) { const pk_f32x2_t v = {lo, hi}; return __builtin_bit_cast(unsigned, __builtin_convertvector(v, pk_bf16x2_t)); }
__device__ __forceinline__ unsigned f2bf(float f) { return pk2(f, 0.f) & 0xffffu; }

#define XB_TMO      128
#define XB_XCNT(j)  (256  + 64 * (j))
#define XB_XSUB(j)  (1280 + 64 * (j))
#define XB_XGEN(j)  (2304 + 64 * (j))
#define XB_TOP      3328
#define XB_TOPGEN   3392
#define XCD_BAR_WORDS 3456
#define XB_SPIN_CAP (1u << 18)

__device__ __forceinline__ unsigned xb_ld(unsigned* p)              { return __hip_atomic_load(p, __ATOMIC_RELAXED, __HIP_MEMORY_SCOPE_AGENT); }
__device__ __forceinline__ unsigned xb_add(unsigned* p, unsigned v) { return __hip_atomic_fetch_add(p, v, __ATOMIC_RELAXED, __HIP_MEMORY_SCOPE_AGENT); }
__device__ __forceinline__ unsigned xb_xcc_id() { return (unsigned)__builtin_amdgcn_s_getreg((3 << 11) | 20) & 0xFu; }
#define XB_SPIN(cond, bar) do { unsigned _sp = 0; while (cond) { __builtin_amdgcn_s_sleep(1); \
    if ((++_sp & 255u) == 0u) { if (xb_ld(&(bar)[XB_TMO])) break; if (_sp > XB_SPIN_CAP) { atomicAdd(&(bar)[XB_TMO], 1u); break; } } } } while (0)

struct XcdBarrier {
    unsigned* bar; unsigned x;
    volatile LAS unsigned* st;
};

__device__ __forceinline__ XcdBarrier xcd_barrier_post(unsigned* bar, volatile LAS unsigned* st) {
    XcdBarrier b; b.bar = bar; b.x = xb_xcc_id(); b.st = st;
    if (threadIdx.x == 0) (void)xb_add(&bar[XB_XCNT(b.x)], 1u);
    return b;
}
__device__ __forceinline__ void xcd_barrier_complete(unsigned* bar, unsigned x, unsigned& nloc, unsigned& nx) {
    const unsigned G = gridDim.x * gridDim.y * gridDim.z;
    unsigned sum, cnt, mine, sp = 0u;
    for (;;) {
        sum = 0u; cnt = 0u; mine = 0u;
#pragma unroll
        for (unsigned j = 0; j < 16; ++j) { const unsigned c = xb_ld(&bar[XB_XCNT(j)]); sum += c; cnt += (c > 0u) ? 1u : 0u; mine = (j == x) ? c : mine; }
        if (sum == G) break;
        __builtin_amdgcn_s_sleep(1);
        if ((++sp & 255u) == 0u) { if (xb_ld(&bar[XB_TMO])) break; if (sp > XB_SPIN_CAP) { atomicAdd(&bar[XB_TMO], 1u); break; } }
    }
    nloc = mine > 0u ? mine : 1u; nx = cnt > 0u ? cnt : 1u;
}

__device__ __forceinline__ void xcd_barrier(const XcdBarrier& b, const bool leader_thread) {
    asm volatile("s_waitcnt vmcnt(0)" ::: "memory");
    __syncthreads();
    if (leader_thread) {
        unsigned* bar = b.bar;
        __builtin_amdgcn_s_waitcnt(0);
        unsigned nloc = b.st[0], nx = b.st[1];
        if (nloc == 0u) { xcd_barrier_complete(bar, b.x, nloc, nx); b.st[0] = nloc; b.st[1] = nx; }
        const unsigned old = xb_add(&bar[XB_XSUB(b.x)], 1u);
        const unsigned gen = old / nloc;
        if (old + 1u == (gen + 1u) * nloc) {
            __builtin_amdgcn_fence(__ATOMIC_RELEASE, "agent");
            asm volatile("s_waitcnt vmcnt(0)" ::: "memory");
            const unsigned og = xb_add(&bar[XB_TOP], 1u);
            const unsigned tg = og / nx;
            if (og + 1u == (tg + 1u) * nx) xb_add(&bar[XB_TOPGEN], 1u);
            else XB_SPIN(xb_ld(&bar[XB_TOPGEN]) == tg, bar);
            __builtin_amdgcn_fence(__ATOMIC_ACQUIRE, "agent");
            xb_add(&bar[XB_XGEN(b.x)], 1u);
            asm volatile("s_waitcnt vmcnt(0)" ::: "memory");
        } else {
            XB_SPIN(xb_ld(&bar[XB_XGEN(b.x)]) == gen, bar);
            __builtin_amdgcn_fence(__ATOMIC_ACQUIRE, "agent");
            asm volatile("s_waitcnt vmcnt(0)" ::: "memory");
        }
    }
    __syncthreads();
}

constexpr int SEQ = 8192, DM = 4096, DIN = 13392, LDP = 14592, DFF = 16384, BW = 2048;
constexpr int C_QA = 0, C_KA = 1024, C_VA = 2048, C_RB = 3072, C_KB = 5120, C_VB = 7168, C_QC = 9216, C_KC = 10240, C_VC = 11264, C_QI = 12288, C_KI = 13312, C_WI = 13376;
constexpr int C_LWH = 13392, C_LWS = 13488, C_LAH = 13584, C_LAS = 13680, C_LGH = 13776, C_LGS = 14032, C_LVH = 14288, C_LVS = 14352;
constexpr float RMS_EPS = 1e-6f, GN_EPS = 64e-5f;
constexpr float QA_SCALE = 0.125f * 1.4426950408889634f;
constexpr float QC_SCALE = 0.08838834764831845f * 1.4426950408889634f;

enum { I_X = 0, I_NMG, I_WIN, I_LQ1, I_LK1, I_LQ2, I_LK2, I_SUBLN, I_MURKV, I_MUWAG, I_W0, I_W1, I_W2, I_A0, I_A1, I_A2, I_G1, I_G2, I_KK, I_KA, I_RK, I_LNW, I_LNB,
       I_VMU, I_V0, I_V1, I_V2, I_WOUT, I_NFG, I_WUP, I_WDN, I_NFIN, N_INPUTS };

constexpr size_t MiB = 1u << 20;
constexpr size_t WS_CTL = 0, CTL_ZERO_BYTES = 1 * MiB;
constexpr size_t SZ_WIN = (size_t)LDP * DM * 2, SZ_WOUT = (size_t)DM * DM * 2, SZ_WFF = (size_t)DFF * DM * 2, SZ_BT2 = (size_t)8192 * 256 * 2;
constexpr size_t WS_WIN = 2 * MiB;
constexpr size_t WS_WOUT = WS_WIN + SZ_WIN;
constexpr size_t WS_WUP = WS_WOUT + SZ_WOUT;
constexpr size_t WS_WDN = WS_WUP + SZ_WFF;
constexpr size_t WS_BT2 = WS_WDN + SZ_WFF;
constexpr size_t SZ_SB = (size_t)SEQ * BW * 4;
constexpr size_t WS_VF = WS_BT2 + SZ_BT2;
constexpr size_t WS_H = WS_VF + SZ_SB;
constexpr size_t WS_MIX = WS_H + (size_t)SEQ * DM * 2;
constexpr size_t WS_P = WS_MIX + (size_t)SEQ * DM * 2;
constexpr size_t WS_AP = WS_P + (size_t)SEQ * LDP * 2;
constexpr size_t WS_Z = WS_AP + (size_t)SEQ * 1024 * 2;
constexpr size_t WS_ZB = WS_Z + (size_t)SEQ * 2048 * 4;
constexpr size_t WS_U = WS_Z;
constexpr int SREC = 6 * 64 * 4;
constexpr size_t WS_XS = WS_Z + (size_t)SEQ * 8192 * 4;
constexpr size_t WS_BON = WS_XS + (size_t)32 * SEQ * SREC;
constexpr size_t WS_Y = WS_BON + (size_t)SEQ * 32 * 4;
constexpr size_t WS_O0 = WS_Y + SZ_SB, WS_O1 = WS_O0 + (size_t)SEQ * 1024 * 2;
constexpr size_t WS_SC = WS_O1 + (size_t)SEQ * 1024 * 2;
constexpr size_t WS_BM = WS_SC + (size_t)SEQ * SEQ * 4;
constexpr size_t WS_KF = WS_BM + (size_t)SEQ * 256 * 4;
constexpr size_t WS_VFR = WS_KF + (size_t)16 * MiB;
constexpr size_t WS_KIF = WS_VFR + (size_t)16 * MiB;
constexpr size_t WS_END = WS_KIF + (size_t)1 * MiB;
static_assert(WS_END <= 2040 * MiB && (size_t)SEQ * DFF * 2 <= (size_t)SEQ * 8192 * 4, "d_ws map must fit the 2 GiB workspace");
constexpr int CW_TMO = 0, CW_CODE = 1, CW_LAM = 16;
constexpr int CW_BAR = 4096;
constexpr int CW_RDY = 16384;
constexpr int CW_PREP = 32768;
constexpr int CW_SS = 65536;
constexpr int CW_AQ = 12288;
constexpr int CW_QUEUE = 8192;

constexpr int RING_OFF = 0, RING_BYTES = 131072;
constexpr int LDSCTL_OFF = RING_BYTES, MISC_OFF = LDSCTL_OFF + 320;
constexpr int LDS_BYTES = 147456;
constexpr int NWAVES = 8;

__device__ __forceinline__ float bf2f(unsigned short b) { return __uint_as_float(((unsigned)b) << 16); }
__device__ __forceinline__ float bflo(unsigned w) { return __uint_as_float(w << 16); }
__device__ __forceinline__ float bfhi(unsigned w) { return __uint_as_float(w & 0xffff0000u); }
#define DPPF(v, ctrl) __builtin_bit_cast(float, __builtin_amdgcn_update_dpp(0, __builtin_bit_cast(int, (v)), (ctrl), 0xF, 0xF, false))
#define DPPF_ROWS(old, v, ctrl, rows) __builtin_bit_cast(float, __builtin_amdgcn_update_dpp(__builtin_bit_cast(int, (old)), __builtin_bit_cast(int, (v)), (ctrl), (rows), 0xF, false))
__device__ __forceinline__ float dpp_sum16(float v) {
    v += DPPF(v, 0xB1);
    v += DPPF(v, 0x4E);
    v += DPPF(v, 0x141);
    v += DPPF(v, 0x140);
    return v;
}
__device__ __forceinline__ float dpp_max16(float v) {
    v = fmaxf(v, DPPF(v, 0xB1)); v = fmaxf(v, DPPF(v, 0x4E)); v = fmaxf(v, DPPF(v, 0x141)); v = fmaxf(v, DPPF(v, 0x140));
    return v;
}
__device__ __forceinline__ float wave_sum(float v) {
    v = dpp_sum16(v);
    v += DPPF_ROWS(0.f, v, 0x142, 0xA);
    v += DPPF_ROWS(0.f, v, 0x143, 0xC);
    return __builtin_bit_cast(float, __builtin_amdgcn_readlane(__builtin_bit_cast(int, v), 63));
}
__device__ __forceinline__ float wave_max(float v) {
    v = dpp_max16(v);
    v = fmaxf(v, DPPF_ROWS(v, v, 0x142, 0xA));
    v = fmaxf(v, DPPF_ROWS(v, v, 0x143, 0xC));
    return __builtin_bit_cast(float, __builtin_amdgcn_readlane(__builtin_bit_cast(int, v), 63));
}
__device__ __forceinline__ float swap32_sum(float v) {
    auto rr = __builtin_amdgcn_permlane32_swap(__float_as_uint(v), __float_as_uint(v), false, false);
    return __uint_as_float(rr[0]) + __uint_as_float(rr[1]);
}
__device__ __forceinline__ unsigned bperm_u32(unsigned v, int src_lane) { return (unsigned)__builtin_amdgcn_ds_bpermute(src_lane << 2, (int)v); }
__device__ __forceinline__ float sigmoidf_(float x) { return 1.0f / (1.0f + __expf(-x)); }

__device__ __forceinline__ void transpose_item(const float* W, int N, bf16* WT, int ldk, int row_off, const float* ks, int mode, LAS float* scr, int item, int lane) {
    const int nblk = (N + 31) >> 5, kb = item / nblk, nb = item - kb * nblk, k0 = 64 * kb, n0 = 32 * nb;
    const int n_r = n0 + (lane & 31);
#pragma unroll
    for (int i = 0; i < 32; ++i) { const int kk = 2 * i + (lane >> 5); float v = 0.f;
        if (n_r < N) v = W[(size_t)(k0 + kk) * N + n_r];
        scr[kk * 33 + (lane & 31)] = v; }
    LDS_WAIT(); asm volatile("" ::: "memory");
    const int c = lane & 7;
    float f[8];
#pragma unroll
    for (int j = 0; j < 8; ++j) f[j] = 1.f;
    if (mode) { const f32x4 fa = *(const GAS f32x4*)(ks + k0 + 8 * c), fb = *(const GAS f32x4*)(ks + k0 + 8 * c + 4);
#pragma unroll
        for (int j = 0; j < 4; ++j) { f[j] = (mode == 1) ? (1.f - fa[j]) : fa[j]; f[4 + j] = (mode == 1) ? (1.f - fb[j]) : fb[j]; } }
#pragma unroll
    for (int j = 0; j < 4; ++j) { const int n = (lane >> 3) + 8 * j; const LAS float* s = scr + (8 * c) * 33 + n;
        v4u o; o.x = pk2(s[0 * 33] * f[0], s[1 * 33] * f[1]); o.y = pk2(s[2 * 33] * f[2], s[3 * 33] * f[3]); o.z = pk2(s[4 * 33] * f[4], s[5 * 33] * f[5]); o.w = pk2(s[6 * 33] * f[6], s[7 * 33] * f[7]);
        if (n0 + n < N) *(GAS v4u*)(WT + (size_t)(row_off + n0 + n) * ldk + k0 + 8 * c) = o; }
    LDS_WAIT(); asm volatile("" ::: "memory");
}

template <int OFF> __device__ __forceinline__ unsigned long long karg64() {
    auto kp = __builtin_amdgcn_kernarg_segment_ptr(); unsigned long long v;
    asm volatile("s_load_dwordx2 %0, %1, %2\n\ts_waitcnt lgkmcnt(0)" : "=s"(v) : "s"(kp), "n"(OFF) : "memory");
    return v;
}
template <int IDX_> __device__ __forceinline__ const float* inp() { return (const float*)(const GAS float*)karg64<IDX_ * 8>(); }
#define ARG_OUT ((float*)(GAS float*)karg64<N_INPUTS * 8>())
#define ARG_WS ((unsigned char*)(GAS unsigned char*)karg64<N_INPUTS * 8 + 8>())
struct Ctx { int tid, lane, wave, G, bx, vcu, gw, NGW, l; unsigned char* ws; };
__device__ __forceinline__ Ctx ctx_make(int wave, int layer = 0) {
    Ctx c; int ln; asm volatile("v_mbcnt_lo_u32_b32 %0, -1, 0\n\tv_mbcnt_hi_u32_b32 %0, -1, %0" : "=v"(ln)); int g = gridDim.x, b = blockIdx.x; asm volatile("" : "+s"(g), "+s"(b), "+s"(wave));
    c.tid = wave * 64 + ln; c.lane = ln; c.wave = wave; c.G = g; c.bx = b;
    c.vcu = (g % 8 == 0) ? (b % 8) * (g / 8) + b / 8 : b; c.gw = c.vcu * NWAVES + c.wave; c.NGW = g * NWAVES; c.ws = ARG_WS; asm volatile("" : "+s"(layer)); c.l = layer; return c;
}

constexpr int IT_IN = (DM / 64) * ((DIN + 31) / 32), IT_L96 = (DM / 64) * 3, IT_L256 = (DM / 64) * 8, IT_L64 = (DM / 64) * 2;
constexpr int IT_OUT = (DM / 64) * (DM / 32), IT_UP = (DM / 64) * (DFF / 32), IT_DN = (DFF / 64) * (DM / 32);
constexpr int IT_PRO = IT_IN + 4 * IT_L96 + 2 * IT_L256 + 2 * IT_L64;
constexpr int IT_LATE = IT_OUT + IT_UP + IT_DN, CONV_PER_ITEM = 128, N_CONV_BIG = 448, CONV_PER_SMALL = 32, N_CONV_ITEMS = N_CONV_BIG + (IT_LATE - N_CONV_BIG * CONV_PER_ITEM) / CONV_PER_SMALL;
static_assert((IT_LATE - N_CONV_BIG * CONV_PER_ITEM) % CONV_PER_SMALL == 0 && IT_LATE > N_CONV_BIG * CONV_PER_ITEM, "conversion items");
__device__ __forceinline__ void conv_late_item(unsigned char* ws, const int l, int r, LAS float* scr, int lane) {
    if (r < IT_OUT) { transpose_item(inp<I_WOUT>() + (size_t)l * DM * DM, DM, (bf16*)(ws + WS_WOUT), DM, 0, nullptr, 0, scr, r, lane); return; } r -= IT_OUT;
    if (r < IT_UP) { transpose_item(inp<I_WUP>() + (size_t)l * DM * DFF, DFF, (bf16*)(ws + WS_WUP), DM, 0, inp<I_NFG>() + (size_t)l * DM, 2, scr, r, lane); return; } r -= IT_UP;
    transpose_item(inp<I_WDN>() + (size_t)l * DFF * DM, DM, (bf16*)(ws + WS_WDN), DFF, 0, nullptr, 0, scr, r, lane);
}
__device__ __forceinline__ void layer_prologue(unsigned char* ws, gu32* ctl, LAS unsigned char* lds, const int l, int gw, int NGW, int wave, int lane) {
    LAS float* scr = (LAS float*)(lds + RING_OFF + wave * 16384);
    for (int it = gw; it < IT_PRO; it += NGW) {
        int r = it;
        bf16* Wi = (bf16*)(ws + WS_WIN);
        const float* mu = inp<I_MUWAG>() + (size_t)l * 3 * DM;
        if (r < IT_IN) { transpose_item(inp<I_WIN>() + (size_t)l * DM * DIN, DIN, Wi, DM, 0, nullptr, 0, scr, r, lane); continue; } r -= IT_IN;
        if (r < IT_L96) { transpose_item(inp<I_W1>() + (size_t)l * DM * 96, 96, Wi, DM, C_LWH, mu, 1, scr, r, lane); continue; } r -= IT_L96;
        if (r < IT_L96) { transpose_item(inp<I_W1>() + (size_t)l * DM * 96, 96, Wi, DM, C_LWS, mu, 2, scr, r, lane); continue; } r -= IT_L96;
        if (r < IT_L96) { transpose_item(inp<I_A1>() + (size_t)l * DM * 96, 96, Wi, DM, C_LAH, mu + DM, 1, scr, r, lane); continue; } r -= IT_L96;
        if (r < IT_L96) { transpose_item(inp<I_A1>() + (size_t)l * DM * 96, 96, Wi, DM, C_LAS, mu + DM, 2, scr, r, lane); continue; } r -= IT_L96;
        if (r < IT_L256) { transpose_item(inp<I_G1>() + (size_t)l * DM * 256, 256, Wi, DM, C_LGH, mu + 2 * DM, 1, scr, r, lane); continue; } r -= IT_L256;
        if (r < IT_L256) { transpose_item(inp<I_G1>() + (size_t)l * DM * 256, 256, Wi, DM, C_LGS, mu + 2 * DM, 2, scr, r, lane); continue; } r -= IT_L256;
        if (r < IT_L64) { if (l == 1) transpose_item(inp<I_V1>(), 64, Wi, DM, C_LVH, inp<I_VMU>(), 1, scr, r, lane); continue; } r -= IT_L64;
        if (l == 1) transpose_item(inp<I_V1>(), 64, Wi, DM, C_LVS, inp<I_VMU>(), 2, scr, r, lane);
    }
    for (int i = gw * 64 + lane; i < 8192 * 32; i += NGW * 64) {
        const int n = i >> 5, k8 = i & 31, grp = n >> 11, c = n & 2047;
        const float* src; int rank;
        if (grp == 0) { src = inp<I_W2>() + (size_t)l * 96 * BW; rank = 96; }
        else if (grp == 1) { src = inp<I_A2>() + (size_t)l * 96 * BW; rank = 96; }
        else if (grp == 2) { src = inp<I_G2>() + (size_t)l * 256 * BW; rank = 256; }
        else { src = inp<I_V2>(); rank = (l == 1) ? 64 : 0; }
        float v[8];
#pragma unroll
        for (int e = 0; e < 8; ++e) { const int k = 8 * k8 + e; v[e] = (k < rank) ? src[(size_t)k * BW + c] : 0.f; }
        v4u o; o.x = pk2(v[0], v[1]); o.y = pk2(v[2], v[3]); o.z = pk2(v[4], v[5]); o.w = pk2(v[6], v[7]);
        *(GAS v4u*)((bf16*)(ws + WS_BT2) + (size_t)n * 256 + 8 * k8) = o;
    }
    if (gw == 0) {
        const float a = wave_sum(inp<I_LQ1>()[l * 64 + lane] * inp<I_LK1>()[l * 64 + lane]), b = wave_sum(inp<I_LQ2>()[l * 64 + lane] * inp<I_LK2>()[l * 64 + lane]);
        const float lam_init = 0.8f - 0.6f * expf(-0.3f * (float)l);
        if (lane == 0) __hip_atomic_store(ctl + CW_LAM + l, __float_as_uint(expf(a) - expf(b) + lam_init), RLX_AGENT); }
}

__device__ __forceinline__ void rmsnorm_rows_bf16(const float* src, const float* g, bf16* dst, int gw, int NGW, int lane) {
    for (int m = gw; m < SEQ; m += NGW) {
        const GAS f32x4* xr = (const GAS f32x4*)(src + (size_t)m * DM) + lane; const GAS f32x4* gr = (const GAS f32x4*)g + lane;
        f32x4 v[16]; float s = 0.f;
#pragma unroll
        for (int j = 0; j < 16; ++j) { v[j] = xr[64 * j]; s += (v[j].x * v[j].x + v[j].y * v[j].y) + (v[j].z * v[j].z + v[j].w * v[j].w); }
        const float rstd = 1.0f / sqrtf(wave_sum(s) * (1.f / DM) + RMS_EPS);
        GAS unsigned long long* o8 = (GAS unsigned long long*)(dst + (size_t)m * DM) + lane;
#pragma unroll
        for (int j = 0; j < 16; ++j) { const f32x4 gv = gr[64 * j];
            o8[64 * j] = (unsigned long long)pk2(v[j].x * rstd * gv.x, v[j].y * rstd * gv.y) | ((unsigned long long)pk2(v[j].z * rstd * gv.z, v[j].w * rstd * gv.w) << 32); }
    }
}
__device__ __forceinline__ void rmsnorm_rows_f32_inplace(float* x, const float* g, int gw, int NGW, int lane) {
    for (int m = gw; m < SEQ; m += NGW) {
        GAS f32x4* xr = (GAS f32x4*)(x + (size_t)m * DM) + lane; const GAS f32x4* gr = (const GAS f32x4*)g + lane;
        f32x4 v[16]; float s = 0.f;
#pragma unroll
        for (int j = 0; j < 16; ++j) { v[j] = xr[64 * j]; s += (v[j].x * v[j].x + v[j].y * v[j].y) + (v[j].z * v[j].z + v[j].w * v[j].w); }
        const float rstd = 1.0f / sqrtf(wave_sum(s) * (1.f / DM) + RMS_EPS);
#pragma unroll
        for (int j = 0; j < 16; ++j) { const f32x4 gv = gr[64 * j]; xr[64 * j] = v[j] * rstd * gv; }
    }
}

__device__ __forceinline__ void lora_prep(const bf16* P, bf16* AP, const float* PART, int layer, int gw, int NGW, int lane) {
    for (int t = gw; t < SEQ; t += NGW) {
        const bf16* cur = P + (size_t)t * LDP; const bf16* prv = cur - LDP;
#pragma unroll
        for (int k = 0; k < 16; ++k) { const int grp = k >> 2, i = lane + 64 * (k & 3);
            const int rank = (grp == 2) ? 256 : (grp == 3 ? ((layer == 1) ? 64 : 0) : 96);
            const int ch = (grp == 0) ? C_LWH : (grp == 1) ? C_LAH : (grp == 2) ? C_LGH : C_LVH, cs = (grp == 0) ? C_LWS : (grp == 1) ? C_LAS : (grp == 2) ? C_LGS : C_LVS;
            float v = 0.f;
            if (grp == 3) {
                if (i < rank) {
                    const float* pc = PART + (size_t)t * 2048 + (C_LVH + i - 14336); const float* pp = PART + (size_t)(t > 0 ? t - 1 : 0) * 2048 + (C_LVS + i - 14336);
                    float sc = 0.f, sp = 0.f;
#pragma unroll
                    for (int s = 0; s < 8; ++s) { sp += pp[s * 256]; if (C_LVH + i >= 14336) sc += pc[s * 256]; }
                    if (C_LVH + i < 14336) sc = bf2f(cur[C_LVH + i]);
                    v = sc + ((t > 0) ? sp : 0.f); }
            } else if (i < rank) { v = bf2f(cur[ch + i]); if (t > 0) v += bf2f(prv[cs + i]);
                if (grp == 0) v = tanhf(v); else if (grp == 2) v = sigmoidf_(v); }
            AP[(size_t)t * 1024 + grp * 256 + i] = (bf16)f2bf(v); }
    }
}

__device__ __forceinline__ void rwkv_prep(unsigned char* ws, int layer, int gw, int NGW, int lane) {
    const bf16* P = (const bf16*)(ws + WS_P); const float* ZW = (const float*)(ws + WS_Z); const bf16* ZB = (const bf16*)(ws + WS_ZB);
    unsigned char* XS = ws + WS_XS; float* BON = (float*)(ws + WS_BON);
    float* VF = (float*)(ws + WS_VF);
    const int head = gw & 31, c = head * 64 + lane, nch = NGW >> 5, ch = gw >> 5;
    if (nch == 0 || ch >= nch) return;
    const int tper = (SEQ + nch - 1) / nch, tb = ch * tper, te = (tb + tper < SEQ) ? tb + tper : SEQ;
    const float* mu = inp<I_MURKV>() + (size_t)layer * 3 * BW;
    const float mu_r = mu[c], mu_k = mu[BW + c], mu_v = mu[2 * BW + c];
    const float w0 = inp<I_W0>()[layer * BW + c], a0 = inp<I_A0>()[layer * BW + c], kkw = inp<I_KK>()[layer * BW + c], kaw = inp<I_KA>()[layer * BW + c], rkw = inp<I_RK>()[layer * BW + c];
    const float v0 = (layer == 1) ? inp<I_V0>()[c] : 0.f;
    float rp = 0.f, kp = 0.f, vp = 0.f;
    if (tb > 0 && tb < SEQ) { const bf16* prv = P + (size_t)(tb - 1) * LDP; rp = bf2f(prv[C_RB + c]); kp = bf2f(prv[C_KB + c]); vp = bf2f(prv[C_VB + c]); }
#pragma unroll 4
    for (int t = tb; t < te; ++t) {
        const bf16* cur = P + (size_t)t * LDP;
        const float r0 = bf2f(cur[C_RB + c]), k0 = bf2f(cur[C_KB + c]), v0r = bf2f(cur[C_VB + c]);
        const bf16* zb = ZB + (size_t)t * 6144;
        const float zw = ZW[(size_t)t * 2048 + c], za = bf2f(zb[c]);
        float zv = 0.f, vf = 0.f; if (layer == 1) { zv = bf2f(zb[2 * BW + c]); vf = VF[(size_t)t * BW + c]; }
        const float r = r0 + (rp - r0) * mu_r, k = k0 + (kp - k0) * mu_k; float v = v0r + (vp - v0r) * mu_v;
        rp = r0; kp = k0; vp = v0r;
        const float decay = __expf(-0.6065306597126334f * sigmoidf_(w0 + zw));
        const float a = sigmoidf_(a0 + za);
        if (layer == 0) VF[(size_t)t * BW + c] = v; else v += (vf - v) * sigmoidf_(v0 + zv);
        float kk = k * kkw;
        const float nrm = sqrtf(wave_sum(kk * kk));
        kk = kk / fmaxf(nrm, 1e-12f);
        const float kn = k * (1.0f + (a - 1.0f) * kaw);
        float* rec = (float*)(XS + ((size_t)head * SEQ + t) * SREC) + lane;
        rec[0] = decay; rec[64] = r; rec[128] = kn; rec[192] = -kk; rec[256] = kk * a; rec[320] = v;
        const float bon = wave_sum(r * kn * rkw);
        if (lane == 0) BON[t * 32 + head] = bon;
    }
}

typedef unsigned short us4 __attribute__((ext_vector_type(4)));
__device__ __forceinline__ void st16_sc1(void* p, const f32x4 v) { asm volatile("global_store_dwordx4 %0, %1, off sc1\n\ts_nop 1" :: "v"((GAS void*)p), "v"(v) : "memory"); }
__device__ __forceinline__ void rwkv_prep_item(unsigned char* ws, int layer, int pi, int wave, int lane) {
    const bf16* P = (const bf16*)(ws + WS_P); const float* ZW = (const float*)(ws + WS_Z); const bf16* ZB = (const bf16*)(ws + WS_ZB);
    unsigned char* XS = ws + WS_XS; float* BON = (float*)(ws + WS_BON); float* VF = (float*)(ws + WS_VF);
    const int head = (pi & 3) * 8 + wave, tb = (pi >> 2) * 32, kq = lane & 15, c4 = head * 64 + 4 * kq;
    const float* mu = inp<I_MURKV>() + (size_t)layer * 3 * BW;
    const f32x4 mu_r = *(const GAS f32x4*)(mu + c4), mu_k = *(const GAS f32x4*)(mu + BW + c4), mu_v = *(const GAS f32x4*)(mu + 2 * BW + c4);
    const f32x4 w0 = *(const GAS f32x4*)(inp<I_W0>() + layer * BW + c4), a0 = *(const GAS f32x4*)(inp<I_A0>() + layer * BW + c4), kkw = *(const GAS f32x4*)(inp<I_KK>() + layer * BW + c4),
                kaw = *(const GAS f32x4*)(inp<I_KA>() + layer * BW + c4), rkw = *(const GAS f32x4*)(inp<I_RK>() + layer * BW + c4);
    f32x4 v0 = (f32x4){0.f, 0.f, 0.f, 0.f}; if (layer == 1) v0 = *(const GAS f32x4*)(inp<I_V0>() + c4);
#pragma unroll 2
    for (int p = 0; p < 8; ++p) {
        const int t = tb + 4 * p + (lane >> 4);
        const bf16* cur = P + (size_t)t * LDP + c4; const bf16* prv = cur - (t > 0 ? LDP : 0);
        const us4 r0b = *(const GAS us4*)(cur + C_RB), k0b = *(const GAS us4*)(cur + C_KB), v0b = *(const GAS us4*)(cur + C_VB);
        const us4 rpb = *(const GAS us4*)(prv + C_RB), kpb = *(const GAS us4*)(prv + C_KB), vpb = *(const GAS us4*)(prv + C_VB);
        const bf16* zb = ZB + (size_t)t * 6144 + c4;
        const f32x4 zw = *(const GAS f32x4*)(ZW + (size_t)t * 2048 + c4); const us4 zab = *(const GAS us4*)zb;
        us4 zvb = (us4){0, 0, 0, 0}; f32x4 vf = (f32x4){0.f, 0.f, 0.f, 0.f};
        if (layer == 1) { zvb = *(const GAS us4*)(zb + 2 * BW); vf = *(const GAS f32x4*)(VF + (size_t)t * BW + c4); }
        const float pm = (t > 0) ? 1.f : 0.f;
        f32x4 dec, r, kn, kk, kb, v; float n2 = 0.f, bon = 0.f;
#pragma unroll
        for (int j = 0; j < 4; ++j) {
            const float r0 = bf2f(r0b[j]), k0 = bf2f(k0b[j]), v0r = bf2f(v0b[j]);
            const float rp = pm * bf2f(rpb[j]), kp = pm * bf2f(kpb[j]), vp = pm * bf2f(vpb[j]);
            const float rr = r0 + (rp - r0) * mu_r[j], k = k0 + (kp - k0) * mu_k[j]; float vv = v0r + (vp - v0r) * mu_v[j];
            dec[j] = __expf(-0.6065306597126334f * sigmoidf_(w0[j] + zw[j]));
            const float a = sigmoidf_(a0[j] + bf2f(zab[j]));
            if (layer == 1) vv += (vf[j] - vv) * sigmoidf_(v0[j] + bf2f(zvb[j]));
            const float q = k * kkw[j];
            n2 += q * q;
            kk[j] = q; kb[j] = a;
            kn[j] = k * (1.0f + (a - 1.0f) * kaw[j]);
            bon += rr * kn[j] * rkw[j];
            r[j] = rr; v[j] = vv;
        }
        n2 = dpp_sum16(n2); bon = dpp_sum16(bon);
        const float inv = 1.0f / fmaxf(sqrtf(n2), 1e-12f);
        f32x4 nk;
#pragma unroll
        for (int j = 0; j < 4; ++j) { const float q = kk[j] * inv; nk[j] = -q; kb[j] = q * kb[j]; }
        if (layer == 0) *(GAS f32x4*)(VF + (size_t)t * BW + c4) = v;
        unsigned char* rec = XS + ((size_t)head * SEQ + t) * SREC + kq * 16;
        st16_sc1(rec, dec); st16_sc1(rec + 256, r); st16_sc1(rec + 512, kn); st16_sc1(rec + 768, nk); st16_sc1(rec + 1024, kb); st16_sc1(rec + 1280, v);
        if (kq == 0) BON[t * 32 + head] = bon;
    }
}

constexpr int SCH = 32, SCHB = SCH * SREC;
typedef float f32x2 __attribute__((ext_vector_type(2)));
struct ScanIn { f32x4 w, r, k, a, b; f32x2 v; };
__device__ __forceinline__ f32x2 lo2(const f32x4& x) { return (f32x2){x.x, x.y}; }
__device__ __forceinline__ f32x2 hi2(const f32x4& x) { return (f32x2){x.z, x.w}; }
__device__ __forceinline__ void scan_unit(unsigned char* ws, int layer, int unit, int wave, int lane, LAS unsigned char* lds) {
    const int head = unit >> 1, half = unit & 1, row = half * 32 + (wave & 3) * 8 + (lane >> 4) * 2, kq = lane & 15;
    const unsigned char* src = ws + WS_XS + (size_t)head * SEQ * SREC + (size_t)wave * 6144 + lane * 16;
    float* py = (float*)(ws + WS_Y) + head * 64 + row;
    f32x2 S0 = (f32x2){0.f, 0.f}, S1 = (f32x2){0.f, 0.f}, T0 = (f32x2){0.f, 0.f}, T1 = (f32x2){0.f, 0.f};
    const unsigned rdo = (unsigned)kq * 16u, rdv = 1280u + (unsigned)row * 4u;
    const bool ev0 = (lane & 1) == 0, ev1 = (lane & 2) == 0;
#define SCAN_DMA(c, buf) do { _Pragma("unroll") for (int p_ = 0; p_ < 6; ++p_) \
        __builtin_amdgcn_global_load_lds((const unsigned*)(src + (size_t)(c) * SCHB + p_ * 1024), (LAS unsigned*)(lds + (buf) * SCHB + wave * 6144 + p_ * 1024), 16, 0, 16); } while (0)
#define SCAN_LOAD(X, base) do { _Pragma("unroll") for (int i_ = 0; i_ < 4; ++i_) { const LAS unsigned char* q_ = (base) + i_ * SREC; \
        X[i_].w = *(const LAS f32x4*)(q_ + rdo); X[i_].r = *(const LAS f32x4*)(q_ + rdo + 256); X[i_].k = *(const LAS f32x4*)(q_ + rdo + 512); X[i_].a = *(const LAS f32x4*)(q_ + rdo + 768); X[i_].b = *(const LAS f32x4*)(q_ + rdo + 1024); \
        X[i_].v = *(const LAS f32x2*)(q_ + rdv); } } while (0)
#define SCAN_STEP(X, ANEXT, ROUT) do { \
          \
        const float p1_ = ev0 ? sap : sbp, q1_ = ev0 ? sbp : sap, p2_ = ev0 ? ypp : zpp, q2_ = ev0 ? zpp : ypp; \
        const float r1_ = p1_ + DPPF(q1_, 0xB1), r2_ = p2_ + DPPF(q2_, 0xB1); \
        const float p3_ = ev1 ? r1_ : r2_, q3_ = ev1 ? r2_ : r1_; \
        float rr_ = p3_ + DPPF(q3_, 0x4E); \
        rr_ += DPPF(rr_, 0x124); rr_ += DPPF(rr_, 0x128);                   \
        const float sa_ = __builtin_bit_cast(float, __builtin_amdgcn_mov_dpp(__builtin_bit_cast(int, rr_), 0x00, 0xF, 0xF, false)), sb_ = __builtin_bit_cast(float, __builtin_amdgcn_mov_dpp(__builtin_bit_cast(int, rr_), 0x55, 0xF, 0xF, false));     \
        ROUT = rr_;                                                          \
        { const f32x2 kv0 = lo2(X.k) * X.v.x, kv1 = hi2(X.k) * X.v.x; \
          const f32x2 t0_ = __builtin_elementwise_fma(lo2(X.b), (f32x2){sa_, sa_}, kv0), t1_ = __builtin_elementwise_fma(hi2(X.b), (f32x2){sa_, sa_}, kv1); \
          S0 = __builtin_elementwise_fma(S0, lo2(X.w), t0_); S1 = __builtin_elementwise_fma(S1, hi2(X.w), t1_); } \
        { const f32x2 kv0 = lo2(X.k) * X.v.y, kv1 = hi2(X.k) * X.v.y; \
          const f32x2 t0_ = __builtin_elementwise_fma(lo2(X.b), (f32x2){sb_, sb_}, kv0), t1_ = __builtin_elementwise_fma(hi2(X.b), (f32x2){sb_, sb_}, kv1); \
          T0 = __builtin_elementwise_fma(T0, lo2(X.w), t0_); T1 = __builtin_elementwise_fma(T1, hi2(X.w), t1_); } \
        { const f32x2 u_ = __builtin_elementwise_fma(S1, hi2(ANEXT), S0 * lo2(ANEXT)); sap = u_.x + u_.y; } \
        { const f32x2 u_ = __builtin_elementwise_fma(T1, hi2(ANEXT), T0 * lo2(ANEXT)); sbp = u_.x + u_.y; } \
        { const f32x2 u_ = __builtin_elementwise_fma(S1, hi2(X.r), S0 * lo2(X.r)); ypp = u_.x + u_.y; } \
        { const f32x2 u_ = __builtin_elementwise_fma(T1, hi2(X.r), T0 * lo2(X.r)); zpp = u_.x + u_.y; } } while (0)
#define SCAN_STEPS(X, AN4, t0) do { float r0_, r1x_, r2x_, r3_; \
        SCAN_STEP(X[0], X[1].a, r0_); SCAN_STEP(X[1], X[2].a, r1x_); SCAN_STEP(X[2], X[3].a, r2x_); SCAN_STEP(X[3], AN4, r3_); \
        const int qd_ = kq >> 2; const float ys_ = (qd_ == 0) ? r0_ : (qd_ == 1) ? r1x_ : (qd_ == 2) ? r2x_ : r3_; const int ts_ = (t0) - 1 + qd_; \
        if ((kq & 2) && ts_ >= 0) py[(size_t)ts_ * BW + (kq & 1)] = ys_; } while (0)
    const gu32* flg = (const gu32*)(ws + WS_CTL) + CW_PREP + 1024 * layer + (head >> 3);
#define SCAN_FRAW(c) __hip_atomic_load(flg + 4 * (c), RLX_AGENT)
#define SCAN_FLAG(c) ((unsigned)__builtin_amdgcn_readfirstlane((int)SCAN_FRAW(c)))
#define SCAN_WAIT(c, f) do { unsigned f_ = (f), sp_ = 0u; while (f_ == 0u) { __builtin_amdgcn_s_sleep(1); f_ = SCAN_FLAG(c); if (++sp_ > (1u << 24)) break; } } while (0)
    SCAN_WAIT(0, 0u);
    SCAN_DMA(0, 0);
    unsigned fnext = SCAN_FRAW(1);
    __syncthreads();
    float sap = 0.f, ypp = 0.f, sbp = 0.f, zpp = 0.f;
    for (int c = 0; c < SEQ / SCH; ++c) {
        const int cur = c & 1;
        if (c + 1 < SEQ / SCH) { SCAN_WAIT(c + 1, (unsigned)__builtin_amdgcn_readfirstlane((int)fnext)); SCAN_DMA(c + 1, cur ^ 1); fnext = SCAN_FRAW(c + 2 < SEQ / SCH ? c + 2 : c + 1); }
        if (wave < 4) {
            const LAS unsigned char* cb = lds + cur * SCHB;
            ScanIn A[4], B[4];
            SCAN_LOAD(A, cb);
#pragma unroll
            for (int s = 0; s < SCH; s += 8) {
                SCAN_LOAD(B, cb + (s + 4) * SREC);
                SCAN_STEPS(A, B[0].a, c * SCH + s);
                if (s + 8 < SCH) { SCAN_LOAD(A, cb + (s + 8) * SREC); SCAN_STEPS(B, A[0].a, c * SCH + s + 4); }
                else { SCAN_STEPS(B, B[3].a, c * SCH + s + 4); }
            }
        }
        if (wave < 4) { asm volatile("s_waitcnt vmcnt(9) lgkmcnt(0)" ::: "memory"); __builtin_amdgcn_s_barrier(); asm volatile("" ::: "memory"); }
        else __syncthreads();
        if (c + 1 < SEQ / SCH && wave < 4) {
            const f32x4 an = *(const LAS f32x4*)(lds + (cur ^ 1) * SCHB + rdo + 768);
            { const f32x2 u_ = __builtin_elementwise_fma(S1, hi2(an), S0 * lo2(an)); sap = u_.x + u_.y; }
            { const f32x2 u_ = __builtin_elementwise_fma(T1, hi2(an), T0 * lo2(an)); sbp = u_.x + u_.y; }
        }
    }
    if (wave < 4) {
        float yp_ = ypp, zp_ = zpp;
        yp_ += DPPF(yp_, 0xB1); zp_ += DPPF(zp_, 0xB1); yp_ += DPPF(yp_, 0x4E); zp_ += DPPF(zp_, 0x4E); yp_ += DPPF(yp_, 0x141); zp_ += DPPF(zp_, 0x141); yp_ += DPPF(yp_, 0x140); zp_ += DPPF(zp_, 0x140);
        if (kq == 0) { f32x2 o; o.x = yp_; o.y = zp_; *(GAS f32x2*)(py + (size_t)(SEQ - 1) * BW) = o; }
    }
#undef SCAN_DMA
#undef SCAN_FLAG
#undef SCAN_FRAW
#undef SCAN_WAIT
#undef SCAN_LOAD
#undef SCAN_STEP
#undef SCAN_STEPS
}

__device__ __forceinline__ float relu0(float x) { return __builtin_amdgcn_fmed3f(x, 0.f, __builtin_inff()); }
__device__ __forceinline__ void idx_scores_quad(const bf16* P, const bf16* KIF, float* Sc, int t0, int lane) {
    typedef float f32x16 __attribute__((ext_vector_type(16)));
    const int r = lane & 31, hh = lane >> 5;
    bf16x8 af[2][4]; float wq[2][16];
#pragma unroll
    for (int a = 0; a < 2; ++a) {
        const bf16* qrow = P + (size_t)(t0 + 2 * a + (r >> 4)) * LDP + C_QI + (r & 15) * 64 + hh * 8;
#pragma unroll
        for (int ks = 0; ks < 4; ++ks) af[a][ks] = *(const GAS bf16x8*)(qrow + ks * 16);
#pragma unroll
        for (int i = 0; i < 16; ++i) { const int head = (i & 3) + 8 * ((i >> 2) & 1) + 4 * hh; wq[a][i] = bf2f(P[(size_t)(t0 + 2 * a + (i >> 3)) * LDP + C_WI + head]); }
    }
    const int nkt = (t0 + 3) / 32 + 1;
    const bf16* kp = KIF + (size_t)lane * 8;
    float* sp0 = Sc + (size_t)(t0 + hh) * SEQ + r; float* sp1 = Sc + (size_t)(t0 + 2 + hh) * SEQ + r;
#define IDX_LOAD(X, kt_) do { const bf16* k_ = kp + (size_t)((kt_) < nkt ? (kt_) : nkt - 1) * 2048; _Pragma("unroll") for (int ks = 0; ks < 4; ++ks) X[ks] = *(const GAS bf16x8*)(k_ + ks * 512); } while (0)
#define IDX_TILE(X, kt_) do { _Pragma("unroll") for (int a = 0; a < 2; ++a) { f32x16 acc; \
            _Pragma("unroll") for (int i = 0; i < 16; ++i) acc[i] = 0.f; \
            _Pragma("unroll") for (int ks = 0; ks < 4; ++ks) acc = __builtin_amdgcn_mfma_f32_32x32x16_bf16(af[a][ks], X[ks], acc, 0, 0, 0); \
            float s0 = 0.f, s1 = 0.f; \
            _Pragma("unroll") for (int i = 0; i < 8; ++i) { s0 += wq[a][i] * relu0(acc[i]); s1 += wq[a][8 + i] * relu0(acc[8 + i]); } \
            s0 = swap32_sum(s0); s1 = swap32_sum(s1); \
            (a ? sp1 : sp0)[(kt_) * 32] = hh ? s1 : s0; } } while (0)
    bf16x8 fa[4], fb[4];
    IDX_LOAD(fa, 0);
#pragma unroll 1
    for (int kt = 0; kt < nkt; kt += 2) {
        IDX_LOAD(fb, kt + 1);
        IDX_TILE(fa, kt);
        if (kt + 1 < nkt) { IDX_LOAD(fa, kt + 2); IDX_TILE(fb, kt + 1); }
    }
#undef IDX_LOAD
#undef IDX_TILE
}

__device__ __forceinline__ unsigned f2key(float f) { const unsigned u = __float_as_uint(f); return (u & 0x80000000u) ? ~u : (u | 0x80000000u); }
__device__ __forceinline__ void topk_row(const float* sc, int L, unsigned* out, LAS unsigned* hist, int lane) {
    unsigned prefix = 0u, himask = 0u; int kneed = 256;
    for (int pass = 0; pass < 4; ++pass) {
        const int shift = 24 - 8 * pass;
#pragma unroll
        for (int b = 0; b < 4; ++b) hist[lane + 64 * b] = 0u;
        LDS_WAIT(); asm volatile("" ::: "memory");
        for (int i0 = lane; i0 < L; i0 += 1024) { float v[16];
#pragma unroll
            for (int j = 0; j < 16; ++j) v[j] = (i0 + 64 * j < L) ? sc[i0 + 64 * j] : 0.f;
#pragma unroll
            for (int j = 0; j < 16; ++j) { const unsigned u = f2key(v[j]); if (i0 + 64 * j < L && (u & himask) == prefix) __hip_atomic_fetch_add(&hist[(u >> shift) & 255u], 1u, __ATOMIC_RELAXED, __HIP_MEMORY_SCOPE_WORKGROUP); } }
        LDS_WAIT(); asm volatile("" ::: "memory");
        unsigned c[4];
#pragma unroll
        for (int j = 0; j < 4; ++j) c[j] = hist[4 * lane + j];
        const unsigned tot = (c[0] + c[1]) + (c[2] + c[3]);
        unsigned inc = tot;
#pragma unroll
        for (int o = 1; o < 64; o <<= 1) { const unsigned v = bperm_u32(inc, (lane + o) & 63); if (lane + o < 64) inc += v; }
        unsigned cum = inc - tot; bool found = false; unsigned d = 0u, gt = 0u;
#pragma unroll
        for (int j = 3; j >= 0; --j) { if (!found && cum < (unsigned)kneed && (unsigned)kneed <= cum + c[j]) { found = true; d = 4u * lane + j; gt = cum; } cum += c[j]; }
        const unsigned long long m = __ballot(found);
        const int src = m ? (int)__builtin_ctzll(m) : 0;
        d = (unsigned)__builtin_amdgcn_readlane((int)d, src); gt = (unsigned)__builtin_amdgcn_readlane((int)gt, src);
        prefix |= d << shift; himask |= 0xFFu << shift; kneed -= (int)gt;
        LDS_WAIT(); asm volatile("" ::: "memory");
    }
    int eqtaken = 0;
    const unsigned long long lt = (1ull << lane) - 1ull;
    for (int base0 = 0; base0 < L; base0 += 1024) { float v[16];
#pragma unroll
        for (int j = 0; j < 16; ++j) v[j] = (base0 + 64 * j + lane < L) ? sc[base0 + 64 * j + lane] : 0.f;
#pragma unroll
        for (int j = 0; j < 16; ++j) { const int base = base0 + 64 * j; if (base < L) {
            const int i = base + lane; const bool valid = i < L; const unsigned u = f2key(v[j]);
            const bool gtm = valid && u > prefix, eqm = valid && u == prefix;
            const unsigned long long meq = __ballot(eqm);
            const bool take = gtm || (eqm && (eqtaken + __popcll(meq & lt) < kneed));
            const unsigned long long mt = __ballot(take);
            if (lane < 2) __hip_atomic_store((gu32*)out + (base >> 5) + lane, (unsigned)(mt >> (32 * lane)), RLX_AGENT);
            eqtaken += __popcll(meq); } }
    }
    const int wdone = ((L + 63) >> 6) << 1;
#pragma unroll
    for (int w = lane; w < 256; w += 64) if (w >= wdone) __hip_atomic_store((gu32*)out + w, 0u, RLX_AGENT);
}
__device__ __forceinline__ void causal_bm_row(int t, unsigned* out, int lane) {
#pragma unroll
    for (int w = lane; w < 256; w += 64) { const int lo_ = 32 * w; __hip_atomic_store((gu32*)out + w, (t >= lo_ + 31) ? 0xffffffffu : (t < lo_ ? 0u : ((2u << (t - lo_)) - 1u)), RLX_AGENT); }
}

__device__ __forceinline__ void dsa_attn_wave(const bf16* P, const unsigned* BM, const bf16* KF, const bf16* VF, bf16* mix, int t0, int h, LAS unsigned char* kst, LAS float* wsf, int lane) {
    typedef float f32x16 __attribute__((ext_vector_type(16)));
    const int r32 = lane & 31, hi = lane >> 5;
    bf16x8 qf[8];
    { const bf16* qrow = P + (size_t)(t0 + r32) * LDP + C_QC + h * 128 + hi * 8;
#pragma unroll
      for (int ks = 0; ks < 8; ++ks) qf[ks] = *(const GAS bf16x8*)(qrow + ks * 16); }
    f32x16 o[4];
#pragma unroll
    for (int db = 0; db < 4; ++db)
#pragma unroll
        for (int i = 0; i < 16; ++i) o[db][i] = 0.f;
    float lsum = 0.f;
    const unsigned* bmrow = BM + (size_t)(t0 + r32) * 256;
    const bf16* kbase = KF + (size_t)h * 256 * 8 * 512 + lane * 8;
    const bf16* vbase = VF + (size_t)h * 128 * 16 * 512 + lane * 8;
    const int nkt = (t0 + 31) / 64 + 1;
#define DSA_KDMA(kt_) do { _Pragma("unroll") for (int f_ = 0; f_ < 16; ++f_) \
        __builtin_amdgcn_global_load_lds((const unsigned*)(kbase + (size_t)((kt_) * 16 + f_) * 512), (LAS unsigned*)(kst + f_ * 1024), 16, 0, 0); } while (0)
    DSA_KDMA(0);
#pragma unroll 1
    for (int kt = 0; kt < nkt; ++kt) {
        bf16x8 kf[16];
        asm volatile("s_waitcnt vmcnt(0)" ::: "memory");
#pragma unroll
        for (int f = 0; f < 16; ++f) kf[f] = *(const LAS bf16x8*)(kst + f * 1024 + lane * 16);
        const unsigned m0 = bmrow[2 * kt] >> (4 * hi), m1 = bmrow[2 * kt + 1] >> (4 * hi);
        asm volatile("s_waitcnt lgkmcnt(0)" ::: "memory");
        if (kt + 1 < nkt) DSA_KDMA(kt + 1);
        f32x16 p[2];
#pragma unroll
        for (int kb = 0; kb < 2; ++kb) {
#pragma unroll
            for (int i = 0; i < 16; ++i) p[kb][i] = 0.f;
#pragma unroll
            for (int ks = 0; ks < 8; ++ks) p[kb] = __builtin_amdgcn_mfma_f32_32x32x16_bf16(kf[kb * 8 + ks], qf[ks], p[kb], 0, 0, 0);
        }
        bf16x8 vf[16];
        { const bf16* vrow = vbase + (size_t)(kt * 16) * 512;
#pragma unroll
          for (int f = 0; f < 16; ++f) vf[f] = *(const GAS bf16x8*)(vrow + f * 512); }
#pragma unroll
        for (int i = 0; i < 16; ++i) { const int kk = (i & 3) + 8 * (i >> 2);
            const float e0 = __builtin_amdgcn_exp2f(fminf(p[0][i], 60.f)), e1 = __builtin_amdgcn_exp2f(fminf(p[1][i], 60.f));
            p[0][i] = __uint_as_float(__float_as_uint(e0) & (unsigned)__builtin_amdgcn_sbfe((int)m0, kk, 1)); p[1][i] = __uint_as_float(__float_as_uint(e1) & (unsigned)__builtin_amdgcn_sbfe((int)m1, kk, 1)); lsum += p[0][i] + p[1][i]; }
        bf16x8 pa[4];
#pragma unroll
        for (int s = 0; s < 4; ++s) { v4u w;
#pragma unroll
            for (int j = 0; j < 4; ++j) w[j] = pk2(p[s >> 1][8 * (s & 1) + 2 * j], p[s >> 1][8 * (s & 1) + 2 * j + 1]);
            pa[s] = __builtin_bit_cast(bf16x8, w); }
#pragma unroll
        for (int db = 0; db < 4; ++db)
#pragma unroll
            for (int s = 0; s < 4; ++s) o[db] = __builtin_amdgcn_mfma_f32_32x32x16_bf16(pa[s], vf[s * 4 + db], o[db], 0, 0, 0);
    }
#undef DSA_KDMA
    lsum = swap32_sum(lsum);
    if (hi == 0) wsf[r32] = lsum;
    LDS_WAIT(); asm volatile("" ::: "memory");
    bf16* orow = mix + (size_t)t0 * DM + 3072 + h * 128 + r32;
#pragma unroll
    for (int i = 0; i < 16; ++i) { const int q = (i & 3) + 8 * (i >> 2) + 4 * hi; const float inv = 1.0f / wsf[q];
#pragma unroll
        for (int db = 0; db < 4; ++db) orow[(size_t)q * DM + 32 * db] = (bf16)f2bf(o[db][i] * inv); }
    LDS_WAIT(); asm volatile("" ::: "memory");
}
__device__ __forceinline__ void dsa_attn_unit(const bf16* P, const unsigned* BM, const bf16* KF, const bf16* VF, bf16* mix, int qb, int h, LAS unsigned char* stage, LAS float* wsf, int wave, int lane) {
    typedef float f32x16 __attribute__((ext_vector_type(16)));
    const int r32 = lane & 31, hi = lane >> 5, t0 = 256 * qb + 32 * wave;
    bf16x8 qf[8];
    { const bf16* qrow = P + (size_t)(t0 + r32) * LDP + C_QC + h * 128 + hi * 8;
#pragma unroll
      for (int ks = 0; ks < 8; ++ks) qf[ks] = *(const GAS bf16x8*)(qrow + ks * 16); }
    f32x16 o[4];
#pragma unroll
    for (int db = 0; db < 4; ++db)
#pragma unroll
        for (int i = 0; i < 16; ++i) o[db][i] = 0.f;
    float lsum = 0.f;
    const unsigned* bmrow = BM + (size_t)(t0 + r32) * 256;
    const bf16* kbase = KF + (size_t)h * 256 * 8 * 512 + lane * 8;
    const bf16* vbase = VF + (size_t)h * 128 * 16 * 512 + lane * 8;
    const int nkt = 4 * qb + 4;
#define DSA_DMA(kt_, buf_) do { _Pragma("unroll") for (int f_ = 0; f_ < 2; ++f_) { \
        __builtin_amdgcn_global_load_lds((const unsigned*)(kbase + (size_t)((kt_) * 16 + 2 * wave + f_) * 512), (LAS unsigned*)(stage + (buf_) * 32768 + (2 * wave + f_) * 1024), 16, 0, 0); \
        __builtin_amdgcn_global_load_lds((const unsigned*)(vbase + (size_t)((kt_) * 16 + 2 * wave + f_) * 512), (LAS unsigned*)(stage + (buf_) * 32768 + 16384 + (2 * wave + f_) * 1024), 16, 0, 0); } } while (0)
    DSA_DMA(0, 0);
    __syncthreads();
#pragma unroll 1
    for (int kt = 0; kt < nkt; ++kt) {
        const LAS unsigned char* sb = stage + (kt & 1) * 32768 + lane * 16;
        if (kt + 1 < nkt) DSA_DMA(kt + 1, (kt + 1) & 1);
        const unsigned m0 = bmrow[2 * kt] >> (4 * hi), m1 = bmrow[2 * kt + 1] >> (4 * hi);
        f32x16 p[2];
#pragma unroll
        for (int kb = 0; kb < 2; ++kb) {
#pragma unroll
            for (int i = 0; i < 16; ++i) p[kb][i] = 0.f;
#pragma unroll
            for (int ks = 0; ks < 8; ++ks) p[kb] = __builtin_amdgcn_mfma_f32_32x32x16_bf16(*(const LAS bf16x8*)(sb + (kb * 8 + ks) * 1024), qf[ks], p[kb], 0, 0, 0);
        }
#pragma unroll
        for (int i = 0; i < 16; ++i) { const int kk = (i & 3) + 8 * (i >> 2);
            const float e0 = __builtin_amdgcn_exp2f(fminf(p[0][i], 60.f)), e1 = __builtin_amdgcn_exp2f(fminf(p[1][i], 60.f));
            p[0][i] = __uint_as_float(__float_as_uint(e0) & (unsigned)__builtin_amdgcn_sbfe((int)m0, kk, 1)); p[1][i] = __uint_as_float(__float_as_uint(e1) & (unsigned)__builtin_amdgcn_sbfe((int)m1, kk, 1)); lsum += p[0][i] + p[1][i]; }
        bf16x8 pa[4];
#pragma unroll
        for (int s = 0; s < 4; ++s) { v4u w;
#pragma unroll
            for (int j = 0; j < 4; ++j) w[j] = pk2(p[s >> 1][8 * (s & 1) + 2 * j], p[s >> 1][8 * (s & 1) + 2 * j + 1]);
            pa[s] = __builtin_bit_cast(bf16x8, w); }
#pragma unroll
        for (int db = 0; db < 4; ++db)
#pragma unroll
            for (int s = 0; s < 4; ++s) o[db] = __builtin_amdgcn_mfma_f32_32x32x16_bf16(pa[s], *(const LAS bf16x8*)(sb + 16384 + (s * 4 + db) * 1024), o[db], 0, 0, 0);
        __syncthreads();
    }
#undef DSA_DMA
    lsum = swap32_sum(lsum);
    if (hi == 0) wsf[r32] = lsum;
    LDS_WAIT(); asm volatile("" ::: "memory");
    bf16* orow = mix + (size_t)t0 * DM + 3072 + h * 128 + r32;
#pragma unroll
    for (int i = 0; i < 16; ++i) { const int q = (i & 3) + 8 * (i >> 2) + 4 * hi; const float inv = 1.0f / wsf[q];
#pragma unroll
        for (int db = 0; db < 4; ++db) orow[(size_t)q * DM + 32 * db] = (bf16)f2bf(o[db][i] * inv); }
    LDS_WAIT(); asm volatile("" ::: "memory");
}
__device__ __forceinline__ void dsa_pretile(const bf16* P, unsigned char* ws, int gw, int NGW, int lane) {
    const int r32 = lane & 31, hi = lane >> 5;
    bf16* KF = (bf16*)(ws + WS_KF); bf16* VF = (bf16*)(ws + WS_VFR); bf16* KIF = (bf16*)(ws + WS_KIF);
    for (int it = gw; it < 2048 + 1024 + 256; it += NGW) {
        if (it < 2048) {
            const int h = it >> 8, kb = it & 255; const bf16* src = P + (size_t)(32 * kb + r32) * LDP + C_KC + h * 128 + 8 * hi;
#pragma unroll
            for (int ks = 0; ks < 8; ++ks) *(GAS v4u*)(KF + ((size_t)((h * 256 + kb) * 8 + ks) * 64 + lane) * 8) = *(const GAS v4u*)(src + 16 * ks);
        } else if (it < 3072) {
            const int h = (it - 2048) >> 7, kt = (it - 2048) & 127; const bf16* src = P + (size_t)(64 * kt + 4 * hi) * LDP + C_VC + h * 128 + r32;
#pragma unroll
            for (int s = 0; s < 4; ++s)
#pragma unroll
                for (int db = 0; db < 4; ++db) { const bf16* q_ = src + (size_t)(16 * s) * LDP + 32 * db; unsigned short e[8];
#pragma unroll
                    for (int j = 0; j < 8; ++j) e[j] = q_[(size_t)(8 * (j >> 2) + (j & 3)) * LDP];
                    v4u o; o.x = e[0] | ((unsigned)e[1] << 16); o.y = e[2] | ((unsigned)e[3] << 16); o.z = e[4] | ((unsigned)e[5] << 16); o.w = e[6] | ((unsigned)e[7] << 16);
                    *(GAS v4u*)(VF + ((size_t)((h * 128 + kt) * 16 + s * 4 + db) * 64 + lane) * 8) = o; }
        } else {
            const int kb = it - 3072; const bf16* src = P + (size_t)(32 * kb + r32) * LDP + C_KI + 8 * hi;
#pragma unroll
            for (int ks = 0; ks < 4; ++ks) *(GAS v4u*)(KIF + ((size_t)(kb * 4 + ks) * 64 + lane) * 8) = *(const GAS v4u*)(src + 16 * ks);
        }
    }
}

__device__ __forceinline__ void finalize_mix(unsigned char* ws, gu32* ctl, int layer, int gw, int NGW, int lane) {
    const bf16* O0 = (const bf16*)(ws + WS_O0); const bf16* O1 = (const bf16*)(ws + WS_O1); bf16* mix = (bf16*)(ws + WS_MIX);
    const int nch = NGW / 40, j = gw % 40, ch = gw / 40;
    if (nch == 0 || ch >= nch) return;
    const int tper = (((SEQ + nch - 1) / nch) + 3) & ~3, tb = ch * tper, te = (tb + tper < SEQ) ? tb + tper : SEQ;
    const int kq = lane & 15, tj = lane >> 4;
    if (j < 8) {
        const float lam = __uint_as_float(__hip_atomic_load(ctl + CW_LAM + layer, RLX_AGENT));
        const float lam_init = 0.8f - 0.6f * expf(-0.3f * (float)layer);
        const float* gp = inp<I_SUBLN>() + layer * 128 + 8 * kq;
        const f32x4 ga = *(const GAS f32x4*)gp * (1.0f - lam_init), gb = *(const GAS f32x4*)(gp + 4) * (1.0f - lam_init);
#pragma unroll 2
        for (int t0 = tb; t0 < te; t0 += 4) {
            const int t = t0 + tj;
            const size_t o = (size_t)t * 1024 + j * 128 + 8 * kq;
            const v4u a = *(const GAS v4u*)(O0 + o), b = *(const GAS v4u*)(O1 + o);
            float x[8];
            x[0] = bflo(a.x) - lam * bflo(b.x); x[1] = bfhi(a.x) - lam * bfhi(b.x); x[2] = bflo(a.y) - lam * bflo(b.y); x[3] = bfhi(a.y) - lam * bfhi(b.y);
            x[4] = bflo(a.z) - lam * bflo(b.z); x[5] = bfhi(a.z) - lam * bfhi(b.z); x[6] = bflo(a.w) - lam * bflo(b.w); x[7] = bfhi(a.w) - lam * bfhi(b.w);
            float ss = 0.f;
#pragma unroll
            for (int i = 0; i < 8; ++i) ss += x[i] * x[i];
            const float rs = 1.0f / sqrtf(dpp_sum16(ss) * (1.f / 128.f) + RMS_EPS);
            v4u w; w.x = pk2(x[0] * rs * ga[0], x[1] * rs * ga[1]); w.y = pk2(x[2] * rs * ga[2], x[3] * rs * ga[3]); w.z = pk2(x[4] * rs * gb[0], x[5] * rs * gb[1]); w.w = pk2(x[6] * rs * gb[2], x[7] * rs * gb[3]);
            *(GAS v4u*)(mix + (size_t)t * DM + j * 128 + 8 * kq) = w;
        }
    } else {
        const float* Y = (const float*)(ws + WS_Y); const float* BON = (const float*)(ws + WS_BON); const unsigned char* XS = ws + WS_XS; const bf16* ZB = (const bf16*)(ws + WS_ZB);
        const int head = j - 8, c4 = head * 64 + 4 * kq;
        const f32x4 lnw = *(const GAS f32x4*)(inp<I_LNW>() + layer * BW + c4), lnb = *(const GAS f32x4*)(inp<I_LNB>() + layer * BW + c4);
#pragma unroll 2
        for (int t0 = tb; t0 < te; t0 += 4) {
            const int t = t0 + tj;
            const f32x4 y = *(const GAS f32x4*)(Y + (size_t)t * BW + c4);
            const us4 g = *(const GAS us4*)(ZB + (size_t)t * 6144 + BW + c4);
            const f32x4 v = *(const GAS f32x4*)(XS + ((size_t)head * SEQ + t) * SREC + 1280 + kq * 16);
            const float bon = BON[t * 32 + head];
            const float mean = dpp_sum16((y[0] + y[1]) + (y[2] + y[3])) * (1.f / 64.f);
            const f32x4 d = y - mean;
            const float var = dpp_sum16((d[0] * d[0] + d[1] * d[1]) + (d[2] * d[2] + d[3] * d[3])) * (1.f / 64.f);
            const float rs = 1.0f / sqrtf(var + GN_EPS);
            float o[4];
#pragma unroll
            for (int i = 0; i < 4; ++i) o[i] = (d[i] * rs * lnw[i] + lnb[i] + bon * v[i]) * bf2f(g[i]);
            typedef unsigned u32x2_t __attribute__((ext_vector_type(2)));
            u32x2_t w; w.x = pk2(o[0], o[1]); w.y = pk2(o[2], o[3]);
            *(GAS u32x2_t*)(mix + (size_t)t * DM + 1024 + c4) = w;
        }
    }
}

constexpr int NPL = 15, NSCAN = 64;
constexpr int PH_FINAL = 2 * NPL, N_PHASES = PH_FINAL + 1;
struct Args { const float* in[N_INPUTS]; float* out; unsigned char* ws; int ph_lo, ph_hi; };
static_assert(sizeof(Args) == N_INPUTS * 8 + 24, "kernarg layout: in[i] at 8*i, out, ws, ph_lo, ph_hi");
__device__ __forceinline__ XcdBarrier bar_make(unsigned char* ws, volatile LAS unsigned* misc) { XcdBarrier b; b.bar = (unsigned*)(ws + WS_CTL) + CW_BAR; b.x = xb_xcc_id(); b.st = misc + 8; return b; }

extern __shared__ __attribute__((aligned(16))) unsigned char lds_[];
#define IN(k) (lo <= (k) && (k) < hi)
#define SEAM(k) do { if (IN(k) && IN((k) + 1)) { const Ctx cb_ = ctx_make(wave0); xcd_barrier(bar_make(cb_.ws, MISC), cb_.tid == 0); } } while (0)
#define WSP(T, off) ((T*)(c.ws + (off)))
#define SEAM5(k) do { if (IN(k) && IN((k) + 5)) { const Ctx cb_ = ctx_make(wave0); xcd_barrier(bar_make(cb_.ws, MISC), cb_.tid == 0); } } while (0)
#ifndef PROBE_PH
#define PROBE_PH 0
#define PROBE_REP 1
#endif
#ifndef REP_SCAN
#define REP_SCAN 1
#define REP_DSA 1
#define REP_ATT 1
#define REP_CONV 1
#endif
#define REPEAT(k) for (int rep_ = 0; rep_ < ((L == 0 && ((PROBE_PH >> (k)) & 1)) ? PROBE_REP : 1); ++rep_)
template <int L> __device__ __forceinline__ void layer_phases(const int lo, const int hi, const int wave0) {
    LAS unsigned char* lds = (LAS unsigned char*)lds_;
    volatile LAS unsigned* MISC = (volatile LAS unsigned*)(lds + MISC_OFF);
    constexpr int pb = L * NPL;
        if (IN(pb + 0)) REPEAT(0) { const Ctx c = ctx_make(wave0, L); layer_prologue(c.ws, (gu32*)(c.ws + WS_CTL), lds, c.l, c.gw, c.NGW, c.wave, c.lane);
            rmsnorm_rows_bf16(c.l == 0 ? inp<I_X>() : ARG_OUT, inp<I_NMG>() + (size_t)c.l * DM, WSP(bf16, WS_H), c.gw, c.NGW, c.lane); SEAM(pb + 0); }
        if (IN(pb + 1)) REPEAT(1) { const Ctx c = ctx_make(wave0, L);
            constexpr int NP = 14336;
            pg8::Gemm g{WSP(bf16, WS_H), WSP(bf16, WS_WIN), SEQ, NP, DM, DM, DM}; pg8::StaticOrder S; S.init(SEQ, NP, c.G, c.bx);
            pg8::EpiBf16x<0> E{WSP(bf16, WS_P), LDP, QA_SCALE, 4, QC_SCALE, C_QC / 256, C_QC / 256 + 4};
            pg8::gemm_phase<pg8::EpiBf16x<0>, pg8::StaticOrder, true, true>(lds + RING_OFF, g, S, E, c.tid);
            if (L == 1) {
                const Ctx c2 = ctx_make(wave0, L);
                pg8::Gemm g2{(const pg8::bf16_t*)(c2.ws + WS_H), (const pg8::bf16_t*)(c2.ws + WS_WIN) + (size_t)NP * DM, SEQ, 256, DM / 8, DM, DM}; pg8::SplitKOrder S2; S2.init(SEQ, 8, DM / 8, c2.G, c2.bx);
                pg8::EpiF32x E2{(float*)(c2.ws + WS_Y), 2048, nullptr};
                pg8::gemm_phase<pg8::EpiF32x, pg8::SplitKOrder, true, true>(lds + RING_OFF, g2, S2, E2, c2.tid);
            }
            SEAM(pb + 1);
        }
        if (IN(pb + 2)) REPEAT(2) { const Ctx c = ctx_make(wave0, L); lora_prep(WSP(bf16, WS_P), WSP(bf16, WS_AP), WSP(float, WS_Y), c.l, c.gw, c.NGW, c.lane);
            dsa_pretile(WSP(bf16, WS_P), c.ws, c.gw, c.NGW, c.lane);
            SEAM(pb + 2); }
        if (IN(pb + 3)) REPEAT(3) { const Ctx c = ctx_make(wave0, L);
            const int N2 = (c.l == 0) ? 6144 : 8192;
            pg8::Gemm g{WSP(bf16, WS_AP), WSP(bf16, WS_BT2), SEQ, N2, 256, 1024, 256}; pg8::LoraOrder S; S.init(SEQ, N2, c.G, c.bx);
            pg8::EpiLora E{WSP(float, WS_Z), WSP(bf16, WS_ZB)};
            pg8::gemm_phase<pg8::EpiLora, pg8::LoraOrder, true, true>(lds + RING_OFF, g, S, E, c.tid);
            SEAM(pb + 3);
        }
        if (IN(pb + 5)) REPEAT(5) {
            for (;;) {
                const Ctx c = ctx_make(wave0, L);
                volatile LAS unsigned* qslot = MISC + 16;
                if (c.tid == 0) qslot[0] = __hip_atomic_fetch_add((gu32*)(c.ws + WS_CTL) + CW_QUEUE + 64 * L + 16 * rep_, 1u, RLX_AGENT);
                __syncthreads();
                int item = (int)qslot[0];
                __syncthreads();
                constexpr int NPREP = 1024, NPREP0 = 256;
                if (item >= NPREP + NSCAN + 1536 + N_CONV_ITEMS) break;
                { int pi = -1;
                  if (item < NPREP0) pi = item; else if (item < NPREP0 + NSCAN) item -= NPREP0; else if (item < NPREP + NSCAN) pi = item - NSCAN; else item -= NPREP;
#if defined(PROBE_SKIP)
                  if (rep_ == 1) { const int cls = (pi >= 0) ? 0 : (item < NSCAN) ? 1 : (item < NSCAN + 256) ? 2 : (item < NSCAN + 1280) ? 3 : (item < NSCAN + 1536) ? 4 : 5; if ((PROBE_SKIP >> cls) & 1) continue; }
#endif
                  if (pi >= 0) {
                      rwkv_prep_item(c.ws, c.l, pi, c.wave, c.lane);
                      asm volatile("s_waitcnt vmcnt(0)" ::: "memory");
                      __syncthreads();
                      if (c.tid == 0) __hip_atomic_store((gu32*)(c.ws + WS_CTL) + CW_PREP + 1024 * L + pi, 1u, RLX_AGENT);
                      continue; } }
                if (item < NSCAN) {
                    { const Ctx c2 = ctx_make(wave0, L);
                      if (c2.tid == 0) { const unsigned x0 = xb_xcc_id() & 7u; unsigned got = 0u;
                          for (unsigned kx = 0; kx < 8u; ++kx) { const unsigned xx = (x0 + kx) & 7u;
                              const unsigned v = __hip_atomic_fetch_add((gu32*)(c2.ws + WS_CTL) + CW_AQ + 64 * (32 + 8 * L + xx), 1u, RLX_AGENT);
                              if (v < 8u) { got = xx * 8u + v; break; } }
                          qslot[1] = got; }
                      __syncthreads(); }
                    const int su = (int)qslot[1];
                    __syncthreads();
                    const Ctx c3 = ctx_make(wave0, L);
                    scan_unit(c3.ws, c3.l, su, c3.wave, c3.lane, lds + RING_OFF);
                }
                else if (item < NSCAN + 256) {
                    const int t0 = 32 * (NSCAN + 255 - item);
                    idx_scores_quad(WSP(bf16, WS_P), WSP(bf16, WS_KIF), WSP(float, WS_SC), t0 + 4 * c.wave, c.lane);
                    __syncthreads();
                    { LAS unsigned* hist = (LAS unsigned*)(lds + RING_OFF + c.wave * 16384);
#pragma unroll 1
                      for (int i = 0; i < 4; ++i) { const int row = t0 + 4 * c.wave + i; unsigned* bm = WSP(unsigned, WS_BM) + (size_t)row * 256;
                          if (row >= 256) topk_row(WSP(float, WS_SC) + (size_t)row * SEQ, row + 1, bm, hist, c.lane); else causal_bm_row(row, bm, c.lane); } }
                    asm volatile("s_waitcnt vmcnt(0)" ::: "memory");
                    __syncthreads();
                    if (c.tid == 0) __hip_atomic_fetch_add((gu32*)(c.ws + WS_CTL) + CW_RDY + 64 * (32 * L + (t0 >> 8)), 1u, RLX_AGENT);
                } else if (item >= NSCAN + 1536) {
                    LAS float* scr = (LAS float*)(lds + RING_OFF + c.wave * 16384);
                    const int ci = item - NSCAN - 1536;
                    const int per = (ci < N_CONV_BIG) ? CONV_PER_ITEM / NWAVES : CONV_PER_SMALL / NWAVES;
                    const int r0 = (ci < N_CONV_BIG) ? ci * CONV_PER_ITEM : N_CONV_BIG * CONV_PER_ITEM + (ci - N_CONV_BIG) * CONV_PER_SMALL;
#pragma unroll 1
                    for (int i = 0; i < per; ++i) conv_late_item(c.ws, c.l, r0 + c.wave * per + i, scr, c.lane);
                } else if (item >= NSCAN + 1280) {
                    const int u = item - NSCAN - 1280, qb = 31 - (u >> 3), h = u & 7;
                    if (c.wave == 0) { gu32* rdy = (gu32*)(c.ws + WS_CTL) + CW_RDY + 64 * (32 * L + qb); gu32* tmo = (gu32*)(c.ws + WS_CTL) + CW_TMO; unsigned sp = 0u;
                        while ((unsigned)__builtin_amdgcn_readfirstlane(__hip_atomic_load(rdy, RLX_AGENT)) < 8u) { __builtin_amdgcn_s_sleep(2);
                            if ((++sp & 255u) == 0u) { if (__builtin_amdgcn_readfirstlane(__hip_atomic_load(tmo, RLX_AGENT)) != 0u) break; if (sp > (1u << 22)) { if (c.lane == 0) __hip_atomic_store(tmo, 1u, RLX_AGENT); break; } } }
                        __builtin_amdgcn_fence(__ATOMIC_ACQUIRE, "agent");
                        asm volatile("s_waitcnt vmcnt(0)" ::: "memory"); }
                    __syncthreads();
                    dsa_attn_unit(WSP(bf16, WS_P), WSP(unsigned, WS_BM), WSP(bf16, WS_KF), WSP(bf16, WS_VFR), WSP(bf16, WS_MIX), qb, h, lds + RING_OFF, (LAS float*)(lds + MISC_OFF + 1024 + c.wave * 256), c.wave, c.lane);
                } else {
                    { const Ctx c2 = ctx_make(wave0, L);
                      if (c2.tid == 0) { const unsigned x0 = xb_xcc_id() & 7u; unsigned got = 0u;
                          for (unsigned kx = 0; kx < 8u; ++kx) { const unsigned xx = (x0 + kx) & 7u;
                              const unsigned v = __hip_atomic_fetch_add((gu32*)(c2.ws + WS_CTL) + CW_AQ + 64 * (8 * L + xx), 1u, RLX_AGENT);
                              if (v < 128u) { got = xx * 128u + v; break; } }
                          qslot[1] = got; }
                      __syncthreads(); }
                    const int a = (int)qslot[1];
                    __syncthreads();
                    const int h = a >> 7, qb = 31 - ((a & 127) >> 2), m = (a >> 1) & 1, vh = a & 1;
                    attn_body::attn_unit<8>((2 * h + m) * 64, 1024 + (2 * h + m) * 64, 2048 + h * 128 + vh * 64, h * 128 + vh * 64, qb, WSP(const attn_body::bf16, WS_P), WSP(const attn_body::bf16, WS_P), WSP(const attn_body::bf16, WS_P),
                                            WSP(attn_body::bf16, m ? WS_O1 : WS_O0), (char*)lds_ + RING_OFF, c.tid);
                }
            }
#if defined(PROBE_UNIT)
            if (L == 0 && blockIdx.x == 0) { const Ctx c = ctx_make(wave0, L); const int t0 = 8160;
                if (PROBE_UNIT == 1 || PROBE_UNIT == 2) idx_scores_quad(WSP(bf16, WS_P), WSP(bf16, WS_KIF), WSP(float, WS_SC), t0 + 4 * c.wave, c.lane);
                __syncthreads();
                if (PROBE_UNIT == 1 || PROBE_UNIT == 3) { LAS unsigned* hist = (LAS unsigned*)(lds + RING_OFF + c.wave * 16384);
#pragma unroll 1
                    for (int i = 0; i < 4; ++i) { const int row = t0 + 4 * c.wave + i; topk_row(WSP(float, WS_SC) + (size_t)row * SEQ, row + 1, WSP(unsigned, WS_BM) + (size_t)row * 256, hist, c.lane); } }
                __syncthreads();
                if (PROBE_UNIT == 1 || PROBE_UNIT == 4) dsa_attn_wave(WSP(bf16, WS_P), WSP(unsigned, WS_BM), WSP(bf16, WS_KF), WSP(bf16, WS_VFR), WSP(bf16, WS_MIX), t0, c.wave, lds + RING_OFF + c.wave * 16384, (LAS float*)(lds + MISC_OFF + 1024 + c.wave * 256), c.lane);
                if (PROBE_UNIT == 5) scan_unit(c.ws, c.l, 0, c.wave, c.lane, lds + RING_OFF);
            }
#endif
            SEAM5(pb + 5);
        }
        if (IN(pb + 10)) REPEAT(10) { const Ctx c = ctx_make(wave0, L); finalize_mix(c.ws, (gu32*)(c.ws + WS_CTL), c.l, c.gw, c.NGW, c.lane); SEAM(pb + 10); }
        if (IN(pb + 11)) REPEAT(11) { const Ctx c = ctx_make(wave0, L);
            pg8::Gemm g{WSP(bf16, WS_MIX), WSP(bf16, WS_WOUT), SEQ, DM, DM, DM, DM}; pg8::StaticOrder S; S.init(SEQ, DM, c.G, c.bx);
            float* out = ARG_OUT; pg8::EpiF32xN E{out, DM, c.l == 0 ? inp<I_X>() : out, WSP(bf16, WS_H), (unsigned long long*)((gu32*)(c.ws + WS_CTL) + CW_SS + 16384 * L)};
            pg8::gemm_phase<pg8::EpiF32xN, pg8::StaticOrder, true, true>(lds + RING_OFF, g, S, E, c.tid);
            SEAM(pb + 11);
        }
        if (IN(pb + 13)) REPEAT(13) { const Ctx c = ctx_make(wave0, L);
            pg8::Gemm g{WSP(bf16, WS_H), WSP(bf16, WS_WUP), SEQ, DFF, DM, DM, DM}; pg8::StaticOrder S; S.init(SEQ, DFF, c.G, c.bx);
            pg8::EpiUpN E{WSP(bf16, WS_U), DFF, (const unsigned long long*)((gu32*)(c.ws + WS_CTL) + CW_SS + 16384 * L), 1.f / DM, RMS_EPS};
            pg8::gemm_phase<pg8::EpiUpN, pg8::StaticOrder, true, true>(lds + RING_OFF, g, S, E, c.tid);
            SEAM(pb + 13);
        }
        if (IN(pb + 14)) REPEAT(14) { const Ctx c = ctx_make(wave0, L);
            pg8::Gemm g{WSP(bf16, WS_U), WSP(bf16, WS_WDN), SEQ, DM, DFF, DFF, DFF}; pg8::StaticOrder S; S.init(SEQ, DM, c.G, c.bx);
            float* out = ARG_OUT; pg8::EpiF32x E{out, DM, out};
            pg8::gemm_phase<pg8::EpiF32x, pg8::StaticOrder, true, true>(lds + RING_OFF, g, S, E, c.tid);
            SEAM(pb + 14);
        }
    }
__global__ void __launch_bounds__(NWAVES * 64, 2) mk_fwd(Args args) {
    LAS unsigned char* lds = (LAS unsigned char*)lds_;
    volatile LAS unsigned* MISC = (volatile LAS unsigned*)(lds + MISC_OFF);
    for (int u = threadIdx.x; u < (LDS_BYTES - LDSCTL_OFF) / 4; u += NWAVES * 64) ((LAS unsigned*)(lds + LDSCTL_OFF))[u] = 0u;
    __syncthreads();
    const int lo = args.ph_lo, hi = args.ph_hi, wave0 = __builtin_amdgcn_readfirstlane((int)threadIdx.x >> 6);
    if (hi - lo > 1) (void)xcd_barrier_post((unsigned*)(ARG_WS + WS_CTL) + CW_BAR, MISC + 8);

    layer_phases<0>(lo, hi, wave0);
    layer_phases<1>(lo, hi, wave0);
    if (IN(PH_FINAL)) { const Ctx c = ctx_make(wave0); rmsnorm_rows_f32_inplace(ARG_OUT, inp<I_NFIN>(), c.gw, c.NGW, c.lane); }
#undef IN
#undef SEAM
#undef WSP
}

extern "C" void kernel_launch(void* const* d_in, const int* in_sizes, int n_in, void* d_out, int out_size, void* d_ws, size_t ws_size, hipStream_t stream) {
    static int grid = 0;
    if (grid == 0) {
        if (n_in != N_INPUTS || in_sizes[0] != SEQ * DM || out_size != SEQ * DM || ws_size < WS_END) {
            fprintf(stderr, "kernel_launch: unexpected shapes: n_in %d in0 %d out %d ws %zu (need %zu)\n", n_in, n_in > 0 ? in_sizes[0] : -1, out_size, ws_size, (size_t)WS_END); _exit(77); }
        int dev = 0, cus = 0;
        if (hipGetDevice(&dev) != hipSuccess || hipDeviceGetAttribute(&cus, hipDeviceAttributeMultiprocessorCount, dev) != hipSuccess) { grid = -1; return; }
        if (hipFuncSetAttribute((const void*)mk_fwd, hipFuncAttributeMaxDynamicSharedMemorySize, LDS_BYTES) != hipSuccess) { fprintf(stderr, "kernel_launch: hipFuncSetAttribute failed\n"); grid = -1; return; }
        (void)hipGetLastError();
        grid = cus;
    }
    if (grid < 0) return;
    if (hipMemsetAsync((char*)d_ws + WS_CTL, 0, CTL_ZERO_BYTES, stream) != hipSuccess) return;
    Args a{};
    for (int i = 0; i < N_INPUTS; ++i) a.in[i] = (const float*)d_in[i];
    a.out = (float*)d_out; a.ws = (unsigned char*)d_ws;
#ifndef MK_ONE_LAUNCH
#ifndef MK_MAXPH
#define MK_MAXPH N_PHASES
#endif
    for (int ph = 0; ph < MK_MAXPH; ++ph) { a.ph_lo = ph; a.ph_hi = ph + 1;
        hipLaunchKernelGGL(mk_fwd, dim3(grid), dim3(NWAVES * 64), LDS_BYTES, stream, a); }
#else
    a.ph_lo = 0; a.ph_hi = N_PHASES;
    hipLaunchKernelGGL(mk_fwd, dim3(grid), dim3(NWAVES * 64), LDS_BYTES, stream, a);
#endif
}
```

```cpp
#define MK_ONE_LAUNCH 1
#include <hip/hip_runtime.h>
#include <hip/hip_bf16.h>
#include <cstdio>
#include <cstdint>
#include <cmath>
#include <unistd.h>
namespace pg8 {
#define PG8_LAS __attribute__((address_space(3)))
typedef unsigned short bf16_t;
typedef short bf16x8 __attribute__((ext_vector_type(8)));
typedef float f32x4 __attribute__((ext_vector_type(4)));
typedef unsigned u32x4 __attribute__((ext_vector_type(4)));
constexpr int BM = 256, BK = 64, HALF = 128, HTB = HALF * BK * 2  , STAGE_BYTES = 8 * HTB, NXCD = 8, WGM = 8;

__host__ __device__ __forceinline__ int lds_byte(int r, int c) { const int st = (r >> 4) * 2 + (c >> 5), rr = r & 15, cc = c & 31, ob = rr * 64 + cc * 2; return st * 1024 + (ob ^ (((ob >> 9) & 1) << 5)); }
__host__ __device__ __forceinline__ void stage_rc(int b, int& R, int& C) { const int st = b / 1024, sb = b % 1024, swz = sb ^ (((sb >> 9) & 1) << 5); R = (st >> 1) * 16 + swz / 64; C = (st & 1) * 32 + (swz % 64) / 2; }
__host__ __device__ __forceinline__ int perm32(int rho) { const int n = rho >> 4, i = rho & 15; return 8 * (i >> 2) + 4 * n + (i & 3); }

struct Unit { int pm, pn; };
struct Gemm { const bf16_t* A; const bf16_t* Bt; int M, N, K, lda, ldb; };

struct StaticOrder {
    int nM, nN, nwg, G, c;
    __host__ __device__ void init(int M, int N, int G_, int c_) { nM = M / BM; nN = N / BM; nwg = nM * nN; G = G_; c = c_; }
    __host__ __device__ bool next(int i, Unit& u) const {
        const long L = (long)i * G + c; if (L >= nwg) return false;
        int wgid = (int)L; { const int q = nwg / NXCD, r = nwg % NXCD, xcd = wgid % NXCD, off = wgid / NXCD; wgid = (xcd < r ? xcd * (q + 1) : r * (q + 1) + (xcd - r) * q) + off; }
        const int nig = WGM * nN, gid = wgid / nig, fm = gid * WGM, gsz = (nM - fm) < WGM ? (nM - fm) : WGM;
        u.pm = fm + ((wgid % nig) % gsz); u.pn = (wgid % nig) / gsz; return true;
    }
    __device__ __forceinline__ void a_ready(const Unit&) const {}
    __device__ __forceinline__ size_t a_off(const Unit&) const { return 0; }
    __device__ __forceinline__ int b_tile(const Unit& u) const { return u.pn; }
    __device__ __forceinline__ size_t b_off(const Unit&) const { return 0; }
    __device__ __forceinline__ void done(const Unit&) const {}
};
struct SplitKOrder {
    int nM, NS, G, c; size_t wbytes;
    __host__ __device__ void init(int M, int ns, int kwin, int G_, int c_) { nM = M / BM; NS = ns; G = G_; c = c_; wbytes = (size_t)kwin * 2; }
    __host__ __device__ bool next(int i, Unit& u) const { const long L = (long)i * G + c; if (L >= (long)nM * NS) return false; u.pm = (int)(L / NS); u.pn = (int)(L % NS); return true; }
    __device__ __forceinline__ void a_ready(const Unit&) const {}
    __device__ __forceinline__ size_t a_off(const Unit& u) const { return (size_t)u.pn * wbytes; }
    __device__ __forceinline__ int b_tile(const Unit&) const { return 0; }
    __device__ __forceinline__ size_t b_off(const Unit& u) const { return (size_t)u.pn * wbytes; }
    __device__ __forceinline__ void done(const Unit&) const {}
};


__device__ __forceinline__ unsigned cvt_pk_bf16(float lo, float hi) { unsigned r; asm volatile("v_cvt_pk_bf16_f32 %0, %1, %2" : "=v"(r) : "v"(lo), "v"(hi)); return r; }
template <int MODE> struct EpiBf16x {
    static constexpr bool PERM = true, AFTER_DRAIN = false;
    bf16_t* O; int ldc; float sc; int nsc; float sc2; int lo2, hi2;
    const unsigned long long* SS; float inv_n, eps;
    __device__ __forceinline__ void operator()(const f32x4 (&acc)[2][2][4][2], const Unit& u, int wr, int wc, int fr, int fq) const {
        const int row0 = u.pm * BM + wr * 64 + fr, col0 = u.pn * BM + wc * 32 + 8 * fq;
        const float s = (MODE == 0) ? ((u.pn < nsc) ? sc : ((u.pn >= lo2 && u.pn < hi2) ? sc2 : 1.f)) : 1.f;
#pragma unroll
        for (int ai = 0; ai < 2; ++ai)
#pragma unroll
            for (int m = 0; m < 4; ++m) { bf16_t* rowp = O + (size_t)(row0 + ai * HALF + m * 16) * ldc + col0;
                const float sr = SS ? s / sqrtf((float)SS[row0 + ai * HALF + m * 16] * (inv_n * (1.f / 16777216.f)) + eps) : s;
#pragma unroll
                for (int bj = 0; bj < 2; ++bj) { f32x4 v0 = acc[ai][bj][m][0], v1 = acc[ai][bj][m][1];
                    if (MODE == 0) { v0 = v0 * sr; v1 = v1 * sr; }
                    if (MODE == 1) {
#pragma unroll
                        for (int j = 0; j < 4; ++j) { const float a = fmaxf(v0[j], 0.f), b = fmaxf(v1[j], 0.f); v0[j] = a * a; v1[j] = b * b; } }
                    u32x4 w; w.x = cvt_pk_bf16(v0[0], v0[1]); w.y = cvt_pk_bf16(v0[2], v0[3]); w.z = cvt_pk_bf16(v1[0], v1[1]); w.w = cvt_pk_bf16(v1[2], v1[3]);
                    *(u32x4*)(rowp + bj * HALF) = w; } }
    }
};
struct EpiF32x {
    static constexpr bool PERM = false, AFTER_DRAIN = false;
    float* C; int ldc; const float* base;
    __device__ __forceinline__ void operator()(const f32x4 (&acc)[2][2][4][2], const Unit& u, int wr, int wc, int fr, int fq) const {
        const int row0 = u.pm * BM + wr * 64 + fr, col0 = u.pn * BM + wc * 32 + 4 * fq;
#pragma unroll
        for (int ai = 0; ai < 2; ++ai)
#pragma unroll
            for (int m = 0; m < 4; ++m) { const size_t off = (size_t)(row0 + ai * HALF + m * 16) * ldc + col0;
#pragma unroll
                for (int bj = 0; bj < 2; ++bj)
#pragma unroll
                    for (int n = 0; n < 2; ++n) { f32x4 v = acc[ai][bj][m][n]; if (base) v = v + *(const f32x4*)(base + off + bj * HALF + n * 16); *(f32x4*)(C + off + bj * HALF + n * 16) = v; }
                asm volatile("" ::: "memory"); }
    }
};

__device__ __forceinline__ float xor16_sum(float v) { auto rr = __builtin_amdgcn_permlane16_swap(__float_as_uint(v), __float_as_uint(v), false, false); return __uint_as_float(rr[0]) + __uint_as_float(rr[1]); }
__device__ __forceinline__ float xor32_sum(float v) { auto rr = __builtin_amdgcn_permlane32_swap(__float_as_uint(v), __float_as_uint(v), false, false); return __uint_as_float(rr[0]) + __uint_as_float(rr[1]); }
struct EpiF32xN {
    static constexpr bool PERM = true, AFTER_DRAIN = false;
    float* C; int ldc; const float* base; bf16_t* XB; unsigned long long* SS;
    __device__ __forceinline__ void operator()(const f32x4 (&acc)[2][2][4][2], const Unit& u, int wr, int wc, int fr, int fq) const {
        const int row0 = u.pm * BM + wr * 64 + fr, col0 = u.pn * BM + wc * 32 + 8 * fq;
#pragma unroll
        for (int ai = 0; ai < 2; ++ai)
#pragma unroll
            for (int m = 0; m < 4; ++m) { const int row = row0 + ai * HALF + m * 16; const size_t off = (size_t)row * ldc + col0; float s = 0.f;
#pragma unroll
                for (int bj = 0; bj < 2; ++bj) { f32x4 v0 = acc[ai][bj][m][0], v1 = acc[ai][bj][m][1];
                    v0 = v0 + *(const f32x4*)(base + off + bj * HALF); v1 = v1 + *(const f32x4*)(base + off + bj * HALF + 4);
                    *(f32x4*)(C + off + bj * HALF) = v0; *(f32x4*)(C + off + bj * HALF + 4) = v1;
                    s += (v0[0] * v0[0] + v0[1] * v0[1]) + (v0[2] * v0[2] + v0[3] * v0[3]) + (v1[0] * v1[0] + v1[1] * v1[1]) + (v1[2] * v1[2] + v1[3] * v1[3]);
                    u32x4 w; w.x = cvt_pk_bf16(v0[0], v0[1]); w.y = cvt_pk_bf16(v0[2], v0[3]); w.z = cvt_pk_bf16(v1[0], v1[1]); w.w = cvt_pk_bf16(v1[2], v1[3]);
                    *(u32x4*)(XB + off + bj * HALF) = w; }
                s = xor16_sum(s); s = xor32_sum(s);
                if (fq == 0) __hip_atomic_fetch_add(SS + row, (unsigned long long)(s * 16777216.f), __ATOMIC_RELAXED, __HIP_MEMORY_SCOPE_AGENT);
                asm volatile("" ::: "memory"); }
    }
};
__device__ __forceinline__ float bf_lo(unsigned w) { return __uint_as_float(w << 16); }
__device__ __forceinline__ float bf_hi(unsigned w) { return __uint_as_float(w & 0xffff0000u); }
struct EpiResN {
    static constexpr bool PERM = true, AFTER_DRAIN = false;
    bf16_t* X; int ldc; const float* basef; const bf16_t* baseb; unsigned long long* SS;
    __device__ __forceinline__ void operator()(const f32x4 (&acc)[2][2][4][2], const Unit& u, int wr, int wc, int fr, int fq) const {
        const int row0 = u.pm * BM + wr * 64 + fr, col0 = u.pn * BM + wc * 32 + 8 * fq;
#pragma unroll
        for (int ai = 0; ai < 2; ++ai)
#pragma unroll
            for (int m = 0; m < 4; ++m) { const int row = row0 + ai * HALF + m * 16; const size_t off = (size_t)row * ldc + col0; float s = 0.f;
#pragma unroll
                for (int bj = 0; bj < 2; ++bj) { f32x4 v0 = acc[ai][bj][m][0], v1 = acc[ai][bj][m][1];
                    if (basef) { v0 = v0 + *(const f32x4*)(basef + off + bj * HALF); v1 = v1 + *(const f32x4*)(basef + off + bj * HALF + 4); }
                    else { const u32x4 w = *(const u32x4*)(baseb + off + bj * HALF);
                        v0[0] += bf_lo(w.x); v0[1] += bf_hi(w.x); v0[2] += bf_lo(w.y); v0[3] += bf_hi(w.y); v1[0] += bf_lo(w.z); v1[1] += bf_hi(w.z); v1[2] += bf_lo(w.w); v1[3] += bf_hi(w.w); }
                    s += (v0[0] * v0[0] + v0[1] * v0[1]) + (v0[2] * v0[2] + v0[3] * v0[3]) + (v1[0] * v1[0] + v1[1] * v1[1]) + (v1[2] * v1[2] + v1[3] * v1[3]);
                    u32x4 o; o.x = cvt_pk_bf16(v0[0], v0[1]); o.y = cvt_pk_bf16(v0[2], v0[3]); o.z = cvt_pk_bf16(v1[0], v1[1]); o.w = cvt_pk_bf16(v1[2], v1[3]);
                    *(u32x4*)(X + off + bj * HALF) = o; }
                if (SS) { s = xor16_sum(s); s = xor32_sum(s);
                    if (fq == 0) __hip_atomic_fetch_add(SS + row, (unsigned long long)(s * 16777216.f), __ATOMIC_RELAXED, __HIP_MEMORY_SCOPE_AGENT); }
                asm volatile("" ::: "memory"); }
    }
};
struct EpiUpN {
    static constexpr bool PERM = true, AFTER_DRAIN = false;
    bf16_t* O; int ldc; const unsigned long long* SS; float inv_n, eps;
    __device__ __forceinline__ void operator()(const f32x4 (&acc)[2][2][4][2], const Unit& u, int wr, int wc, int fr, int fq) const {
        const int row0 = u.pm * BM + wr * 64 + fr, col0 = u.pn * BM + wc * 32 + 8 * fq;
#pragma unroll
        for (int ai = 0; ai < 2; ++ai)
#pragma unroll
            for (int m = 0; m < 4; ++m) { const int row = row0 + ai * HALF + m * 16; bf16_t* rowp = O + (size_t)row * ldc + col0;
                const float rstd = 1.0f / sqrtf((float)SS[row] * (inv_n * (1.f / 16777216.f)) + eps);
#pragma unroll
                for (int bj = 0; bj < 2; ++bj) { f32x4 v0 = acc[ai][bj][m][0] * rstd, v1 = acc[ai][bj][m][1] * rstd;
#pragma unroll
                    for (int j = 0; j < 4; ++j) { const float a = fmaxf(v0[j], 0.f), b = fmaxf(v1[j], 0.f); v0[j] = a * a; v1[j] = b * b; }
                    u32x4 w; w.x = cvt_pk_bf16(v0[0], v0[1]); w.y = cvt_pk_bf16(v0[2], v0[3]); w.z = cvt_pk_bf16(v1[0], v1[1]); w.w = cvt_pk_bf16(v1[2], v1[3]);
                    *(u32x4*)(rowp + bj * HALF) = w; } }
    }
};

struct EpiLora {
    static constexpr bool PERM = true, AFTER_DRAIN = false;
    float* ZW; bf16_t* ZB;
    __device__ __forceinline__ void operator()(const f32x4 (&acc)[2][2][4][2], const Unit& u, int wr, int wc, int fr, int fq) const {
        const int row0 = u.pm * BM + wr * 64 + fr, col0 = u.pn * BM + wc * 32 + 8 * fq;
        if (u.pn < 8) {
#pragma unroll
            for (int ai = 0; ai < 2; ++ai)
#pragma unroll
                for (int m = 0; m < 4; ++m) { float* rowp = ZW + (size_t)(row0 + ai * HALF + m * 16) * 2048 + col0;
#pragma unroll
                    for (int bj = 0; bj < 2; ++bj) { *(f32x4*)(rowp + bj * HALF) = acc[ai][bj][m][0]; *(f32x4*)(rowp + bj * HALF + 4) = acc[ai][bj][m][1]; }
                    asm volatile("" ::: "memory"); }
        } else {
#pragma unroll
            for (int ai = 0; ai < 2; ++ai)
#pragma unroll
                for (int m = 0; m < 4; ++m) { bf16_t* rowp = ZB + (size_t)(row0 + ai * HALF + m * 16) * 6144 + (col0 - 2048);
#pragma unroll
                    for (int bj = 0; bj < 2; ++bj) { const f32x4 v0 = acc[ai][bj][m][0], v1 = acc[ai][bj][m][1];
                        u32x4 w; w.x = cvt_pk_bf16(v0[0], v0[1]); w.y = cvt_pk_bf16(v0[2], v0[3]); w.z = cvt_pk_bf16(v1[0], v1[1]); w.w = cvt_pk_bf16(v1[2], v1[3]);
                        *(u32x4*)(rowp + bj * HALF) = w; }
                    asm volatile("" ::: "memory"); }
        }
    }
};
struct LoraOrder : StaticOrder {
    __device__ __forceinline__ size_t a_off(const Unit& u) const { return (size_t)(u.pn >> 3) * 256 * 2; }
};
template <class Epi, class Sched, bool ALIGN_EPI = false, bool SP2 = false>
__device__ __forceinline__ void gemm_phase(PG8_LAS unsigned char* lds, const Gemm g, const Sched& S, const Epi& E, const int tid) {
    const int wid = __builtin_amdgcn_readfirstlane(tid >> 6), lane = tid & 63, wr = wid >> 2, wc = wid & 3, fr = lane & 15, fq = lane >> 4;
    const int K = g.K, nt = K / BK;
    unsigned voffA[2], voffB[2];
#pragma unroll
    for (int i = 0; i < 2; ++i) { int R, C; stage_rc(tid * 16 + i * 8192, R, C); const int Rb = Epi::PERM ? ((R & ~31) + perm32(R & 31)) : R;
        voffA[i] = (unsigned)(R * g.lda + C) * 2u; voffB[i] = (unsigned)(Rb * g.ldb + C) * 2u; }
    const size_t kstep = (size_t)(BK * 2);
    const size_t hA = (size_t)HALF * g.lda * 2, hB = (size_t)HALF * g.ldb * 2;
    const size_t tA = 2 * hA, tB = 2 * hB;
    const unsigned ldsw = (unsigned)wid * 1024u;
    const int aoff = lds_byte(wr * 64 + fr, fq * 8), boff = lds_byte(wc * 32 + fr, fq * 8);
#define PG8_SA(b, h) (((b) * 2 + (h)) * HTB)
#define PG8_SB(b, h) ((4 + (b) * 2 + (h)) * HTB)
#define PG8_STAGE(bufoff, gbase, voff) do { _Pragma("unroll") for (int _i = 0; _i < 2; ++_i) \
        __builtin_amdgcn_global_load_lds((const unsigned*)((const char*)(gbase) + (voff)[_i]), (PG8_LAS unsigned*)(lds + (bufoff) + ldsw + _i * 8192), 16, 0, 0); } while (0)
#define PG8_LDA(dst, b, h) do { _Pragma("unroll") for (int m = 0; m < 4; ++m) _Pragma("unroll") for (int k = 0; k < 2; ++k) dst[m][k] = *(const PG8_LAS bf16x8*)(lds + PG8_SA(b, h) + aoff + m * 2048 + k * 1024); } while (0)
#define PG8_LDB(dst, b, h) do { _Pragma("unroll") for (int n = 0; n < 2; ++n) _Pragma("unroll") for (int k = 0; k < 2; ++k) dst[n][k] = *(const PG8_LAS bf16x8*)(lds + PG8_SB(b, h) + boff + n * 2048 + k * 1024); } while (0)
#define PG8_MMA(ai, bj, At, Bt) do { __builtin_amdgcn_s_setprio(1); _Pragma("unroll") for (int m = 0; m < 4; ++m) _Pragma("unroll") for (int n = 0; n < 2; ++n) _Pragma("unroll") for (int k = 0; k < 2; ++k) \
        acc[ai][bj][m][n] = __builtin_amdgcn_mfma_f32_16x16x32_bf16(Bt[n][k], At[m][k], acc[ai][bj][m][n], 0, 0, 0); __builtin_amdgcn_s_setprio(0); } while (0)
#define PG8_WAIT_V(n) asm volatile("s_waitcnt vmcnt(" #n ")" ::: "memory")
#define PG8_WAIT_L(n) asm volatile("s_waitcnt lgkmcnt(" #n ")" ::: "memory")
#define PG8_BAR __builtin_amdgcn_s_barrier()
#define PG8_SCHED __builtin_amdgcn_sched_barrier(0)
    Unit cur, nxt; int ui = 0;
    if (!S.next(0, cur)) return;
    f32x4 acc[2][2][4][2];
#pragma unroll
    for (int a = 0; a < 2; ++a)
#pragma unroll
        for (int b = 0; b < 2; ++b)
#pragma unroll
            for (int m = 0; m < 4; ++m)
#pragma unroll
                for (int n = 0; n < 2; ++n) acc[a][b][m][n] = (f32x4){0.f, 0.f, 0.f, 0.f};
    bf16x8 At[4][2], B0[2][2], B1[2][2];
    const char* cA = (const char*)g.A + (size_t)cur.pm * tA + S.a_off(cur); const char* cB = (const char*)g.Bt + (size_t)S.b_tile(cur) * tB + S.b_off(cur);
    S.a_ready(cur);
    if constexpr (SP2) {
        PG8_STAGE(PG8_SB(0, 0), cB, voffB); PG8_STAGE(PG8_SB(0, 1), cB + hB, voffB); PG8_STAGE(PG8_SA(0, 0), cA, voffA); PG8_STAGE(PG8_SA(0, 1), cA + hA, voffA);
        if (wr == 1) PG8_BAR;
        PG8_WAIT_V(2); PG8_BAR;
        PG8_STAGE(PG8_SB(1, 0), cB + kstep, voffB); PG8_STAGE(PG8_SA(1, 0), cA + kstep, voffA); PG8_STAGE(PG8_SB(1, 1), cB + hB + kstep, voffB);
        PG8_WAIT_V(6); PG8_BAR;
    } else {
        PG8_STAGE(PG8_SB(0, 0), cB, voffB); PG8_STAGE(PG8_SA(0, 0), cA, voffA); PG8_STAGE(PG8_SB(0, 1), cB + hB, voffB); PG8_STAGE(PG8_SA(0, 1), cA + hA, voffA);
        if (wr == 1) PG8_BAR;
        PG8_WAIT_V(4); PG8_BAR;
        PG8_STAGE(PG8_SB(1, 0), cB + kstep, voffB); PG8_STAGE(PG8_SA(1, 0), cA + kstep, voffA); PG8_STAGE(PG8_SB(1, 1), cB + hB + kstep, voffB);
        PG8_WAIT_V(6); PG8_BAR;
    }
    for (;;) {
        const bool has_next = S.next(ui + 1, nxt);
        const char* nA = has_next ? (const char*)g.A + (size_t)nxt.pm * tA + S.a_off(nxt) : cA; const char* nB = has_next ? (const char*)g.Bt + (size_t)S.b_tile(nxt) * tB + S.b_off(nxt) : cB;
        for (int t = 0; t < nt; t += 2) {
            const bool last = (t == nt - 2);
            const char* a1 = cA + (size_t)(t + 1) * kstep;
            const char* a2 = last ? nA : cA + (size_t)(t + 2) * kstep; const char* b2 = last ? nB : cB + (size_t)(t + 2) * kstep;
            const char* a3 = a2 + kstep; const char* b3 = b2 + kstep;
            if (last && has_next) S.a_ready(nxt);
            if constexpr (SP2) {
            PG8_LDB(B0, 0, 0); PG8_LDB(B1, 0, 1); PG8_SCHED; PG8_LDA(At, 0, 0); PG8_STAGE(PG8_SA(1, 1), a1 + hA, voffA);
            PG8_WAIT_V(8); PG8_WAIT_L(0); PG8_BAR; PG8_MMA(0, 0, At, B0); PG8_MMA(0, 1, At, B1); PG8_BAR; PG8_SCHED;
            PG8_LDA(At, 0, 1); PG8_STAGE(PG8_SB(0, 0), b2, voffB); PG8_STAGE(PG8_SB(0, 1), b2 + hB, voffB); PG8_STAGE(PG8_SA(0, 0), a2, voffA);
            PG8_WAIT_V(8); PG8_WAIT_L(0); PG8_BAR; PG8_MMA(1, 0, At, B0); PG8_MMA(1, 1, At, B1); PG8_BAR; PG8_SCHED;
            PG8_LDB(B0, 1, 0); PG8_LDB(B1, 1, 1); PG8_SCHED; PG8_LDA(At, 1, 0); PG8_STAGE(PG8_SA(0, 1), a2 + hA, voffA);
            PG8_WAIT_V(8); PG8_WAIT_L(0); PG8_BAR; PG8_MMA(0, 0, At, B0); PG8_MMA(0, 1, At, B1); PG8_BAR; PG8_SCHED;
            PG8_LDA(At, 1, 1); PG8_STAGE(PG8_SB(1, 0), b3, voffB); PG8_STAGE(PG8_SB(1, 1), b3 + hB, voffB); PG8_STAGE(PG8_SA(1, 0), a3, voffA);
            PG8_WAIT_V(8); PG8_WAIT_L(0); PG8_BAR; PG8_MMA(1, 0, At, B0); PG8_MMA(1, 1, At, B1); PG8_BAR; PG8_SCHED;
            } else {
            PG8_LDB(B0, 0, 0); PG8_SCHED; PG8_LDA(At, 0, 0); PG8_STAGE(PG8_SA(1, 1), a1 + hA, voffA);
            PG8_WAIT_L(8); PG8_BAR; PG8_WAIT_L(0); PG8_MMA(0, 0, At, B0); PG8_BAR; PG8_SCHED;
            PG8_LDB(B1, 0, 1); PG8_STAGE(PG8_SB(0, 0), b2, voffB);
            PG8_BAR; PG8_WAIT_L(0); PG8_MMA(0, 1, At, B1); PG8_BAR;
            PG8_LDA(At, 0, 1); PG8_STAGE(PG8_SA(0, 0), a2, voffA);
            PG8_BAR; PG8_WAIT_L(0); PG8_MMA(1, 0, At, B0); PG8_BAR; PG8_SCHED;
            PG8_STAGE(PG8_SB(0, 1), b2 + hB, voffB);
            PG8_WAIT_V(6); PG8_BAR; PG8_MMA(1, 1, At, B1); PG8_BAR;
            PG8_LDB(B0, 1, 0); PG8_SCHED; PG8_LDA(At, 1, 0); PG8_STAGE(PG8_SA(0, 1), a2 + hA, voffA);
            PG8_WAIT_L(8); PG8_BAR; PG8_WAIT_L(0); PG8_MMA(0, 0, At, B0); PG8_BAR; PG8_SCHED;
            PG8_LDB(B1, 1, 1); PG8_STAGE(PG8_SB(1, 0), b3, voffB);
            PG8_BAR; PG8_WAIT_L(0); PG8_MMA(0, 1, At, B1); PG8_BAR;
            PG8_LDA(At, 1, 1); PG8_STAGE(PG8_SA(1, 0), a3, voffA);
            PG8_BAR; PG8_WAIT_L(0); PG8_MMA(1, 0, At, B0); PG8_BAR; PG8_SCHED;
            PG8_STAGE(PG8_SB(1, 1), b3 + hB, voffB);
            PG8_WAIT_V(6); PG8_BAR; PG8_MMA(1, 1, At, B1); PG8_BAR;
            }
        }
        if constexpr (ALIGN_EPI) { if (wr == 0) PG8_BAR; }
        if constexpr (!Epi::AFTER_DRAIN) { E(acc, cur, wr, wc, fr, fq); S.done(cur); }
        if (!has_next) break;
#pragma unroll
        for (int a = 0; a < 2; ++a)
#pragma unroll
            for (int b = 0; b < 2; ++b)
#pragma unroll
                for (int m = 0; m < 4; ++m)
#pragma unroll
                    for (int n = 0; n < 2; ++n) acc[a][b][m][n] = (f32x4){0.f, 0.f, 0.f, 0.f};
        cur = nxt; cA = nA; cB = nB; ++ui;
        if constexpr (ALIGN_EPI) { if (wr == 1) PG8_BAR; }
    }
    PG8_WAIT_V(0);
    if constexpr (!ALIGN_EPI) { if (wr == 0) PG8_BAR; }
    PG8_BAR;
    if constexpr (Epi::AFTER_DRAIN) { E.fused(acc, cur, wr, wc, fr, fq, lds, wid, lane); S.done(cur); }
#undef PG8_SA
#undef PG8_SB
#undef PG8_STAGE
#undef PG8_LDA
#undef PG8_LDB
#undef PG8_MMA
#undef PG8_WAIT_V
#undef PG8_WAIT_L
#undef PG8_BAR
#undef PG8_SCHED
}
}
#include <hip/hip_bf16.h>
#include <cmath>
namespace attn_body {
using bf16=__hip_bfloat16;
using bf16x8=__attribute__((ext_vector_type(8)))short;
using s16x4=__attribute__((ext_vector_type(4)))short;
using f32x16=__attribute__((ext_vector_type(16)))float;
using u32x4=__attribute__((ext_vector_type(4)))unsigned;
constexpr int SEQ=8192,D=64,DM=14592,DO=1024;
constexpr int NW=8,QBLK=32,QB=QBLK*NW,KVBLK=64,NQB=SEQ/QB;
constexpr int ATTN_UNIT_ROWS=QB;
__device__ __forceinline__ int crow(int r,int hi){return (r&3)+8*(r>>2)+4*hi;}
#define SBAR() __builtin_amdgcn_sched_barrier(0)
__device__ __forceinline__ void cmask(f32x16&p0,f32x16&p1,int jb,int qrel,int hi){
  const float NEG=-INFINITY; int kb=64*jb+4*hi;
  #pragma unroll
  for(int r=0;r<16;++r){int kv=kb+(r&3)+8*(r>>2); if(kv>qrel)p0[r]=NEG; if(kv+32>qrel)p1[r]=NEG;}
}

constexpr int NSLOT=3, SLOTB=8192;
constexpr int LDS_K=0, LDS_V=NSLOT*SLOTB, LDS_WS=2*NSLOT*SLOTB, LDS_OST=LDS_WS+NW*64*4, LDS_BYTES=LDS_OST+NW*4096;
constexpr float C2=0.125f*1.4426950408889634f;
__device__ __forceinline__ void glds16(const void*sbase,unsigned voff,unsigned lds_dst){unsigned keep;
  asm volatile("s_mov_b32 %0, m0\n\ts_mov_b32 m0, %3\n\ts_nop 0\n\tglobal_load_lds_dwordx4 %1, %2\n\ts_mov_b32 m0, %0":"=&s"(keep):"v"(voff),"s"(sbase),"s"(lds_dst):"memory");}
__device__ __forceinline__ float max3f(float a,float b,float c){float r;asm("v_max3_f32 %0, %1, %2, %3":"=v"(r):"v"(a),"v"(b),"v"(c));return r;}
__device__ __forceinline__ float max2f(float a,float b){float r;asm("v_max_f32_e32 %0, %1, %2":"=v"(r):"v"(a),"v"(b));return r;}
__device__ __forceinline__ float fadd_s(float a,float b){float r;asm("v_add_f32_e32 %0, %1, %2":"=v"(r):"v"(a),"v"(b));return r;}
__device__ __forceinline__ float fsub_s(float a,float b){float r;asm("v_sub_f32_e32 %0, %1, %2":"=v"(r):"v"(a),"v"(b));return r;}
typedef float f32x2_t __attribute__((ext_vector_type(2))); typedef __bf16 bf16x2_t __attribute__((ext_vector_type(2)));
__device__ __forceinline__ unsigned cvtpk_s(float lo,float hi){f32x2_t v={lo,hi};bf16x2_t b=__builtin_convertvector(v,bf16x2_t);return __builtin_bit_cast(unsigned,b);}
#define WAIT_BAR(N) asm volatile("s_waitcnt vmcnt(" #N ") lgkmcnt(0)\n\ts_barrier":::"memory")

__device__ __forceinline__ void qkt(f32x16&p0,f32x16&p1,const char*Kslot,const bf16x8*qr,const f32x16&negm,int r32,int hi){
  const char*kb=Kslot+hi*1024+r32*16;
  #pragma unroll
  for(int d0=0;d0<4;++d0){
    const bf16x8 b0=*reinterpret_cast<const bf16x8*>(kb+d0*2048);
    const bf16x8 b1=*reinterpret_cast<const bf16x8*>(kb+d0*2048+512);
    if(d0==0){p0=__builtin_amdgcn_mfma_f32_32x32x16_bf16(b0,qr[0],negm,0,0,0);p1=__builtin_amdgcn_mfma_f32_32x32x16_bf16(b1,qr[0],negm,0,0,0);}
    else{p0=__builtin_amdgcn_mfma_f32_32x32x16_bf16(b0,qr[d0],p0,0,0,0);p1=__builtin_amdgcn_mfma_f32_32x32x16_bf16(b1,qr[d0],p1,0,0,0);}}
}
typedef __attribute__((address_space(3))) const char* lds_cptr;
typedef short v4i16_t __attribute__((ext_vector_type(4)));
__device__ __forceinline__ void kload8(bf16x8*kf,lds_cptr kp){
  kf[0]=*(const __attribute__((address_space(3))) bf16x8*)(kp);      kf[1]=*(const __attribute__((address_space(3))) bf16x8*)(kp+512);
  kf[2]=*(const __attribute__((address_space(3))) bf16x8*)(kp+2048); kf[3]=*(const __attribute__((address_space(3))) bf16x8*)(kp+2560);
  kf[4]=*(const __attribute__((address_space(3))) bf16x8*)(kp+4096); kf[5]=*(const __attribute__((address_space(3))) bf16x8*)(kp+4608);
  kf[6]=*(const __attribute__((address_space(3))) bf16x8*)(kp+6144); kf[7]=*(const __attribute__((address_space(3))) bf16x8*)(kp+6656);
}
__device__ __forceinline__ void kload2(bf16x8*kf,lds_cptr kp,int j){ kf[2*j]=*(const __attribute__((address_space(3))) bf16x8*)(kp+j*2048); kf[2*j+1]=*(const __attribute__((address_space(3))) bf16x8*)(kp+j*2048+512); }
__device__ __forceinline__ s16x4 vtr(lds_cptr p){ return __builtin_bit_cast(s16x4,__builtin_amdgcn_ds_read_tr16_b64_v4i16((__attribute__((address_space(3))) v4i16_t*)p)); }
__device__ __forceinline__ float rowmax(const f32x16&p0,const f32x16&p1){
  float a=max3f(p0[0],p0[1],p1[0]),b=max3f(p0[2],p0[3],p1[1]);a=max3f(a,p1[2],p1[3]);
  #pragma unroll
  for(int r=4;r<16;r+=4){a=max3f(a,p0[r],p0[r+1]);b=max3f(b,p0[r+2],p0[r+3]);a=max3f(a,p1[r],p1[r+1]);b=max3f(b,p1[r+2],p1[r+3]);}
  const float m=max2f(a,b);
  auto rr=__builtin_amdgcn_permlane32_swap(__float_as_uint(m),__float_as_uint(m),false,false);
  return max2f(__uint_as_float(rr[0]),__uint_as_float(rr[1]));
}
__device__ __forceinline__ void pv(f32x16*o,int vb,bf16x8 pa0,bf16x8 pa1,bf16x8 pa2,bf16x8 pa3){
  #pragma unroll
  for(int d0=0;d0<2;++d0){s16x4 lo[4],hi[4];
    #pragma unroll
    for(int ks=0;ks<4;++ks){
      asm volatile("ds_read_b64_tr_b16 %0,%1 offset:%c2":"=&v"(lo[ks]):"v"(vb),"i"(d0*4096+ks*1024):"memory");
      asm volatile("ds_read_b64_tr_b16 %0,%1 offset:%c2":"=&v"(hi[ks]):"v"(vb),"i"(d0*4096+ks*1024+512):"memory");}
    asm volatile("s_waitcnt lgkmcnt(0)":::"memory");SBAR();
    #define PK(k) (bf16x8){lo[k][0],lo[k][1],lo[k][2],lo[k][3],hi[k][0],hi[k][1],hi[k][2],hi[k][3]}
    o[d0]=__builtin_amdgcn_mfma_f32_32x32x16_bf16(pa0,PK(0),o[d0],0,0,0);
    o[d0]=__builtin_amdgcn_mfma_f32_32x32x16_bf16(pa1,PK(1),o[d0],0,0,0);
    o[d0]=__builtin_amdgcn_mfma_f32_32x32x16_bf16(pa2,PK(2),o[d0],0,0,0);
    o[d0]=__builtin_amdgcn_mfma_f32_32x32x16_bf16(pa3,PK(3),o[d0],0,0,0);
    #undef PK
  }
}

#ifndef ATTN_STORE16
#define ATTN_STORE16(p,v) (*(u32x4*)(p)=(v))
#endif
template<int THRL> __device__ __forceinline__ void attn_unit(int qc,int kc,int vc,int oc,int qb,const bf16*Q,const bf16*__restrict__ K,const bf16*__restrict__ V,bf16*O,char*shm,const int tid){
  const int lane=tid&63,r32=lane&31,hi=lane>>5; const int wid=__builtin_amdgcn_readfirstlane(tid>>6);
  const long rowbase=0; const int q0=qb*QB;
  const bf16*Qw=Q+(rowbase+q0+wid*QBLK)*DM+qc;
  const bf16*Kh=K+rowbase*DM+kc,*Vh=V+rowbase*DM+vc;
  const unsigned lds0=(unsigned)(uintptr_t)shm;
  float*wsf=(float*)(shm+LDS_WS)+wid*64;
  const unsigned koff=(unsigned)(lane*DM+wid*8)*2u;
  const unsigned voff=(unsigned)((16*(wid&3)+(lane>>2))*DM+(wid>>2)*32+(lane&3)*8)*2u;
  const unsigned kdst=lds0+LDS_K+wid*1024, vdst=lds0+LDS_V+wid*1024;
  #define DMA_K(t,slot) glds16((const char*)Kh+(size_t)(t)*(KVBLK*DM*2),koff,(unsigned)__builtin_amdgcn_readfirstlane(kdst+(slot)))
  #define DMA_V(t,slot) glds16((const char*)Vh+(size_t)(t)*(KVBLK*DM*2),voff,(unsigned)__builtin_amdgcn_readfirstlane(vdst+(slot)))
  const int vb0=(int)(lds0+LDS_V)+((lane>>4)&1)*32+(lane&3)*8+(4*hi+((lane&15)>>2))*64;
  const char*Kbase=shm+LDS_K; bf16x8 kf[8];
  const lds_cptr shm3=(lds_cptr)shm; const lds_cptr kp0=shm3+LDS_K+hi*1024+r32*16; const lds_cptr vp0=shm3+LDS_V+((lane>>4)&1)*32+(lane&3)*8+(4*hi+((lane&15)>>2))*64;
  const int NT=(q0+QB)/KVBLK;
  DMA_K(0,0);DMA_V(0,0);DMA_K(1,SLOTB);
  bf16x8 qr[4];
  #pragma unroll
  for(int d0=0;d0<4;++d0)qr[d0]=*reinterpret_cast<const bf16x8*>(&Qw[(long)r32*DM+d0*16+hi*8]);
  float mhat=0.f,l_reg=0.f;f32x16 o[2];o[0]=f32x16{};o[1]=f32x16{};f32x16 negm=f32x16{};asm volatile("":"+v"(negm));
  const int qrel=wid*QBLK+r32;
  #define CMASK(P0,P1,t) do{int jb_=(t)-(NT-4); if(jb_>=0)cmask(P0,P1,jb_,qrel,hi);}while(0)
  bool resc=false;
  #define START(P0,P1) do{ const float rm=rowmax(P0,P1); resc=false; \
    { const float dl=rm; mhat=fadd_s(mhat,dl); \
      _Pragma("unroll") for(int r=0;r<16;++r){P0[r]=fsub_s(P0[r],dl);P1[r]=fsub_s(P1[r],dl);} \
      _Pragma("unroll") for(int r=0;r<16;++r)negm[r]=-mhat; asm volatile("":"+v"(negm)); } \
    _Pragma("unroll") for(int r=0;r<16;++r)P0[r]=__builtin_amdgcn_exp2f(P0[r]); }while(0)
  #define RESC() do{ if(resc){ asm volatile("s_waitcnt lgkmcnt(0)":::"memory"); \
      _Pragma("unroll") for(int d_=0;d_<2;++d_) _Pragma("unroll") for(int r=0;r<16;++r)o[d_][r]*=wsf[crow(r,hi)]; } }while(0)
  f32x16 pA0,pA1,pB0,pB1;
  int sl_prev=0,sl_cur=0,sl_next=SLOTB;
  #define ROT() do{sl_prev=sl_cur;sl_cur=sl_next;sl_next=(sl_next==(NSLOT-1)*SLOTB)?0:sl_next+SLOTB;}while(0)
  DMA_K(2,2*SLOTB);
  WAIT_BAR(3);
  qkt(pA0,pA1,Kbase,qr,negm,r32,hi);asm volatile("s_nop 15\n\ts_nop 7":"+v"(pA0),"+v"(pA1));CMASK(pA0,pA1,0);
  START(pA0,pA1);
  _Pragma("unroll") for(int r=0;r<16;++r)pA1[r]=__builtin_amdgcn_exp2f(pA1[r]);
  WAIT_BAR(0);
  DMA_K(3,0);DMA_V(1,SLOTB);
  ROT();
  kload8(kf,kp0+sl_cur);
  WAIT_BAR(2);
  s16x4 vlo[8],vhi[8]; u32x4 pw0,pw1,pw2,pw3;
  #define PKW(P,B) cvtpk_s(P[B],P[B+1])
  #define PAF(k) __builtin_bit_cast(bf16x8,pw##k)
  #define VFR(i) (bf16x8){vlo[i][0],vlo[i][1],vlo[i][2],vlo[i][3],vhi[i][0],vhi[i][1],vhi[i][2],vhi[i][3]}
  #define PIN(x) asm volatile("":"+v"(x))
  #define MX3(a,b,c) __builtin_fmaxf(__builtin_fmaxf((a),(b)),(c))
  #define GAPA(MF,A0,A1,A2,A3,W0,W1,PW) do{ MF; sacc+=A0; sacc+=A1; sacc+=A2; sacc+=A3; PIN(sacc); W0; W1; PIN(PW); SBAR(); }while(0)
  #define EX(v) __builtin_amdgcn_exp2f(v)
  #define GAPB(MF,X,B) do{ MF; X[B]=EX(X[B]); X[B+1]=EX(X[B+1]); X[B+2]=EX(X[B+2]); X[B+3]=EX(X[B+3]); PIN(X); SBAR(); }while(0)
  #define VRD(i) do{ vlo[i]=vtr(vp_+(((i)>>2)*4096+((i)&3)*1024)); vhi[i]=vtr(vp_+(((i)>>2)*4096+((i)&3)*1024+512)); }while(0)
  #define KRD(G,j) do{ if(G){ kload2(kf,kp0+sl_next,j); SBAR(); } }while(0)
  #define STEP(C0,C1,P0,P1,t,GK,GV,GL) do{ SBAR(); \
    const lds_cptr vp_=vp0+sl_prev; \
    VRD(0); SBAR(); float sacc=(P0[0]+P0[1]); \
    GAPA(C0=__builtin_amdgcn_mfma_f32_32x32x16_bf16(kf[0],qr[0],negm,0,0,0), P0[2],P0[3],P0[4],P0[5],     pw0[0]=PKW(P0,0), pw0[1]=PKW(P0,2), pw0); \
    VRD(4); SBAR(); GAPA(C1=__builtin_amdgcn_mfma_f32_32x32x16_bf16(kf[1],qr[0],negm,0,0,0), P0[6],P0[7],P0[8],P0[9],     pw0[2]=PKW(P0,4), pw0[3]=PKW(P0,6), pw0); \
    VRD(1); SBAR(); GAPA(C0=__builtin_amdgcn_mfma_f32_32x32x16_bf16(kf[2],qr[1],C0,0,0,0),   P0[10],P0[11],P0[12],P0[13], pw1[0]=PKW(P0,8), pw1[1]=PKW(P0,10), pw1); \
    VRD(5); SBAR(); GAPA(C1=__builtin_amdgcn_mfma_f32_32x32x16_bf16(kf[3],qr[1],C1,0,0,0),   P0[14],P0[15],P1[0],P1[1],   pw1[2]=PKW(P0,12),pw1[3]=PKW(P0,14), pw1); \
    VRD(2); SBAR(); GAPA(C0=__builtin_amdgcn_mfma_f32_32x32x16_bf16(kf[4],qr[2],C0,0,0,0),   P1[2],P1[3],P1[4],P1[5],     pw2[0]=PKW(P1,0), pw2[1]=PKW(P1,2), pw2); \
    VRD(6); SBAR(); GAPA(C1=__builtin_amdgcn_mfma_f32_32x32x16_bf16(kf[5],qr[2],C1,0,0,0),   P1[6],P1[7],P1[8],P1[9],     pw2[2]=PKW(P1,4), pw2[3]=PKW(P1,6), pw2); \
    VRD(3); SBAR(); GAPA(C0=__builtin_amdgcn_mfma_f32_32x32x16_bf16(kf[6],qr[3],C0,0,0,0),   P1[10],P1[11],P1[12],P1[13], pw3[0]=PKW(P1,8), pw3[1]=PKW(P1,10), pw3); \
    VRD(7); SBAR(); GAPA(C1=__builtin_amdgcn_mfma_f32_32x32x16_bf16(kf[7],qr[3],C1,0,0,0),   P1[14],P1[15],0.f,0.f,       pw3[2]=PKW(P1,12),pw3[3]=PKW(P1,14), pw3); \
    l_reg+=sacc; \
    if(GK){DMA_K((t)+3,sl_cur);} if(GV){DMA_V((t)+1,sl_next);} \
    CMASK(C0,C1,t); \
    { float a=MX3(C0[0],C0[1],C1[0]),b=MX3(C0[2],C0[3],C1[1]); a=MX3(a,C1[2],C1[3]); \
      _Pragma("unroll") for(int r=4;r<16;r+=4){a=MX3(a,C0[r],C0[r+1]);b=MX3(b,C0[r+2],C0[r+3]);a=MX3(a,C1[r],C1[r+1]);b=MX3(b,C1[r+2],C1[r+3]);} \
      float rm=__builtin_fmaxf(a,b); { auto rr=__builtin_amdgcn_permlane32_swap(__float_as_uint(rm),__float_as_uint(rm),false,false); rm=__builtin_fmaxf(__uint_as_float(rr[0]),__uint_as_float(rr[1])); } \
      resc=false; \
      if(__builtin_expect(__any(rm>(float)THRL),0)){ const float dl=__builtin_fmaxf(rm,0.f); mhat+=dl; \
        _Pragma("unroll") for(int r=0;r<16;++r){C0[r]-=dl;C1[r]-=dl;} \
        _Pragma("unroll") for(int r=0;r<16;++r)negm[r]=-mhat; asm volatile("":"+v"(negm)); \
        const float f=__builtin_amdgcn_exp2f(-dl); l_reg*=f; if(hi==0)wsf[r32]=f; resc=true; } } \
    SBAR(); \
    GAPB(o[0]=__builtin_amdgcn_mfma_f32_32x32x16_bf16(PAF(0),VFR(0),o[0],0,0,0), C0,0); \
    GAPB(o[1]=__builtin_amdgcn_mfma_f32_32x32x16_bf16(PAF(0),VFR(4),o[1],0,0,0), C0,4); \
    KRD(GL,0); GAPB(o[0]=__builtin_amdgcn_mfma_f32_32x32x16_bf16(PAF(1),VFR(1),o[0],0,0,0), C0,8); \
    KRD(GL,1); GAPB(o[1]=__builtin_amdgcn_mfma_f32_32x32x16_bf16(PAF(1),VFR(5),o[1],0,0,0), C0,12); \
    KRD(GL,2); GAPB(o[0]=__builtin_amdgcn_mfma_f32_32x32x16_bf16(PAF(2),VFR(2),o[0],0,0,0), C1,0); \
    KRD(GL,3); GAPB(o[1]=__builtin_amdgcn_mfma_f32_32x32x16_bf16(PAF(2),VFR(6),o[1],0,0,0), C1,4); \
    GAPB(o[0]=__builtin_amdgcn_mfma_f32_32x32x16_bf16(PAF(3),VFR(3),o[0],0,0,0), C1,8); \
    GAPB(o[1]=__builtin_amdgcn_mfma_f32_32x32x16_bf16(PAF(3),VFR(7),o[1],0,0,0), C1,12); \
    }while(0)
  int t=1;
  #undef CMASK
  #define CMASK(P0,P1,t) do{}while(0)
  for(;t+5<NT;t+=2){
    STEP(pB0,pB1,pA0,pA1,t,true,true,true);     WAIT_BAR(2); RESC(); ROT();
    STEP(pA0,pA1,pB0,pB1,t+1,true,true,true);   WAIT_BAR(2); RESC(); ROT();
  }
  #undef CMASK
  #define CMASK(P0,P1,t) do{int jb_=(t)-(NT-4); if(jb_>=0)cmask(P0,P1,jb_,qrel,hi);}while(0)
  #define ENDW(tt) do{ if((tt)+3<NT){WAIT_BAR(2);} else if((tt)+2<NT){WAIT_BAR(1);} else {WAIT_BAR(0);} }while(0)
  for(;t+1<NT;t+=2){
    STEP(pB0,pB1,pA0,pA1,t,(t+3<NT),(t+1<NT),(t+1<NT));       ENDW(t);   RESC(); ROT();
    STEP(pA0,pA1,pB0,pB1,t+1,(t+4<NT),(t+2<NT),(t+2<NT));     ENDW(t+1); RESC(); ROT();
  }
  STEP(pB0,pB1,pA0,pA1,NT-1,false,false,false); RESC();
  { float sacc=pB0[0]+pB0[1]; _Pragma("unroll") for(int r=2;r<16;++r)sacc+=pB0[r]; _Pragma("unroll") for(int r=0;r<16;++r)sacc+=pB1[r]; l_reg+=sacc;
    pw0=(u32x4){PKW(pB0,0),PKW(pB0,2),PKW(pB0,4),PKW(pB0,6)};pw1=(u32x4){PKW(pB0,8),PKW(pB0,10),PKW(pB0,12),PKW(pB0,14)};pw2=(u32x4){PKW(pB1,0),PKW(pB1,2),PKW(pB1,4),PKW(pB1,6)};pw3=(u32x4){PKW(pB1,8),PKW(pB1,10),PKW(pB1,12),PKW(pB1,14)};
    SBAR(); pv(o,vb0+sl_cur,PAF(0),PAF(1),PAF(2),PAF(3)); }
  #undef PKW
  #undef PAF
  #undef VFR
  #undef PIN
  #undef MX3
  #undef GAPA
  #undef GAPB
  #undef EX
  #undef VRD
  #undef KRD
  #undef STEP
  #undef ENDW
  {auto rr=__builtin_amdgcn_permlane32_swap(__float_as_uint(l_reg),__float_as_uint(l_reg),false,false);l_reg=__uint_as_float(rr[0])+__uint_as_float(rr[1]);}
  if(hi==0)wsf[32+r32]=l_reg;asm volatile("s_waitcnt lgkmcnt(0)":::"memory");
  float rli[16];
  #pragma unroll
  for(int r=0;r<16;++r)rli[r]=__builtin_amdgcn_rcpf(wsf[32+crow(r,hi)]);
  bf16*Ow=O+(rowbase+q0+wid*QBLK)*DO+oc;
  { bf16*stg=(bf16*)(shm+LDS_OST)+wid*2048;
    #pragma unroll
    for(int r=0;r<16;++r){const int orow=crow(r,hi);
      #pragma unroll
      for(int d0=0;d0<2;++d0)stg[orow*64+d0*32+r32]=__float2bfloat16(o[d0][r]*rli[r]);}
    asm volatile("s_waitcnt lgkmcnt(0)":::"memory");
    #pragma unroll
    for(int i=0;i<4;++i){const int row=i*8+(lane>>3),ch=lane&7; const u32x4 v=*(const u32x4*)(stg+row*64+ch*8); ATTN_STORE16(Ow+(long)row*DO+ch*8,v);} }
  asm volatile("s_waitcnt lgkmcnt(0)\n\ts_barrier":::"memory");
  #undef DMA_K
  #undef DMA_V
  #undef CMASK
  #undef START
  #undef RESC
  #undef ROT
}
constexpr int ATTN_LDS_BYTES=LDS_BYTES;
struct AttnTensors { const bf16* Q; const bf16* K; const bf16* V; bf16* O0; bf16* O1; };
struct AttnUnit { int bh; int qb; };
struct StaticOrder {
  int vcu;
  __device__ __forceinline__ explicit StaticOrder(int grid_,int block):vcu((grid_%8==0)?(block%8)*(grid_/8)+block/8:block),grid(grid_){}
  int grid;
  __device__ __forceinline__ bool next(int i,AttnUnit&u)const{ const int v=vcu+(i>>2)*grid; if(v>=256)return false; const int s=v&7,j=i&3; u.bh=v>>3; u.qb=(j==0)?s:(j==1)?15-s:(j==2)?16+s:31-s; return true; }
  __device__ __forceinline__ void a_ready(const AttnUnit&)const{}
  __device__ __forceinline__ void done(const AttnUnit&)const{}
};
template<class Sched,int THRL=8> __device__ __forceinline__ void attn_phase(char*lds,const AttnTensors&T,const Sched&S,const int tid){
  AttnUnit u;
  for(int i=0;S.next(i,u);++i){ S.a_ready(u); const int h=u.bh>>2,m=(u.bh>>1)&1,vh=u.bh&1; attn_unit<THRL>((2*h+m)*64,1024+(2*h+m)*64,2048+h*128+vh*64,h*128+vh*64,u.qb,T.Q,T.K,T.V,m?T.O1:T.O0,lds,tid); S.done(u); }
}
#undef SBAR
#undef WAIT_BAR
}
#define GAS __attribute__((address_space(1)))
#define LAS __attribute__((address_space(3)))
typedef unsigned short bf16;
typedef unsigned v4u __attribute__((ext_vector_type(4)));
typedef float f32x4 __attribute__((ext_vector_type(4)));
typedef short bf16x8 __attribute__((ext_vector_type(8)));
typedef GAS unsigned gu32;
typedef GAS unsigned long long gu64;
#define RLX_AGENT __ATOMIC_RELAXED, __HIP_MEMORY_SCOPE_AGENT
#define LDS_WAIT() asm volatile("s_waitcnt lgkmcnt(0)" ::: "memory")
#define VM_WAIT() asm volatile("s_waitcnt vmcnt(0)" ::: "memory")
__device__ __forceinline__ unsigned long long rt() { return __builtin_amdgcn_s_memrealtime(); }
typedef float pk_f32x2_t __attribute__((ext_vector_type(2))); typedef __bf16 pk_bf16x2_t __attribute__((ext_vector_type(2)));
__device__ __forceinline__ unsigned pk2(float lo, float hi) { const pk_f32x2_t v = {lo, hi}; return __builtin_bit_cast(unsigned, __builtin_convertvector(v, pk_bf16x2_t)); }
__device__ __forceinline__ unsigned f2bf(float f) { return pk2(f, 0.f) & 0xffffu; }

#define XB_TMO      128
#define XB_XCNT(j)  (256  + 64 * (j))
#define XB_XSUB(j)  (1280 + 64 * (j))
#define XB_XGEN(j)  (2304 + 64 * (j))
#define XB_TOP      3328
#define XB_TOPGEN   3392
#define XCD_BAR_WORDS 3456
#define XB_SPIN_CAP (1u << 18)

__device__ __forceinline__ unsigned xb_ld(unsigned* p)              { return __hip_atomic_load(p, __ATOMIC_RELAXED, __HIP_MEMORY_SCOPE_AGENT); }
__device__ __forceinline__ unsigned xb_add(unsigned* p, unsigned v) { return __hip_atomic_fetch_add(p, v, __ATOMIC_RELAXED, __HIP_MEMORY_SCOPE_AGENT); }
__device__ __forceinline__ unsigned xb_xcc_id() { return (unsigned)__builtin_amdgcn_s_getreg((3 << 11) | 20) & 0xFu; }
#define XB_SPIN(cond, bar) do { unsigned _sp = 0; while (cond) { __builtin_amdgcn_s_sleep(1); \
    if ((++_sp & 255u) == 0u) { if (xb_ld(&(bar)[XB_TMO])) break; if (_sp > XB_SPIN_CAP) { atomicAdd(&(bar)[XB_TMO], 1u); break; } } } } while (0)

struct XcdBarrier {
    unsigned* bar; unsigned x;
    volatile LAS unsigned* st;
};

__device__ __forceinline__ XcdBarrier xcd_barrier_post(unsigned* bar, volatile LAS unsigned* st) {
    XcdBarrier b; b.bar = bar; b.x = xb_xcc_id(); b.st = st;
    if (threadIdx.x == 0) (void)xb_add(&bar[XB_XCNT(b.x)], 1u);
    return b;
}
__device__ __forceinline__ void xcd_barrier_complete(unsigned* bar, unsigned x, unsigned& nloc, unsigned& nx) {
    const unsigned G = gridDim.x * gridDim.y * gridDim.z;
    unsigned sum, cnt, mine, sp = 0u;
    for (;;) {
        sum = 0u; cnt = 0u; mine = 0u;
#pragma unroll
        for (unsigned j = 0; j < 16; ++j) { const unsigned c = xb_ld(&bar[XB_XCNT(j)]); sum += c; cnt += (c > 0u) ? 1u : 0u; mine = (j == x) ? c : mine; }
        if (sum == G) break;
        __builtin_amdgcn_s_sleep(1);
        if ((++sp & 255u) == 0u) { if (xb_ld(&bar[XB_TMO])) break; if (sp > XB_SPIN_CAP) { atomicAdd(&bar[XB_TMO], 1u); break; } }
    }
    nloc = mine > 0u ? mine : 1u; nx = cnt > 0u ? cnt : 1u;
}

__device__ __forceinline__ void xcd_barrier(const XcdBarrier& b, const bool leader_thread) {
    asm volatile("s_waitcnt vmcnt(0)" ::: "memory");
    __syncthreads();
    if (leader_thread) {
        unsigned* bar = b.bar;
        __builtin_amdgcn_s_waitcnt(0);
        unsigned nloc = b.st[0], nx = b.st[1];
        if (nloc == 0u) { xcd_barrier_complete(bar, b.x, nloc, nx); b.st[0] = nloc; b.st[1] = nx; }
        const unsigned old = xb_add(&bar[XB_XSUB(b.x)], 1u);
        const unsigned gen = old / nloc;
        if (old + 1u == (gen + 1u) * nloc) {
            __builtin_amdgcn_fence(__ATOMIC_RELEASE, "agent");
            asm volatile("s_waitcnt vmcnt(0)" ::: "memory");
            const unsigned og = xb_add(&bar[XB_TOP], 1u);
            const unsigned tg = og / nx;
            if (og + 1u == (tg + 1u) * nx) xb_add(&bar[XB_TOPGEN], 1u);
            else XB_SPIN(xb_ld(&bar[XB_TOPGEN]) == tg, bar);
            __builtin_amdgcn_fence(__ATOMIC_ACQUIRE, "agent");
            xb_add(&bar[XB_XGEN(b.x)], 1u);
            asm volatile("s_waitcnt vmcnt(0)" ::: "memory");
        } else {
            XB_SPIN(xb_ld(&bar[XB_XGEN(b.x)]) == gen, bar);
            __builtin_amdgcn_fence(__ATOMIC_ACQUIRE, "agent");
            asm volatile("s_waitcnt vmcnt(0)" ::: "memory");
        }
    }
    __syncthreads();
}

constexpr int SEQ = 8192, DM = 4096, DIN = 13392, LDP = 14592, DFF = 16384, BW = 2048;
constexpr int C_QA = 0, C_KA = 1024, C_VA = 2048, C_RB = 3072, C_KB = 5120, C_VB = 7168, C_QC = 9216, C_KC = 10240, C_VC = 11264, C_QI = 12288, C_KI = 13312, C_WI = 13376;
constexpr int C_LWH = 13392, C_LWS = 13488, C_LAH = 13584, C_LAS = 13680, C_LGH = 13776, C_LGS = 14032, C_LVH = 14288, C_LVS = 14352;
constexpr float RMS_EPS = 1e-6f, GN_EPS = 64e-5f;
constexpr float QA_SCALE = 0.125f * 1.4426950408889634f;
constexpr float QC_SCALE = 0.08838834764831845f * 1.4426950408889634f;

enum { I_X = 0, I_NMG, I_WIN, I_LQ1, I_LK1, I_LQ2, I_LK2, I_SUBLN, I_MURKV, I_MUWAG, I_W0, I_W1, I_W2, I_A0, I_A1, I_A2, I_G1, I_G2, I_KK, I_KA, I_RK, I_LNW, I_LNB,
       I_VMU, I_V0, I_V1, I_V2, I_WOUT, I_NFG, I_WUP, I_WDN, I_NFIN, N_INPUTS };

constexpr size_t MiB = 1u << 20;
constexpr size_t WS_CTL = 0, CTL_ZERO_BYTES = 1 * MiB;
constexpr size_t SZ_WIN = (size_t)LDP * DM * 2, SZ_WOUT = (size_t)DM * DM * 2, SZ_WFF = (size_t)DFF * DM * 2, SZ_BT2 = (size_t)8192 * 256 * 2;
constexpr size_t WS_WIN = 2 * MiB;
constexpr size_t WS_WOUT = WS_WIN + SZ_WIN;
constexpr size_t WS_WUP = WS_WOUT + SZ_WOUT;
constexpr size_t WS_WDN = WS_WUP + SZ_WFF;
constexpr size_t WS_BT2 = WS_WDN + SZ_WFF;
constexpr size_t SZ_SB = (size_t)SEQ * BW * 4;
constexpr size_t WS_VF = WS_BT2 + SZ_BT2;
constexpr size_t WS_H = WS_VF + SZ_SB;
constexpr size_t WS_MIX = WS_H + (size_t)SEQ * DM * 2;
constexpr size_t WS_P = WS_MIX + (size_t)SEQ * DM * 2;
constexpr size_t WS_AP = WS_P + (size_t)SEQ * LDP * 2;
constexpr size_t WS_Z = WS_AP + (size_t)SEQ * 1024 * 2;
constexpr size_t WS_ZB = WS_Z + (size_t)SEQ * 2048 * 4;
constexpr size_t WS_U = WS_Z;
constexpr int SREC = 6 * 64 * 4;
constexpr size_t WS_XS = WS_Z + (size_t)SEQ * 8192 * 4;
constexpr size_t WS_BON = WS_XS + (size_t)32 * SEQ * SREC;
constexpr size_t WS_Y = WS_BON + (size_t)SEQ * 32 * 4;
constexpr size_t WS_O0 = WS_Y + SZ_SB, WS_O1 = WS_O0 + (size_t)SEQ * 1024 * 2;
constexpr size_t WS_SC = WS_O1 + (size_t)SEQ * 1024 * 2;
constexpr size_t WS_BM = WS_SC + (size_t)SEQ * SEQ * 4;
constexpr size_t WS_KF = WS_BM + (size_t)SEQ * 256 * 4;
constexpr size_t WS_VFR = WS_KF + (size_t)16 * MiB;
constexpr size_t WS_KIF = WS_VFR + (size_t)16 * MiB;
constexpr size_t WS_XR = WS_KIF + (size_t)1 * MiB;
constexpr size_t WS_END = WS_XR + (size_t)64 * MiB;
static_assert(WS_END <= 2040 * MiB && (size_t)SEQ * DFF * 2 <= (size_t)SEQ * 8192 * 4, "d_ws map must fit the 2 GiB workspace");
constexpr int CW_TMO = 0, CW_CODE = 1, CW_LAM = 16;
constexpr int CW_BAR = 4096;
constexpr int CW_RDY = 16384;
constexpr int CW_PREP = 32768;
constexpr int CW_SS = 65536;
constexpr int CW_AQ = 12288;
constexpr int CW_QUEUE = 8192;

constexpr int RING_OFF = 0, RING_BYTES = 131072;
constexpr int LDSCTL_OFF = RING_BYTES, MISC_OFF = LDSCTL_OFF + 320;
constexpr int LDS_BYTES = 147456;
constexpr int NWAVES = 8;

__device__ __forceinline__ float bf2f(unsigned short b) { return __uint_as_float(((unsigned)b) << 16); }
__device__ __forceinline__ float bflo(unsigned w) { return __uint_as_float(w << 16); }
__device__ __forceinline__ float bfhi(unsigned w) { return __uint_as_float(w & 0xffff0000u); }
#define DPPF(v, ctrl) __builtin_bit_cast(float, __builtin_amdgcn_update_dpp(0, __builtin_bit_cast(int, (v)), (ctrl), 0xF, 0xF, false))
#define DPPF_ROWS(old, v, ctrl, rows) __builtin_bit_cast(float, __builtin_amdgcn_update_dpp(__builtin_bit_cast(int, (old)), __builtin_bit_cast(int, (v)), (ctrl), (rows), 0xF, false))
__device__ __forceinline__ float dpp_sum16(float v) {
    v += DPPF(v, 0xB1);
    v += DPPF(v, 0x4E);
    v += DPPF(v, 0x141);
    v += DPPF(v, 0x140);
    return v;
}
__device__ __forceinline__ float dpp_max16(float v) {
    v = fmaxf(v, DPPF(v, 0xB1)); v = fmaxf(v, DPPF(v, 0x4E)); v = fmaxf(v, DPPF(v, 0x141)); v = fmaxf(v, DPPF(v, 0x140));
    return v;
}
__device__ __forceinline__ float wave_sum(float v) {
    v = dpp_sum16(v);
    v += DPPF_ROWS(0.f, v, 0x142, 0xA);
    v += DPPF_ROWS(0.f, v, 0x143, 0xC);
    return __builtin_bit_cast(float, __builtin_amdgcn_readlane(__builtin_bit_cast(int, v), 63));
}
__device__ __forceinline__ float wave_max(float v) {
    v = dpp_max16(v);
    v = fmaxf(v, DPPF_ROWS(v, v, 0x142, 0xA));
    v = fmaxf(v, DPPF_ROWS(v, v, 0x143, 0xC));
    return __builtin_bit_cast(float, __builtin_amdgcn_readlane(__builtin_bit_cast(int, v), 63));
}
__device__ __forceinline__ float swap32_sum(float v) {
    auto rr = __builtin_amdgcn_permlane32_swap(__float_as_uint(v), __float_as_uint(v), false, false);
    return __uint_as_float(rr[0]) + __uint_as_float(rr[1]);
}
__device__ __forceinline__ unsigned bperm_u32(unsigned v, int src_lane) { return (unsigned)__builtin_amdgcn_ds_bpermute(src_lane << 2, (int)v); }
__device__ __forceinline__ float sigmoidf_(float x) { return 1.0f / (1.0f + __expf(-x)); }

__device__ __forceinline__ void transpose_item(const float* W, int N, bf16* WT, int ldk, int row_off, const float* ks, int mode, LAS float* scr, int item, int lane, const float* ks2 = nullptr) {
    const int nblk = (N + 31) >> 5, kb = item / nblk, nb = item - kb * nblk, k0 = 64 * kb, n0 = 32 * nb;
    const int n_r = n0 + (lane & 31);
#pragma unroll
    for (int i = 0; i < 32; ++i) { const int kk = 2 * i + (lane >> 5); float v = 0.f;
        if (n_r < N) v = W[(size_t)(k0 + kk) * N + n_r];
        scr[kk * 33 + (lane & 31)] = v; }
    LDS_WAIT(); asm volatile("" ::: "memory");
    const int c = lane & 7;
    float f[8];
#pragma unroll
    for (int j = 0; j < 8; ++j) f[j] = 1.f;
    if (mode) { const f32x4 fa = *(const GAS f32x4*)(ks + k0 + 8 * c), fb = *(const GAS f32x4*)(ks + k0 + 8 * c + 4);
#pragma unroll
        for (int j = 0; j < 4; ++j) { f[j] = (mode == 1) ? (1.f - fa[j]) : fa[j]; f[4 + j] = (mode == 1) ? (1.f - fb[j]) : fb[j]; } }
    if (ks2) { const f32x4 ga = *(const GAS f32x4*)(ks2 + k0 + 8 * c), gb = *(const GAS f32x4*)(ks2 + k0 + 8 * c + 4);
#pragma unroll
        for (int j = 0; j < 4; ++j) { f[j] *= ga[j]; f[4 + j] *= gb[j]; } }
#pragma unroll
    for (int j = 0; j < 4; ++j) { const int n = (lane >> 3) + 8 * j; const LAS float* s = scr + (8 * c) * 33 + n;
        v4u o; o.x = pk2(s[0 * 33] * f[0], s[1 * 33] * f[1]); o.y = pk2(s[2 * 33] * f[2], s[3 * 33] * f[3]); o.z = pk2(s[4 * 33] * f[4], s[5 * 33] * f[5]); o.w = pk2(s[6 * 33] * f[6], s[7 * 33] * f[7]);
        if (n0 + n < N) *(GAS v4u*)(WT + (size_t)(row_off + n0 + n) * ldk + k0 + 8 * c) = o; }
    LDS_WAIT(); asm volatile("" ::: "memory");
}

template <int OFF> __device__ __forceinline__ unsigned long long karg64() {
    auto kp = __builtin_amdgcn_kernarg_segment_ptr(); unsigned long long v;
    asm volatile("s_load_dwordx2 %0, %1, %2\n\ts_waitcnt lgkmcnt(0)" : "=s"(v) : "s"(kp), "n"(OFF) : "memory");
    return v;
}
template <int IDX_> __device__ __forceinline__ const float* inp() { return (const float*)(const GAS float*)karg64<IDX_ * 8>(); }
#define ARG_OUT ((float*)(GAS float*)karg64<N_INPUTS * 8>())
#define ARG_WS ((unsigned char*)(GAS unsigned char*)karg64<N_INPUTS * 8 + 8>())
struct Ctx { int tid, lane, wave, G, bx, vcu, gw, NGW, l; unsigned char* ws; };
__device__ __forceinline__ Ctx ctx_make(int wave, int layer = 0) {
    Ctx c; int ln; asm volatile("v_mbcnt_lo_u32_b32 %0, -1, 0\n\tv_mbcnt_hi_u32_b32 %0, -1, %0" : "=v"(ln)); int g = gridDim.x, b = blockIdx.x; asm volatile("" : "+s"(g), "+s"(b), "+s"(wave));
    c.tid = wave * 64 + ln; c.lane = ln; c.wave = wave; c.G = g; c.bx = b;
    c.vcu = (g % 8 == 0) ? (b % 8) * (g / 8) + b / 8 : b; c.gw = c.vcu * NWAVES + c.wave; c.NGW = g * NWAVES; c.ws = ARG_WS; asm volatile("" : "+s"(layer)); c.l = layer; return c;
}

constexpr int IT_IN = (DM / 64) * ((DIN + 31) / 32), IT_L96 = (DM / 64) * 3, IT_L256 = (DM / 64) * 8, IT_L64 = (DM / 64) * 2;
constexpr int IT_OUT = (DM / 64) * (DM / 32), IT_UP = (DM / 64) * (DFF / 32), IT_DN = (DFF / 64) * (DM / 32);
constexpr int IT_PRO = IT_IN + 4 * IT_L96 + 2 * IT_L256 + 2 * IT_L64;
constexpr int IT_LATE = IT_OUT + IT_UP + IT_DN, CONV_PER_ITEM = 128, N_CONV_BIG = 448, CONV_PER_SMALL = 32, N_CONV_ITEMS = N_CONV_BIG + (IT_LATE - N_CONV_BIG * CONV_PER_ITEM) / CONV_PER_SMALL;
static_assert((IT_LATE - N_CONV_BIG * CONV_PER_ITEM) % CONV_PER_SMALL == 0 && IT_LATE > N_CONV_BIG * CONV_PER_ITEM, "conversion items");
__device__ __forceinline__ void conv_late_item(unsigned char* ws, const int l, int r, LAS float* scr, int lane) {
    if (r < IT_OUT) { transpose_item(inp<I_WOUT>() + (size_t)l * DM * DM, DM, (bf16*)(ws + WS_WOUT), DM, 0, nullptr, 0, scr, r, lane); return; } r -= IT_OUT;
    if (r < IT_UP) { transpose_item(inp<I_WUP>() + (size_t)l * DM * DFF, DFF, (bf16*)(ws + WS_WUP), DM, 0, inp<I_NFG>() + (size_t)l * DM, 2, scr, r, lane); return; } r -= IT_UP;
    transpose_item(inp<I_WDN>() + (size_t)l * DFF * DM, DM, (bf16*)(ws + WS_WDN), DFF, 0, nullptr, 0, scr, r, lane);
}
__device__ __forceinline__ void layer_prologue(unsigned char* ws, gu32* ctl, LAS unsigned char* lds, const int l, int gw, int NGW, int wave, int lane) {
    LAS float* scr = (LAS float*)(lds + RING_OFF + wave * 16384);
    for (int it = gw; it < IT_PRO; it += NGW) {
        int r = it;
        bf16* Wi = (bf16*)(ws + WS_WIN);
        const float* mu = inp<I_MUWAG>() + (size_t)l * 3 * DM;
        const float* g1 = inp<I_NMG>() + (size_t)l * DM;
        if (r < IT_IN) { transpose_item(inp<I_WIN>() + (size_t)l * DM * DIN, DIN, Wi, DM, 0, nullptr, 0, scr, r, lane, g1); continue; } r -= IT_IN;
        if (r < IT_L96) { transpose_item(inp<I_W1>() + (size_t)l * DM * 96, 96, Wi, DM, C_LWH, mu, 1, scr, r, lane, g1); continue; } r -= IT_L96;
        if (r < IT_L96) { transpose_item(inp<I_W1>() + (size_t)l * DM * 96, 96, Wi, DM, C_LWS, mu, 2, scr, r, lane, g1); continue; } r -= IT_L96;
        if (r < IT_L96) { transpose_item(inp<I_A1>() + (size_t)l * DM * 96, 96, Wi, DM, C_LAH, mu + DM, 1, scr, r, lane, g1); continue; } r -= IT_L96;
        if (r < IT_L96) { transpose_item(inp<I_A1>() + (size_t)l * DM * 96, 96, Wi, DM, C_LAS, mu + DM, 2, scr, r, lane, g1); continue; } r -= IT_L96;
        if (r < IT_L256) { transpose_item(inp<I_G1>() + (size_t)l * DM * 256, 256, Wi, DM, C_LGH, mu + 2 * DM, 1, scr, r, lane, g1); continue; } r -= IT_L256;
        if (r < IT_L256) { transpose_item(inp<I_G1>() + (size_t)l * DM * 256, 256, Wi, DM, C_LGS, mu + 2 * DM, 2, scr, r, lane, g1); continue; } r -= IT_L256;
        if (r < IT_L64) { if (l == 1) transpose_item(inp<I_V1>(), 64, Wi, DM, C_LVH, inp<I_VMU>(), 1, scr, r, lane, g1); continue; } r -= IT_L64;
        if (l == 1) transpose_item(inp<I_V1>(), 64, Wi, DM, C_LVS, inp<I_VMU>(), 2, scr, r, lane, g1);
    }
    for (int i = gw * 64 + lane; i < 8192 * 32; i += NGW * 64) {
        const int n = i >> 5, k8 = i & 31, grp = n >> 11, c = n & 2047;
        const float* src; int rank;
        if (grp == 0) { src = inp<I_W2>() + (size_t)l * 96 * BW; rank = 96; }
        else if (grp == 1) { src = inp<I_A2>() + (size_t)l * 96 * BW; rank = 96; }
        else if (grp == 2) { src = inp<I_G2>() + (size_t)l * 256 * BW; rank = 256; }
        else { src = inp<I_V2>(); rank = (l == 1) ? 64 : 0; }
        float v[8];
#pragma unroll
        for (int e = 0; e < 8; ++e) { const int k = 8 * k8 + e; v[e] = (k < rank) ? src[(size_t)k * BW + c] : 0.f; }
        v4u o; o.x = pk2(v[0], v[1]); o.y = pk2(v[2], v[3]); o.z = pk2(v[4], v[5]); o.w = pk2(v[6], v[7]);
        *(GAS v4u*)((bf16*)(ws + WS_BT2) + (size_t)n * 256 + 8 * k8) = o;
    }
    if (gw == 0) {
        const float a = wave_sum(inp<I_LQ1>()[l * 64 + lane] * inp<I_LK1>()[l * 64 + lane]), b = wave_sum(inp<I_LQ2>()[l * 64 + lane] * inp<I_LK2>()[l * 64 + lane]);
        const float lam_init = 0.8f - 0.6f * expf(-0.3f * (float)l);
        if (lane == 0) __hip_atomic_store(ctl + CW_LAM + l, __float_as_uint(expf(a) - expf(b) + lam_init), RLX_AGENT); }
}

__device__ __forceinline__ void rmsnorm_rows_bf16(const float* src, const float* g, bf16* dst, int gw, int NGW, int lane) {
    for (int m = gw; m < SEQ; m += NGW) {
        const GAS f32x4* xr = (const GAS f32x4*)(src + (size_t)m * DM) + lane; const GAS f32x4* gr = (const GAS f32x4*)g + lane;
        f32x4 v[16]; float s = 0.f;
#pragma unroll
        for (int j = 0; j < 16; ++j) { v[j] = xr[64 * j]; s += (v[j].x * v[j].x + v[j].y * v[j].y) + (v[j].z * v[j].z + v[j].w * v[j].w); }
        const float rstd = 1.0f / sqrtf(wave_sum(s) * (1.f / DM) + RMS_EPS);
        GAS unsigned long long* o8 = (GAS unsigned long long*)(dst + (size_t)m * DM) + lane;
#pragma unroll
        for (int j = 0; j < 16; ++j) { const f32x4 gv = gr[64 * j];
            o8[64 * j] = (unsigned long long)pk2(v[j].x * rstd * gv.x, v[j].y * rstd * gv.y) | ((unsigned long long)pk2(v[j].z * rstd * gv.z, v[j].w * rstd * gv.w) << 32); }
    }
}
__device__ __forceinline__ void x_to_stream_rows(const float* src, bf16* dst, unsigned long long* SS, int gw, int NGW, int lane) {
    for (int m = gw; m < SEQ; m += NGW) {
        const GAS f32x4* xr = (const GAS f32x4*)(src + (size_t)m * DM) + lane;
        f32x4 v[16]; float s = 0.f;
#pragma unroll
        for (int j = 0; j < 16; ++j) { v[j] = xr[64 * j]; s += (v[j].x * v[j].x + v[j].y * v[j].y) + (v[j].z * v[j].z + v[j].w * v[j].w); }
        const float tot = wave_sum(s);
        GAS unsigned long long* o8 = (GAS unsigned long long*)(dst + (size_t)m * DM) + lane;
#pragma unroll
        for (int j = 0; j < 16; ++j) o8[64 * j] = (unsigned long long)pk2(v[j].x, v[j].y) | ((unsigned long long)pk2(v[j].z, v[j].w) << 32);
        if (lane == 0) SS[m] = (unsigned long long)(tot * 16777216.f);
    }
}
template <bool OUT_F32> __device__ __forceinline__ void rmsnorm_rows_from_bf16(const bf16* src, const float* g, void* dst, int gw, int NGW, int lane) {
    for (int m = gw; m < SEQ; m += NGW) {
        const GAS v4u* xr = (const GAS v4u*)(src + (size_t)m * DM) + lane;
        float v[8][8]; float s = 0.f;
#pragma unroll
        for (int j = 0; j < 8; ++j) { const v4u w = xr[64 * j];
            v[j][0] = bflo(w.x); v[j][1] = bfhi(w.x); v[j][2] = bflo(w.y); v[j][3] = bfhi(w.y); v[j][4] = bflo(w.z); v[j][5] = bfhi(w.z); v[j][6] = bflo(w.w); v[j][7] = bfhi(w.w);
#pragma unroll
            for (int i = 0; i < 8; ++i) s += v[j][i] * v[j][i]; }
        const float rstd = 1.0f / sqrtf(wave_sum(s) * (1.f / DM) + RMS_EPS);
#pragma unroll
        for (int j = 0; j < 8; ++j) { const int e0 = (64 * j + lane) * 8;
            const f32x4 ga = *(const GAS f32x4*)(g + e0), gb = *(const GAS f32x4*)(g + e0 + 4);
            if (OUT_F32) { float* o = (float*)dst + (size_t)m * DM + e0;
                *(GAS f32x4*)o = (f32x4){v[j][0] * rstd * ga.x, v[j][1] * rstd * ga.y, v[j][2] * rstd * ga.z, v[j][3] * rstd * ga.w};
                *(GAS f32x4*)(o + 4) = (f32x4){v[j][4] * rstd * gb.x, v[j][5] * rstd * gb.y, v[j][6] * rstd * gb.z, v[j][7] * rstd * gb.w}; }
            else { v4u w; w.x = pk2(v[j][0] * rstd * ga.x, v[j][1] * rstd * ga.y); w.y = pk2(v[j][2] * rstd * ga.z, v[j][3] * rstd * ga.w); w.z = pk2(v[j][4] * rstd * gb.x, v[j][5] * rstd * gb.y); w.w = pk2(v[j][6] * rstd * gb.z, v[j][7] * rstd * gb.w);
                *(GAS v4u*)((bf16*)dst + (size_t)m * DM + e0) = w; } }
    }
}
__device__ __forceinline__ void rmsnorm_rows_f32_inplace(float* x, const float* g, int gw, int NGW, int lane) {
    for (int m = gw; m < SEQ; m += NGW) {
        GAS f32x4* xr = (GAS f32x4*)(x + (size_t)m * DM) + lane; const GAS f32x4* gr = (const GAS f32x4*)g + lane;
        f32x4 v[16]; float s = 0.f;
#pragma unroll
        for (int j = 0; j < 16; ++j) { v[j] = xr[64 * j]; s += (v[j].x * v[j].x + v[j].y * v[j].y) + (v[j].z * v[j].z + v[j].w * v[j].w); }
        const float rstd = 1.0f / sqrtf(wave_sum(s) * (1.f / DM) + RMS_EPS);
#pragma unroll
        for (int j = 0; j < 16; ++j) { const f32x4 gv = gr[64 * j]; xr[64 * j] = v[j] * rstd * gv; }
    }
}

__device__ __forceinline__ void lora_prep(const bf16* P, bf16* AP, const float* PART, const unsigned long long* SS, int layer, int gw, int NGW, int lane) {
    for (int t = gw; t < SEQ; t += NGW) {
        const bf16* cur = P + (size_t)t * LDP; const bf16* prv = cur - LDP;
#pragma unroll
        for (int k = 0; k < 16; ++k) { const int grp = k >> 2, i = lane + 64 * (k & 3);
            const int rank = (grp == 2) ? 256 : (grp == 3 ? ((layer == 1) ? 64 : 0) : 96);
            const int ch = (grp == 0) ? C_LWH : (grp == 1) ? C_LAH : (grp == 2) ? C_LGH : C_LVH, cs = (grp == 0) ? C_LWS : (grp == 1) ? C_LAS : (grp == 2) ? C_LGS : C_LVS;
            float v = 0.f;
            if (grp == 3) {
                if (i < rank) {
                    const float* pc = PART + (size_t)t * 2048 + (C_LVH + i - 14336); const float* pp = PART + (size_t)(t > 0 ? t - 1 : 0) * 2048 + (C_LVS + i - 14336);
                    float sc = 0.f, sp = 0.f;
#pragma unroll
                    for (int s = 0; s < 8; ++s) { sp += pp[s * 256]; if (C_LVH + i >= 14336) sc += pc[s * 256]; }
                    if (C_LVH + i < 14336) sc = bf2f(cur[C_LVH + i]);
                    const float rc = 1.0f / sqrtf((float)SS[t] * (1.f / DM / 16777216.f) + RMS_EPS), rp = 1.0f / sqrtf((float)SS[t > 0 ? t - 1 : 0] * (1.f / DM / 16777216.f) + RMS_EPS);
                    if (C_LVH + i >= 14336) sc *= rc;
                    v = sc + ((t > 0) ? sp * rp : 0.f); }
            } else if (i < rank) { v = bf2f(cur[ch + i]); if (t > 0) v += bf2f(prv[cs + i]);
                if (grp == 0) v = tanhf(v); else if (grp == 2) v = sigmoidf_(v); }
            AP[(size_t)t * 1024 + grp * 256 + i] = (bf16)f2bf(v); }
    }
}

__device__ __forceinline__ void rwkv_prep(unsigned char* ws, int layer, int gw, int NGW, int lane) {
    const bf16* P = (const bf16*)(ws + WS_P); const float* ZW = (const float*)(ws + WS_Z); const bf16* ZB = (const bf16*)(ws + WS_ZB);
    unsigned char* XS = ws + WS_XS; float* BON = (float*)(ws + WS_BON);
    float* VF = (float*)(ws + WS_VF);
    const int head = gw & 31, c = head * 64 + lane, nch = NGW >> 5, ch = gw >> 5;
    if (nch == 0 || ch >= nch) return;
    const int tper = (SEQ + nch - 1) / nch, tb = ch * tper, te = (tb + tper < SEQ) ? tb + tper : SEQ;
    const float* mu = inp<I_MURKV>() + (size_t)layer * 3 * BW;
    const float mu_r = mu[c], mu_k = mu[BW + c], mu_v = mu[2 * BW + c];
    const float w0 = inp<I_W0>()[layer * BW + c], a0 = inp<I_A0>()[layer * BW + c], kkw = inp<I_KK>()[layer * BW + c], kaw = inp<I_KA>()[layer * BW + c], rkw = inp<I_RK>()[layer * BW + c];
    const float v0 = (layer == 1) ? inp<I_V0>()[c] : 0.f;
    float rp = 0.f, kp = 0.f, vp = 0.f;
    if (tb > 0 && tb < SEQ) { const bf16* prv = P + (size_t)(tb - 1) * LDP; rp = bf2f(prv[C_RB + c]); kp = bf2f(prv[C_KB + c]); vp = bf2f(prv[C_VB + c]); }
#pragma unroll 4
    for (int t = tb; t < te; ++t) {
        const bf16* cur = P + (size_t)t * LDP;
        const float r0 = bf2f(cur[C_RB + c]), k0 = bf2f(cur[C_KB + c]), v0r = bf2f(cur[C_VB + c]);
        const bf16* zb = ZB + (size_t)t * 6144;
        const float zw = ZW[(size_t)t * 2048 + c], za = bf2f(zb[c]);
        float zv = 0.f, vf = 0.f; if (layer == 1) { zv = bf2f(zb[2 * BW + c]); vf = VF[(size_t)t * BW + c]; }
        const float r = r0 + (rp - r0) * mu_r, k = k0 + (kp - k0) * mu_k; float v = v0r + (vp - v0r) * mu_v;
        rp = r0; kp = k0; vp = v0r;
        const float decay = __expf(-0.6065306597126334f * sigmoidf_(w0 + zw));
        const float a = sigmoidf_(a0 + za);
        if (layer == 0) VF[(size_t)t * BW + c] = v; else v += (vf - v) * sigmoidf_(v0 + zv);
        float kk = k * kkw;
        const float nrm = sqrtf(wave_sum(kk * kk));
        kk = kk / fmaxf(nrm, 1e-12f);
        const float kn = k * (1.0f + (a - 1.0f) * kaw);
        float* rec = (float*)(XS + ((size_t)head * SEQ + t) * SREC) + lane;
        rec[0] = decay; rec[64] = r; rec[128] = kn; rec[192] = -kk; rec[256] = kk * a; rec[320] = v;
        const float bon = wave_sum(r * kn * rkw);
        if (lane == 0) BON[t * 32 + head] = bon;
    }
}

typedef unsigned short us4 __attribute__((ext_vector_type(4)));
__device__ __forceinline__ void st16_sc1(void* p, const f32x4 v) { asm volatile("global_store_dwordx4 %0, %1, off sc1\n\ts_nop 1" :: "v"((GAS void*)p), "v"(v) : "memory"); }
__device__ __forceinline__ void rwkv_prep_item(unsigned char* ws, int layer, int pi, int wave, int lane) {
    const bf16* P = (const bf16*)(ws + WS_P); const float* ZW = (const float*)(ws + WS_Z); const bf16* ZB = (const bf16*)(ws + WS_ZB);
    unsigned char* XS = ws + WS_XS; float* BON = (float*)(ws + WS_BON); float* VF = (float*)(ws + WS_VF);
    const int head = (pi & 3) * 8 + wave, tb = (pi >> 2) * 32, kq = lane & 15, c4 = head * 64 + 4 * kq;
    const float* mu = inp<I_MURKV>() + (size_t)layer * 3 * BW;
    const f32x4 mu_r = *(const GAS f32x4*)(mu + c4), mu_k = *(const GAS f32x4*)(mu + BW + c4), mu_v = *(const GAS f32x4*)(mu + 2 * BW + c4);
    const f32x4 w0 = *(const GAS f32x4*)(inp<I_W0>() + layer * BW + c4), a0 = *(const GAS f32x4*)(inp<I_A0>() + layer * BW + c4), kkw = *(const GAS f32x4*)(inp<I_KK>() + layer * BW + c4),
                kaw = *(const GAS f32x4*)(inp<I_KA>() + layer * BW + c4), rkw = *(const GAS f32x4*)(inp<I_RK>() + layer * BW + c4);
    f32x4 v0 = (f32x4){0.f, 0.f, 0.f, 0.f}; if (layer == 1) v0 = *(const GAS f32x4*)(inp<I_V0>() + c4);
#pragma unroll 2
    for (int p = 0; p < 8; ++p) {
        const int t = tb + 4 * p + (lane >> 4);
        const bf16* cur = P + (size_t)t * LDP + c4; const bf16* prv = cur - (t > 0 ? LDP : 0);
        const us4 r0b = *(const GAS us4*)(cur + C_RB), k0b = *(const GAS us4*)(cur + C_KB), v0b = *(const GAS us4*)(cur + C_VB);
        const us4 rpb = *(const GAS us4*)(prv + C_RB), kpb = *(const GAS us4*)(prv + C_KB), vpb = *(const GAS us4*)(prv + C_VB);
        const bf16* zb = ZB + (size_t)t * 6144 + c4;
        const f32x4 zw = *(const GAS f32x4*)(ZW + (size_t)t * 2048 + c4); const us4 zab = *(const GAS us4*)zb;
        us4 zvb = (us4){0, 0, 0, 0}; f32x4 vf = (f32x4){0.f, 0.f, 0.f, 0.f};
        if (layer == 1) { zvb = *(const GAS us4*)(zb + 2 * BW); vf = *(const GAS f32x4*)(VF + (size_t)t * BW + c4); }
        const float pm = (t > 0) ? 1.f : 0.f;
        f32x4 dec, r, kn, kk, kb, v; float n2 = 0.f, bon = 0.f;
#pragma unroll
        for (int j = 0; j < 4; ++j) {
            const float r0 = bf2f(r0b[j]), k0 = bf2f(k0b[j]), v0r = bf2f(v0b[j]);
            const float rp = pm * bf2f(rpb[j]), kp = pm * bf2f(kpb[j]), vp = pm * bf2f(vpb[j]);
            const float rr = r0 + (rp - r0) * mu_r[j], k = k0 + (kp - k0) * mu_k[j]; float vv = v0r + (vp - v0r) * mu_v[j];
            dec[j] = __expf(-0.6065306597126334f * sigmoidf_(w0[j] + zw[j]));
            const float a = sigmoidf_(a0[j] + bf2f(zab[j]));
            if (layer == 1) vv += (vf[j] - vv) * sigmoidf_(v0[j] + bf2f(zvb[j]));
            const float q = k * kkw[j];
            n2 += q * q;
            kk[j] = q; kb[j] = a;
            kn[j] = k * (1.0f + (a - 1.0f) * kaw[j]);
            bon += rr * kn[j] * rkw[j];
            r[j] = rr; v[j] = vv;
        }
        n2 = dpp_sum16(n2); bon = dpp_sum16(bon);
        const float inv = 1.0f / fmaxf(sqrtf(n2), 1e-12f);
        f32x4 nk;
#pragma unroll
        for (int j = 0; j < 4; ++j) { const float q = kk[j] * inv; nk[j] = -q; kb[j] = q * kb[j]; }
        if (layer == 0) *(GAS f32x4*)(VF + (size_t)t * BW + c4) = v;
        unsigned char* rec = XS + ((size_t)head * SEQ + t) * SREC + kq * 16;
        st16_sc1(rec, dec); st16_sc1(rec + 256, r); st16_sc1(rec + 512, kn); st16_sc1(rec + 768, nk); st16_sc1(rec + 1024, kb); st16_sc1(rec + 1280, v);
        if (kq == 0) BON[t * 32 + head] = bon;
    }
}

constexpr int SCH = 32, SCHB = SCH * SREC;
typedef float f32x2 __attribute__((ext_vector_type(2)));
struct ScanIn { f32x4 w, r, k, a, b; f32x2 v; };
__device__ __forceinline__ f32x2 lo2(const f32x4& x) { return (f32x2){x.x, x.y}; }
__device__ __forceinline__ f32x2 hi2(const f32x4& x) { return (f32x2){x.z, x.w}; }
__device__ __forceinline__ void scan_unit(unsigned char* ws, int layer, int unit, int wave, int lane, LAS unsigned char* lds) {
    const int head = unit >> 1, half = unit & 1, row = half * 32 + (wave & 3) * 8 + (lane >> 4) * 2, kq = lane & 15;
    const unsigned char* src = ws + WS_XS + (size_t)head * SEQ * SREC + (size_t)wave * 6144 + lane * 16;
    float* py = (float*)(ws + WS_Y) + head * 64 + row;
    f32x2 S0 = (f32x2){0.f, 0.f}, S1 = (f32x2){0.f, 0.f}, T0 = (f32x2){0.f, 0.f}, T1 = (f32x2){0.f, 0.f};
    const unsigned rdo = (unsigned)kq * 16u, rdv = 1280u + (unsigned)row * 4u;
    const bool ev0 = (lane & 1) == 0, ev1 = (lane & 2) == 0;
#define SCAN_DMA(c, buf) do { _Pragma("unroll") for (int p_ = 0; p_ < 6; ++p_) \
        __builtin_amdgcn_global_load_lds((const unsigned*)(src + (size_t)(c) * SCHB + p_ * 1024), (LAS unsigned*)(lds + (buf) * SCHB + wave * 6144 + p_ * 1024), 16, 0, 16); } while (0)
#define SCAN_LOAD(X, base) do { _Pragma("unroll") for (int i_ = 0; i_ < 4; ++i_) { const LAS unsigned char* q_ = (base) + i_ * SREC; \
        X[i_].w = *(const LAS f32x4*)(q_ + rdo); X[i_].r = *(const LAS f32x4*)(q_ + rdo + 256); X[i_].k = *(const LAS f32x4*)(q_ + rdo + 512); X[i_].a = *(const LAS f32x4*)(q_ + rdo + 768); X[i_].b = *(const LAS f32x4*)(q_ + rdo + 1024); \
        X[i_].v = *(const LAS f32x2*)(q_ + rdv); } } while (0)
#define SCAN_STEP(X, ANEXT, ROUT) do { \
          \
        const float p1_ = ev0 ? sap : sbp, q1_ = ev0 ? sbp : sap, p2_ = ev0 ? ypp : zpp, q2_ = ev0 ? zpp : ypp; \
        const float r1_ = p1_ + DPPF(q1_, 0xB1), r2_ = p2_ + DPPF(q2_, 0xB1); \
        const float p3_ = ev1 ? r1_ : r2_, q3_ = ev1 ? r2_ : r1_; \
        float rr_ = p3_ + DPPF(q3_, 0x4E); \
        rr_ += DPPF(rr_, 0x124); rr_ += DPPF(rr_, 0x128);                   \
        const float sa_ = __builtin_bit_cast(float, __builtin_amdgcn_mov_dpp(__builtin_bit_cast(int, rr_), 0x00, 0xF, 0xF, false)), sb_ = __builtin_bit_cast(float, __builtin_amdgcn_mov_dpp(__builtin_bit_cast(int, rr_), 0x55, 0xF, 0xF, false));     \
        ROUT = rr_;                                                          \
        { const f32x2 kv0 = lo2(X.k) * X.v.x, kv1 = hi2(X.k) * X.v.x; \
          const f32x2 t0_ = __builtin_elementwise_fma(lo2(X.b), (f32x2){sa_, sa_}, kv0), t1_ = __builtin_elementwise_fma(hi2(X.b), (f32x2){sa_, sa_}, kv1); \
          S0 = __builtin_elementwise_fma(S0, lo2(X.w), t0_); S1 = __builtin_elementwise_fma(S1, hi2(X.w), t1_); } \
        { const f32x2 kv0 = lo2(X.k) * X.v.y, kv1 = hi2(X.k) * X.v.y; \
          const f32x2 t0_ = __builtin_elementwise_fma(lo2(X.b), (f32x2){sb_, sb_}, kv0), t1_ = __builtin_elementwise_fma(hi2(X.b), (f32x2){sb_, sb_}, kv1); \
          T0 = __builtin_elementwise_fma(T0, lo2(X.w), t0_); T1 = __builtin_elementwise_fma(T1, hi2(X.w), t1_); } \
        { const f32x2 u_ = __builtin_elementwise_fma(S1, hi2(ANEXT), S0 * lo2(ANEXT)); sap = u_.x + u_.y; } \
        { const f32x2 u_ = __builtin_elementwise_fma(T1, hi2(ANEXT), T0 * lo2(ANEXT)); sbp = u_.x + u_.y; } \
        { const f32x2 u_ = __builtin_elementwise_fma(S1, hi2(X.r), S0 * lo2(X.r)); ypp = u_.x + u_.y; } \
        { const f32x2 u_ = __builtin_elementwise_fma(T1, hi2(X.r), T0 * lo2(X.r)); zpp = u_.x + u_.y; } } while (0)
#define SCAN_STEPS(X, AN4, t0) do { float r0_, r1x_, r2x_, r3_; \
        SCAN_STEP(X[0], X[1].a, r0_); SCAN_STEP(X[1], X[2].a, r1x_); SCAN_STEP(X[2], X[3].a, r2x_); SCAN_STEP(X[3], AN4, r3_); \
        const int qd_ = kq >> 2; const float ys_ = (qd_ == 0) ? r0_ : (qd_ == 1) ? r1x_ : (qd_ == 2) ? r2x_ : r3_; const int ts_ = (t0) - 1 + qd_; \
        if ((kq & 2) && ts_ >= 0) py[(size_t)ts_ * BW + (kq & 1)] = ys_; } while (0)
    const gu32* flg = (const gu32*)(ws + WS_CTL) + CW_PREP + 1024 * layer + (head >> 3);
#define SCAN_FRAW(c) __hip_atomic_load(flg + 4 * (c), RLX_AGENT)
#define SCAN_FLAG(c) ((unsigned)__builtin_amdgcn_readfirstlane((int)SCAN_FRAW(c)))
#define SCAN_WAIT(c, f) do { unsigned f_ = (f), sp_ = 0u; while (f_ == 0u) { __builtin_amdgcn_s_sleep(1); f_ = SCAN_FLAG(c); if (++sp_ > (1u << 24)) break; } } while (0)
    SCAN_WAIT(0, 0u);
    SCAN_DMA(0, 0);
    unsigned fnext = SCAN_FRAW(1);
    __syncthreads();
    float sap = 0.f, ypp = 0.f, sbp = 0.f, zpp = 0.f;
    for (int c = 0; c < SEQ / SCH; ++c) {
        const int cur = c & 1;
        if (c + 1 < SEQ / SCH) { SCAN_WAIT(c + 1, (unsigned)__builtin_amdgcn_readfirstlane((int)fnext)); SCAN_DMA(c + 1, cur ^ 1); fnext = SCAN_FRAW(c + 2 < SEQ / SCH ? c + 2 : c + 1); }
        if (wave < 4) {
            const LAS unsigned char* cb = lds + cur * SCHB;
            ScanIn A[4], B[4];
            SCAN_LOAD(A, cb);
#pragma unroll
            for (int s = 0; s < SCH; s += 8) {
                SCAN_LOAD(B, cb + (s + 4) * SREC);
                SCAN_STEPS(A, B[0].a, c * SCH + s);
                if (s + 8 < SCH) { SCAN_LOAD(A, cb + (s + 8) * SREC); SCAN_STEPS(B, A[0].a, c * SCH + s + 4); }
                else { SCAN_STEPS(B, B[3].a, c * SCH + s + 4); }
            }
        }
        if (wave < 4) { asm volatile("s_waitcnt vmcnt(9) lgkmcnt(0)" ::: "memory"); __builtin_amdgcn_s_barrier(); asm volatile("" ::: "memory"); }
        else __syncthreads();
        if (c + 1 < SEQ / SCH && wave < 4) {
            const f32x4 an = *(const LAS f32x4*)(lds + (cur ^ 1) * SCHB + rdo + 768);
            { const f32x2 u_ = __builtin_elementwise_fma(S1, hi2(an), S0 * lo2(an)); sap = u_.x + u_.y; }
            { const f32x2 u_ = __builtin_elementwise_fma(T1, hi2(an), T0 * lo2(an)); sbp = u_.x + u_.y; }
        }
    }
    if (wave < 4) {
        float yp_ = ypp, zp_ = zpp;
        yp_ += DPPF(yp_, 0xB1); zp_ += DPPF(zp_, 0xB1); yp_ += DPPF(yp_, 0x4E); zp_ += DPPF(zp_, 0x4E); yp_ += DPPF(yp_, 0x141); zp_ += DPPF(zp_, 0x141); yp_ += DPPF(yp_, 0x140); zp_ += DPPF(zp_, 0x140);
        if (kq == 0) { f32x2 o; o.x = yp_; o.y = zp_; *(GAS f32x2*)(py + (size_t)(SEQ - 1) * BW) = o; }
    }
#undef SCAN_DMA
#undef SCAN_FLAG
#undef SCAN_FRAW
#undef SCAN_WAIT
#undef SCAN_LOAD
#undef SCAN_STEP
#undef SCAN_STEPS
}

__device__ __forceinline__ float relu0(float x) { return __builtin_amdgcn_fmed3f(x, 0.f, __builtin_inff()); }
__device__ __forceinline__ void idx_scores_quad(const bf16* P, const bf16* KIF, float* Sc, int t0, int lane) {
    typedef float f32x16 __attribute__((ext_vector_type(16)));
    const int r = lane & 31, hh = lane >> 5;
    bf16x8 af[2][4]; float wq[2][16];
#pragma unroll
    for (int a = 0; a < 2; ++a) {
        const bf16* qrow = P + (size_t)(t0 + 2 * a + (r >> 4)) * LDP + C_QI + (r & 15) * 64 + hh * 8;
#pragma unroll
        for (int ks = 0; ks < 4; ++ks) af[a][ks] = *(const GAS bf16x8*)(qrow + ks * 16);
#pragma unroll
        for (int i = 0; i < 16; ++i) { const int head = (i & 3) + 8 * ((i >> 2) & 1) + 4 * hh; wq[a][i] = bf2f(P[(size_t)(t0 + 2 * a + (i >> 3)) * LDP + C_WI + head]); }
    }
    const int nkt = (t0 + 3) / 32 + 1;
    const bf16* kp = KIF + (size_t)lane * 8;
    float* sp0 = Sc + (size_t)(t0 + hh) * SEQ + r; float* sp1 = Sc + (size_t)(t0 + 2 + hh) * SEQ + r;
#define IDX_LOAD(X, kt_) do { const bf16* k_ = kp + (size_t)((kt_) < nkt ? (kt_) : nkt - 1) * 2048; _Pragma("unroll") for (int ks = 0; ks < 4; ++ks) X[ks] = *(const GAS bf16x8*)(k_ + ks * 512); } while (0)
#define IDX_TILE(X, kt_) do { _Pragma("unroll") for (int a = 0; a < 2; ++a) { f32x16 acc; \
            _Pragma("unroll") for (int i = 0; i < 16; ++i) acc[i] = 0.f; \
            _Pragma("unroll") for (int ks = 0; ks < 4; ++ks) acc = __builtin_amdgcn_mfma_f32_32x32x16_bf16(af[a][ks], X[ks], acc, 0, 0, 0); \
            float s0 = 0.f, s1 = 0.f; \
            _Pragma("unroll") for (int i = 0; i < 8; ++i) { s0 += wq[a][i] * relu0(acc[i]); s1 += wq[a][8 + i] * relu0(acc[8 + i]); } \
            s0 = swap32_sum(s0); s1 = swap32_sum(s1); \
            (a ? sp1 : sp0)[(kt_) * 32] = hh ? s1 : s0; } } while (0)
    bf16x8 fa[4], fb[4];
    IDX_LOAD(fa, 0);
#pragma unroll 1
    for (int kt = 0; kt < nkt; kt += 2) {
        IDX_LOAD(fb, kt + 1);
        IDX_TILE(fa, kt);
        if (kt + 1 < nkt) { IDX_LOAD(fa, kt + 2); IDX_TILE(fb, kt + 1); }
    }
#undef IDX_LOAD
#undef IDX_TILE
}

__device__ __forceinline__ unsigned f2key(float f) { const unsigned u = __float_as_uint(f); return (u & 0x80000000u) ? ~u : (u | 0x80000000u); }
__device__ __forceinline__ void topk_row(const float* sc, int L, unsigned* out, LAS unsigned* hist, int lane) {
    unsigned prefix = 0u, himask = 0u; int kneed = 256;
    for (int pass = 0; pass < 4; ++pass) {
        const int shift = 24 - 8 * pass;
#pragma unroll
        for (int b = 0; b < 4; ++b) hist[lane + 64 * b] = 0u;
        LDS_WAIT(); asm volatile("" ::: "memory");
        for (int i0 = lane; i0 < L; i0 += 1024) { float v[16];
#pragma unroll
            for (int j = 0; j < 16; ++j) v[j] = (i0 + 64 * j < L) ? sc[i0 + 64 * j] : 0.f;
#pragma unroll
            for (int j = 0; j < 16; ++j) { const unsigned u = f2key(v[j]); if (i0 + 64 * j < L && (u & himask) == prefix) __hip_atomic_fetch_add(&hist[(u >> shift) & 255u], 1u, __ATOMIC_RELAXED, __HIP_MEMORY_SCOPE_WORKGROUP); } }
        LDS_WAIT(); asm volatile("" ::: "memory");
        unsigned c[4];
#pragma unroll
        for (int j = 0; j < 4; ++j) c[j] = hist[4 * lane + j];
        const unsigned tot = (c[0] + c[1]) + (c[2] + c[3]);
        unsigned inc = tot;
#pragma unroll
        for (int o = 1; o < 64; o <<= 1) { const unsigned v = bperm_u32(inc, (lane + o) & 63); if (lane + o < 64) inc += v; }
        unsigned cum = inc - tot; bool found = false; unsigned d = 0u, gt = 0u;
#pragma unroll
        for (int j = 3; j >= 0; --j) { if (!found && cum < (unsigned)kneed && (unsigned)kneed <= cum + c[j]) { found = true; d = 4u * lane + j; gt = cum; } cum += c[j]; }
        const unsigned long long m = __ballot(found);
        const int src = m ? (int)__builtin_ctzll(m) : 0;
        d = (unsigned)__builtin_amdgcn_readlane((int)d, src); gt = (unsigned)__builtin_amdgcn_readlane((int)gt, src);
        prefix |= d << shift; himask |= 0xFFu << shift; kneed -= (int)gt;
        LDS_WAIT(); asm volatile("" ::: "memory");
    }
    int eqtaken = 0;
    const unsigned long long lt = (1ull << lane) - 1ull;
    for (int base0 = 0; base0 < L; base0 += 1024) { float v[16];
#pragma unroll
        for (int j = 0; j < 16; ++j) v[j] = (base0 + 64 * j + lane < L) ? sc[base0 + 64 * j + lane] : 0.f;
#pragma unroll
        for (int j = 0; j < 16; ++j) { const int base = base0 + 64 * j; if (base < L) {
            const int i = base + lane; const bool valid = i < L; const unsigned u = f2key(v[j]);
            const bool gtm = valid && u > prefix, eqm = valid && u == prefix;
            const unsigned long long meq = __ballot(eqm);
            const bool take = gtm || (eqm && (eqtaken + __popcll(meq & lt) < kneed));
            const unsigned long long mt = __ballot(take);
            if (lane < 2) __hip_atomic_store((gu32*)out + (base >> 5) + lane, (unsigned)(mt >> (32 * lane)), RLX_AGENT);
            eqtaken += __popcll(meq); } }
    }
    const int wdone = ((L + 63) >> 6) << 1;
#pragma unroll
    for (int w = lane; w < 256; w += 64) if (w >= wdone) __hip_atomic_store((gu32*)out + w, 0u, RLX_AGENT);
}
__device__ __forceinline__ void causal_bm_row(int t, unsigned* out, int lane) {
#pragma unroll
    for (int w = lane; w < 256; w += 64) { const int lo_ = 32 * w; __hip_atomic_store((gu32*)out + w, (t >= lo_ + 31) ? 0xffffffffu : (t < lo_ ? 0u : ((2u << (t - lo_)) - 1u)), RLX_AGENT); }
}

__device__ __forceinline__ void dsa_attn_wave(const bf16* P, const unsigned* BM, const bf16* KF, const bf16* VF, bf16* mix, int t0, int h, LAS unsigned char* kst, LAS float* wsf, int lane) {
    typedef float f32x16 __attribute__((ext_vector_type(16)));
    const int r32 = lane & 31, hi = lane >> 5;
    bf16x8 qf[8];
    { const bf16* qrow = P + (size_t)(t0 + r32) * LDP + C_QC + h * 128 + hi * 8;
#pragma unroll
      for (int ks = 0; ks < 8; ++ks) qf[ks] = *(const GAS bf16x8*)(qrow + ks * 16); }
    f32x16 o[4];
#pragma unroll
    for (int db = 0; db < 4; ++db)
#pragma unroll
        for (int i = 0; i < 16; ++i) o[db][i] = 0.f;
    float lsum = 0.f;
    const unsigned* bmrow = BM + (size_t)(t0 + r32) * 256;
    const bf16* kbase = KF + (size_t)h * 256 * 8 * 512 + lane * 8;
    const bf16* vbase = VF + (size_t)h * 128 * 16 * 512 + lane * 8;
    const int nkt = (t0 + 31) / 64 + 1;
#define DSA_KDMA(kt_) do { _Pragma("unroll") for (int f_ = 0; f_ < 16; ++f_) \
        __builtin_amdgcn_global_load_lds((const unsigned*)(kbase + (size_t)((kt_) * 16 + f_) * 512), (LAS unsigned*)(kst + f_ * 1024), 16, 0, 0); } while (0)
    DSA_KDMA(0);
#pragma unroll 1
    for (int kt = 0; kt < nkt; ++kt) {
        bf16x8 kf[16];
        asm volatile("s_waitcnt vmcnt(0)" ::: "memory");
#pragma unroll
        for (int f = 0; f < 16; ++f) kf[f] = *(const LAS bf16x8*)(kst + f * 1024 + lane * 16);
        const unsigned m0 = bmrow[2 * kt] >> (4 * hi), m1 = bmrow[2 * kt + 1] >> (4 * hi);
        asm volatile("s_waitcnt lgkmcnt(0)" ::: "memory");
        if (kt + 1 < nkt) DSA_KDMA(kt + 1);
        f32x16 p[2];
#pragma unroll
        for (int kb = 0; kb < 2; ++kb) {
#pragma unroll
            for (int i = 0; i < 16; ++i) p[kb][i] = 0.f;
#pragma unroll
            for (int ks = 0; ks < 8; ++ks) p[kb] = __builtin_amdgcn_mfma_f32_32x32x16_bf16(kf[kb * 8 + ks], qf[ks], p[kb], 0, 0, 0);
        }
        bf16x8 vf[16];
        { const bf16* vrow = vbase + (size_t)(kt * 16) * 512;
#pragma unroll
          for (int f = 0; f < 16; ++f) vf[f] = *(const GAS bf16x8*)(vrow + f * 512); }
#pragma unroll
        for (int i = 0; i < 16; ++i) { const int kk = (i & 3) + 8 * (i >> 2);
            const float e0 = __builtin_amdgcn_exp2f(fminf(p[0][i], 60.f)), e1 = __builtin_amdgcn_exp2f(fminf(p[1][i], 60.f));
            p[0][i] = __uint_as_float(__float_as_uint(e0) & (unsigned)__builtin_amdgcn_sbfe((int)m0, kk, 1)); p[1][i] = __uint_as_float(__float_as_uint(e1) & (unsigned)__builtin_amdgcn_sbfe((int)m1, kk, 1)); lsum += p[0][i] + p[1][i]; }
        bf16x8 pa[4];
#pragma unroll
        for (int s = 0; s < 4; ++s) { v4u w;
#pragma unroll
            for (int j = 0; j < 4; ++j) w[j] = pk2(p[s >> 1][8 * (s & 1) + 2 * j], p[s >> 1][8 * (s & 1) + 2 * j + 1]);
            pa[s] = __builtin_bit_cast(bf16x8, w); }
#pragma unroll
        for (int db = 0; db < 4; ++db)
#pragma unroll
            for (int s = 0; s < 4; ++s) o[db] = __builtin_amdgcn_mfma_f32_32x32x16_bf16(pa[s], vf[s * 4 + db], o[db], 0, 0, 0);
    }
#undef DSA_KDMA
    lsum = swap32_sum(lsum);
    if (hi == 0) wsf[r32] = lsum;
    LDS_WAIT(); asm volatile("" ::: "memory");
    bf16* orow = mix + (size_t)t0 * DM + 3072 + h * 128 + r32;
#pragma unroll
    for (int i = 0; i < 16; ++i) { const int q = (i & 3) + 8 * (i >> 2) + 4 * hi; const float inv = 1.0f / wsf[q];
#pragma unroll
        for (int db = 0; db < 4; ++db) orow[(size_t)q * DM + 32 * db] = (bf16)f2bf(o[db][i] * inv); }
    LDS_WAIT(); asm volatile("" ::: "memory");
}
__device__ __forceinline__ void dsa_attn_unit(const bf16* P, const unsigned* BM, const bf16* KF, const bf16* VF, bf16* mix, int qb, int h, LAS unsigned char* stage, LAS float* wsf, int wave, int lane) {
    typedef float f32x16 __attribute__((ext_vector_type(16)));
    const int r32 = lane & 31, hi = lane >> 5, t0 = 256 * qb + 32 * wave;
    bf16x8 qf[8];
    { const bf16* qrow = P + (size_t)(t0 + r32) * LDP + C_QC + h * 128 + hi * 8;
#pragma unroll
      for (int ks = 0; ks < 8; ++ks) qf[ks] = *(const GAS bf16x8*)(qrow + ks * 16); }
    f32x16 o[4];
#pragma unroll
    for (int db = 0; db < 4; ++db)
#pragma unroll
        for (int i = 0; i < 16; ++i) o[db][i] = 0.f;
    float lsum = 0.f;
    const unsigned* bmrow = BM + (size_t)(t0 + r32) * 256;
    const bf16* kbase = KF + (size_t)h * 256 * 8 * 512 + lane * 8;
    const bf16* vbase = VF + (size_t)h * 128 * 16 * 512 + lane * 8;
    const int nkt = 4 * qb + 4;
#define DSA_DMA(kt_, buf_) do { _Pragma("unroll") for (int f_ = 0; f_ < 2; ++f_) { \
        __builtin_amdgcn_global_load_lds((const unsigned*)(kbase + (size_t)((kt_) * 16 + 2 * wave + f_) * 512), (LAS unsigned*)(stage + (buf_) * 32768 + (2 * wave + f_) * 1024), 16, 0, 0); \
        __builtin_amdgcn_global_load_lds((const unsigned*)(vbase + (size_t)((kt_) * 16 + 2 * wave + f_) * 512), (LAS unsigned*)(stage + (buf_) * 32768 + 16384 + (2 * wave + f_) * 1024), 16, 0, 0); } } while (0)
    DSA_DMA(0, 0);
    __syncthreads();
#pragma unroll 1
    for (int kt = 0; kt < nkt; ++kt) {
        const LAS unsigned char* sb = stage + (kt & 1) * 32768 + lane * 16;
        if (kt + 1 < nkt) DSA_DMA(kt + 1, (kt + 1) & 1);
        const unsigned m0 = bmrow[2 * kt] >> (4 * hi), m1 = bmrow[2 * kt + 1] >> (4 * hi);
        f32x16 p[2];
#pragma unroll
        for (int kb = 0; kb < 2; ++kb) {
#pragma unroll
            for (int i = 0; i < 16; ++i) p[kb][i] = 0.f;
#pragma unroll
            for (int ks = 0; ks < 8; ++ks) p[kb] = __builtin_amdgcn_mfma_f32_32x32x16_bf16(*(const LAS bf16x8*)(sb + (kb * 8 + ks) * 1024), qf[ks], p[kb], 0, 0, 0);
        }
#pragma unroll
        for (int i = 0; i < 16; ++i) { const int kk = (i & 3) + 8 * (i >> 2);
            const float e0 = __builtin_amdgcn_exp2f(fminf(p[0][i], 60.f)), e1 = __builtin_amdgcn_exp2f(fminf(p[1][i], 60.f));
            p[0][i] = __uint_as_float(__float_as_uint(e0) & (unsigned)__builtin_amdgcn_sbfe((int)m0, kk, 1)); p[1][i] = __uint_as_float(__float_as_uint(e1) & (unsigned)__builtin_amdgcn_sbfe((int)m1, kk, 1)); lsum += p[0][i] + p[1][i]; }
        bf16x8 pa[4];
#pragma unroll
        for (int s = 0; s < 4; ++s) { v4u w;
#pragma unroll
            for (int j = 0; j < 4; ++j) w[j] = pk2(p[s >> 1][8 * (s & 1) + 2 * j], p[s >> 1][8 * (s & 1) + 2 * j + 1]);
            pa[s] = __builtin_bit_cast(bf16x8, w); }
#pragma unroll
        for (int db = 0; db < 4; ++db)
#pragma unroll
            for (int s = 0; s < 4; ++s) o[db] = __builtin_amdgcn_mfma_f32_32x32x16_bf16(pa[s], *(const LAS bf16x8*)(sb + 16384 + (s * 4 + db) * 1024), o[db], 0, 0, 0);
        __syncthreads();
    }
#undef DSA_DMA
    lsum = swap32_sum(lsum);
    if (hi == 0) wsf[r32] = lsum;
    LDS_WAIT(); asm volatile("" ::: "memory");
    bf16* orow = mix + (size_t)t0 * DM + 3072 + h * 128 + r32;
#pragma unroll
    for (int i = 0; i < 16; ++i) { const int q = (i & 3) + 8 * (i >> 2) + 4 * hi; const float inv = 1.0f / wsf[q];
#pragma unroll
        for (int db = 0; db < 4; ++db) orow[(size_t)q * DM + 32 * db] = (bf16)f2bf(o[db][i] * inv); }
    LDS_WAIT(); asm volatile("" ::: "memory");
}
__device__ __forceinline__ void dsa_pretile(const bf16* P, unsigned char* ws, int gw, int NGW, int lane) {
    const int r32 = lane & 31, hi = lane >> 5;
    bf16* KF = (bf16*)(ws + WS_KF); bf16* VF = (bf16*)(ws + WS_VFR); bf16* KIF = (bf16*)(ws + WS_KIF);
    for (int it = gw; it < 2048 + 1024 + 256; it += NGW) {
        if (it < 2048) {
            const int h = it >> 8, kb = it & 255; const bf16* src = P + (size_t)(32 * kb + r32) * LDP + C_KC + h * 128 + 8 * hi;
#pragma unroll
            for (int ks = 0; ks < 8; ++ks) *(GAS v4u*)(KF + ((size_t)((h * 256 + kb) * 8 + ks) * 64 + lane) * 8) = *(const GAS v4u*)(src + 16 * ks);
        } else if (it < 3072) {
            const int h = (it - 2048) >> 7, kt = (it - 2048) & 127; const bf16* src = P + (size_t)(64 * kt + 4 * hi) * LDP + C_VC + h * 128 + r32;
#pragma unroll
            for (int s = 0; s < 4; ++s)
#pragma unroll
                for (int db = 0; db < 4; ++db) { const bf16* q_ = src + (size_t)(16 * s) * LDP + 32 * db; unsigned short e[8];
#pragma unroll
                    for (int j = 0; j < 8; ++j) e[j] = q_[(size_t)(8 * (j >> 2) + (j & 3)) * LDP];
                    v4u o; o.x = e[0] | ((unsigned)e[1] << 16); o.y = e[2] | ((unsigned)e[3] << 16); o.z = e[4] | ((unsigned)e[5] << 16); o.w = e[6] | ((unsigned)e[7] << 16);
                    *(GAS v4u*)(VF + ((size_t)((h * 128 + kt) * 16 + s * 4 + db) * 64 + lane) * 8) = o; }
        } else {
            const int kb = it - 3072; const bf16* src = P + (size_t)(32 * kb + r32) * LDP + C_KI + 8 * hi;
#pragma unroll
            for (int ks = 0; ks < 4; ++ks) *(GAS v4u*)(KIF + ((size_t)(kb * 4 + ks) * 64 + lane) * 8) = *(const GAS v4u*)(src + 16 * ks);
        }
    }
}

__device__ __forceinline__ void finalize_mix(unsigned char* ws, gu32* ctl, int layer, int gw, int NGW, int lane) {
    const bf16* O0 = (const bf16*)(ws + WS_O0); const bf16* O1 = (const bf16*)(ws + WS_O1); bf16* mix = (bf16*)(ws + WS_MIX);
    const int nch = NGW / 40, j = gw % 40, ch = gw / 40;
    if (nch == 0 || ch >= nch) return;
    const int tper = (((SEQ + nch - 1) / nch) + 3) & ~3, tb = ch * tper, te = (tb + tper < SEQ) ? tb + tper : SEQ;
    const int kq = lane & 15, tj = lane >> 4;
    if (j < 8) {
        const float lam = __uint_as_float(__hip_atomic_load(ctl + CW_LAM + layer, RLX_AGENT));
        const float lam_init = 0.8f - 0.6f * expf(-0.3f * (float)layer);
        const float* gp = inp<I_SUBLN>() + layer * 128 + 8 * kq;
        const f32x4 ga = *(const GAS f32x4*)gp * (1.0f - lam_init), gb = *(const GAS f32x4*)(gp + 4) * (1.0f - lam_init);
#pragma unroll 2
        for (int t0 = tb; t0 < te; t0 += 4) {
            const int t = t0 + tj;
            const size_t o = (size_t)t * 1024 + j * 128 + 8 * kq;
            const v4u a = *(const GAS v4u*)(O0 + o), b = *(const GAS v4u*)(O1 + o);
            float x[8];
            x[0] = bflo(a.x) - lam * bflo(b.x); x[1] = bfhi(a.x) - lam * bfhi(b.x); x[2] = bflo(a.y) - lam * bflo(b.y); x[3] = bfhi(a.y) - lam * bfhi(b.y);
            x[4] = bflo(a.z) - lam * bflo(b.z); x[5] = bfhi(a.z) - lam * bfhi(b.z); x[6] = bflo(a.w) - lam * bflo(b.w); x[7] = bfhi(a.w) - lam * bfhi(b.w);
            float ss = 0.f;
#pragma unroll
            for (int i = 0; i < 8; ++i) ss += x[i] * x[i];
            const float rs = 1.0f / sqrtf(dpp_sum16(ss) * (1.f / 128.f) + RMS_EPS);
            v4u w; w.x = pk2(x[0] * rs * ga[0], x[1] * rs * ga[1]); w.y = pk2(x[2] * rs * ga[2], x[3] * rs * ga[3]); w.z = pk2(x[4] * rs * gb[0], x[5] * rs * gb[1]); w.w = pk2(x[6] * rs * gb[2], x[7] * rs * gb[3]);
            *(GAS v4u*)(mix + (size_t)t * DM + j * 128 + 8 * kq) = w;
        }
    } else {
        const float* Y = (const float*)(ws + WS_Y); const float* BON = (const float*)(ws + WS_BON); const unsigned char* XS = ws + WS_XS; const bf16* ZB = (const bf16*)(ws + WS_ZB);
        const int head = j - 8, c4 = head * 64 + 4 * kq;
        const f32x4 lnw = *(const GAS f32x4*)(inp<I_LNW>() + layer * BW + c4), lnb = *(const GAS f32x4*)(inp<I_LNB>() + layer * BW + c4);
#pragma unroll 2
        for (int t0 = tb; t0 < te; t0 += 4) {
            const int t = t0 + tj;
            const f32x4 y = *(const GAS f32x4*)(Y + (size_t)t * BW + c4);
            const us4 g = *(const GAS us4*)(ZB + (size_t)t * 6144 + BW + c4);
            const f32x4 v = *(const GAS f32x4*)(XS + ((size_t)head * SEQ + t) * SREC + 1280 + kq * 16);
            const float bon = BON[t * 32 + head];
            const float mean = dpp_sum16((y[0] + y[1]) + (y[2] + y[3])) * (1.f / 64.f);
            const f32x4 d = y - mean;
            const float var = dpp_sum16((d[0] * d[0] + d[1] * d[1]) + (d[2] * d[2] + d[3] * d[3])) * (1.f / 64.f);
            const float rs = 1.0f / sqrtf(var + GN_EPS);
            float o[4];
#pragma unroll
            for (int i = 0; i < 4; ++i) o[i] = (d[i] * rs * lnw[i] + lnb[i] + bon * v[i]) * bf2f(g[i]);
            typedef unsigned u32x2_t __attribute__((ext_vector_type(2)));
            u32x2_t w; w.x = pk2(o[0], o[1]); w.y = pk2(o[2], o[3]);
            *(GAS u32x2_t*)(mix + (size_t)t * DM + 1024 + c4) = w;
        }
    }
}

constexpr int NPL = 15, NSCAN = 64;
constexpr int PH_FINAL = 2 * NPL, N_PHASES = PH_FINAL + 1;
struct Args { const float* in[N_INPUTS]; float* out; unsigned char* ws; int ph_lo, ph_hi; };
static_assert(sizeof(Args) == N_INPUTS * 8 + 24, "kernarg layout: in[i] at 8*i, out, ws, ph_lo, ph_hi");
__device__ __forceinline__ XcdBarrier bar_make(unsigned char* ws, volatile LAS unsigned* misc) { XcdBarrier b; b.bar = (unsigned*)(ws + WS_CTL) + CW_BAR; b.x = xb_xcc_id(); b.st = misc + 8; return b; }

extern __shared__ __attribute__((aligned(16))) unsigned char lds_[];
#define IN(k) (lo <= (k) && (k) < hi)
#define SEAM(k) do { if (IN(k) && IN((k) + 1)) { const Ctx cb_ = ctx_make(wave0); xcd_barrier(bar_make(cb_.ws, MISC), cb_.tid == 0); } } while (0)
#define WSP(T, off) ((T*)(c.ws + (off)))
#define SEAM5(k) do { if (IN(k) && IN((k) + 5)) { const Ctx cb_ = ctx_make(wave0); xcd_barrier(bar_make(cb_.ws, MISC), cb_.tid == 0); } } while (0)
#ifndef PROBE_PH
#define PROBE_PH 0
#define PROBE_REP 1
#endif
#ifndef REP_SCAN
#define REP_SCAN 1
#define REP_DSA 1
#define REP_ATT 1
#define REP_CONV 1
#endif
#define REPEAT(k) for (int rep_ = 0; rep_ < ((L == 0 && ((PROBE_PH >> (k)) & 1)) ? PROBE_REP : 1); ++rep_)
template <int L> __device__ __forceinline__ void layer_phases(const int lo, const int hi, const int wave0) {
    LAS unsigned char* lds = (LAS unsigned char*)lds_;
    volatile LAS unsigned* MISC = (volatile LAS unsigned*)(lds + MISC_OFF);
    constexpr int pb = L * NPL;
        if (IN(pb + 0)) REPEAT(0) { const Ctx c = ctx_make(wave0, L); layer_prologue(c.ws, (gu32*)(c.ws + WS_CTL), lds, c.l, c.gw, c.NGW, c.wave, c.lane);
            if (L == 0) x_to_stream_rows(inp<I_X>(), WSP(bf16, WS_XR), (unsigned long long*)((gu32*)(c.ws + WS_CTL) + CW_SS + 49152), c.gw, c.NGW, c.lane);
            SEAM(pb + 0); }
        if (IN(pb + 1)) REPEAT(1) { const Ctx c = ctx_make(wave0, L);
            constexpr int NP = 14336;
            pg8::Gemm g{WSP(bf16, WS_XR), WSP(bf16, WS_WIN), SEQ, NP, DM, DM, DM}; pg8::StaticOrder S; S.init(SEQ, NP, c.G, c.bx);
            pg8::EpiBf16x<0> E{WSP(bf16, WS_P), LDP, QA_SCALE, 4, QC_SCALE, C_QC / 256, C_QC / 256 + 4, (const unsigned long long*)((gu32*)(c.ws + WS_CTL) + CW_SS + (L == 0 ? 49152 : 32768)), 1.f / DM, RMS_EPS};
            pg8::gemm_phase<pg8::EpiBf16x<0>, pg8::StaticOrder, true, true>(lds + RING_OFF, g, S, E, c.tid);
            if (L == 1) {
                const Ctx c2 = ctx_make(wave0, L);
                pg8::Gemm g2{(const pg8::bf16_t*)(c2.ws + WS_XR), (const pg8::bf16_t*)(c2.ws + WS_WIN) + (size_t)NP * DM, SEQ, 256, DM / 8, DM, DM}; pg8::SplitKOrder S2; S2.init(SEQ, 8, DM / 8, c2.G, c2.bx);
                pg8::EpiF32x E2{(float*)(c2.ws + WS_Y), 2048, nullptr};
                pg8::gemm_phase<pg8::EpiF32x, pg8::SplitKOrder, true, true>(lds + RING_OFF, g2, S2, E2, c2.tid);
            }
            SEAM(pb + 1);
        }
        if (IN(pb + 2)) REPEAT(2) { const Ctx c = ctx_make(wave0, L); lora_prep(WSP(bf16, WS_P), WSP(bf16, WS_AP), WSP(float, WS_Y), (const unsigned long long*)((gu32*)(c.ws + WS_CTL) + CW_SS + 32768), c.l, c.gw, c.NGW, c.lane);
            dsa_pretile(WSP(bf16, WS_P), c.ws, c.gw, c.NGW, c.lane);
            SEAM(pb + 2); }
        if (IN(pb + 3)) REPEAT(3) { const Ctx c = ctx_make(wave0, L);
            const int N2 = (c.l == 0) ? 6144 : 8192;
            pg8::Gemm g{WSP(bf16, WS_AP), WSP(bf16, WS_BT2), SEQ, N2, 256, 1024, 256}; pg8::LoraOrder S; S.init(SEQ, N2, c.G, c.bx);
            pg8::EpiLora E{WSP(float, WS_Z), WSP(bf16, WS_ZB)};
            pg8::gemm_phase<pg8::EpiLora, pg8::LoraOrder, true, true>(lds + RING_OFF, g, S, E, c.tid);
            SEAM(pb + 3);
        }
        if (IN(pb + 5)) REPEAT(5) {
            for (;;) {
                const Ctx c = ctx_make(wave0, L);
                volatile LAS unsigned* qslot = MISC + 16;
                if (c.tid == 0) qslot[0] = __hip_atomic_fetch_add((gu32*)(c.ws + WS_CTL) + CW_QUEUE + 64 * L + 16 * rep_, 1u, RLX_AGENT);
                __syncthreads();
                int item = (int)qslot[0];
                __syncthreads();
                constexpr int NPREP = 1024, NPREP0 = 256;
                if (item >= NPREP + NSCAN + 1536 + N_CONV_ITEMS) break;
                { int pi = -1;
                  if (item < NPREP0) pi = item; else if (item < NPREP0 + NSCAN) item -= NPREP0; else if (item < NPREP + NSCAN) pi = item - NSCAN; else item -= NPREP;
#if defined(PROBE_SKIP)
                  if (rep_ == 1) { const int cls = (pi >= 0) ? 0 : (item < NSCAN) ? 1 : (item < NSCAN + 256) ? 2 : (item < NSCAN + 1280) ? 3 : (item < NSCAN + 1536) ? 4 : 5; if ((PROBE_SKIP >> cls) & 1) continue; }
#endif
                  if (pi >= 0) {
                      rwkv_prep_item(c.ws, c.l, pi, c.wave, c.lane);
                      asm volatile("s_waitcnt vmcnt(0)" ::: "memory");
                      __syncthreads();
                      if (c.tid == 0) __hip_atomic_store((gu32*)(c.ws + WS_CTL) + CW_PREP + 1024 * L + pi, 1u, RLX_AGENT);
                      continue; } }
                if (item < NSCAN) {
                    { const Ctx c2 = ctx_make(wave0, L);
                      if (c2.tid == 0) { const unsigned x0 = xb_xcc_id() & 7u; unsigned got = 0u;
                          for (unsigned kx = 0; kx < 8u; ++kx) { const unsigned xx = (x0 + kx) & 7u;
                              const unsigned v = __hip_atomic_fetch_add((gu32*)(c2.ws + WS_CTL) + CW_AQ + 64 * (32 + 8 * L + xx), 1u, RLX_AGENT);
                              if (v < 8u) { got = xx * 8u + v; break; } }
                          qslot[1] = got; }
                      __syncthreads(); }
                    const int su = (int)qslot[1];
                    __syncthreads();
                    const Ctx c3 = ctx_make(wave0, L);
                    scan_unit(c3.ws, c3.l, su, c3.wave, c3.lane, lds + RING_OFF);
                }
                else if (item < NSCAN + 256) {
                    const int t0 = 32 * (NSCAN + 255 - item);
                    idx_scores_quad(WSP(bf16, WS_P), WSP(bf16, WS_KIF), WSP(float, WS_SC), t0 + 4 * c.wave, c.lane);
                    __syncthreads();
                    { LAS unsigned* hist = (LAS unsigned*)(lds + RING_OFF + c.wave * 16384);
#pragma unroll 1
                      for (int i = 0; i < 4; ++i) { const int row = t0 + 4 * c.wave + i; unsigned* bm = WSP(unsigned, WS_BM) + (size_t)row * 256;
                          if (row >= 256) topk_row(WSP(float, WS_SC) + (size_t)row * SEQ, row + 1, bm, hist, c.lane); else causal_bm_row(row, bm, c.lane); } }
                    asm volatile("s_waitcnt vmcnt(0)" ::: "memory");
                    __syncthreads();
                    if (c.tid == 0) __hip_atomic_fetch_add((gu32*)(c.ws + WS_CTL) + CW_RDY + 64 * (32 * L + (t0 >> 8)), 1u, RLX_AGENT);
                } else if (item >= NSCAN + 1536) {
                    LAS float* scr = (LAS float*)(lds + RING_OFF + c.wave * 16384);
                    const int ci = item - NSCAN - 1536;
                    const int per = (ci < N_CONV_BIG) ? CONV_PER_ITEM / NWAVES : CONV_PER_SMALL / NWAVES;
                    const int r0 = (ci < N_CONV_BIG) ? ci * CONV_PER_ITEM : N_CONV_BIG * CONV_PER_ITEM + (ci - N_CONV_BIG) * CONV_PER_SMALL;
#pragma unroll 1
                    for (int i = 0; i < per; ++i) conv_late_item(c.ws, c.l, r0 + c.wave * per + i, scr, c.lane);
                } else if (item >= NSCAN + 1280) {
                    const int u = item - NSCAN - 1280, qb = 31 - (u >> 3), h = u & 7;
                    if (c.wave == 0) { gu32* rdy = (gu32*)(c.ws + WS_CTL) + CW_RDY + 64 * (32 * L + qb); gu32* tmo = (gu32*)(c.ws + WS_CTL) + CW_TMO; unsigned sp = 0u;
                        while ((unsigned)__builtin_amdgcn_readfirstlane(__hip_atomic_load(rdy, RLX_AGENT)) < 8u) { __builtin_amdgcn_s_sleep(2);
                            if ((++sp & 255u) == 0u) { if (__builtin_amdgcn_readfirstlane(__hip_atomic_load(tmo, RLX_AGENT)) != 0u) break; if (sp > (1u << 22)) { if (c.lane == 0) __hip_atomic_store(tmo, 1u, RLX_AGENT); break; } } }
                        __builtin_amdgcn_fence(__ATOMIC_ACQUIRE, "agent");
                        asm volatile("s_waitcnt vmcnt(0)" ::: "memory"); }
                    __syncthreads();
                    dsa_attn_unit(WSP(bf16, WS_P), WSP(unsigned, WS_BM), WSP(bf16, WS_KF), WSP(bf16, WS_VFR), WSP(bf16, WS_MIX), qb, h, lds + RING_OFF, (LAS float*)(lds + MISC_OFF + 1024 + c.wave * 256), c.wave, c.lane);
                } else {
                    { const Ctx c2 = ctx_make(wave0, L);
                      if (c2.tid == 0) { const unsigned x0 = xb_xcc_id() & 7u; unsigned got = 0u;
                          for (unsigned kx = 0; kx < 8u; ++kx) { const unsigned xx = (x0 + kx) & 7u;
                              const unsigned v = __hip_atomic_fetch_add((gu32*)(c2.ws + WS_CTL) + CW_AQ + 64 * (8 * L + xx), 1u, RLX_AGENT);
                              if (v < 128u) { got = xx * 128u + v; break; } }
                          qslot[1] = got; }
                      __syncthreads(); }
                    const int a = (int)qslot[1];
                    __syncthreads();
                    const int h = a >> 7, qb = 31 - ((a & 127) >> 2), m = (a >> 1) & 1, vh = a & 1;
                    attn_body::attn_unit<8>((2 * h + m) * 64, 1024 + (2 * h + m) * 64, 2048 + h * 128 + vh * 64, h * 128 + vh * 64, qb, WSP(const attn_body::bf16, WS_P), WSP(const attn_body::bf16, WS_P), WSP(const attn_body::bf16, WS_P),
                                            WSP(attn_body::bf16, m ? WS_O1 : WS_O0), (char*)lds_ + RING_OFF, c.tid);
                }
            }
#if defined(PROBE_UNIT)
            if (L == 0 && blockIdx.x == 0) { const Ctx c = ctx_make(wave0, L); const int t0 = 8160;
                if (PROBE_UNIT == 1 || PROBE_UNIT == 2) idx_scores_quad(WSP(bf16, WS_P), WSP(bf16, WS_KIF), WSP(float, WS_SC), t0 + 4 * c.wave, c.lane);
                __syncthreads();
                if (PROBE_UNIT == 1 || PROBE_UNIT == 3) { LAS unsigned* hist = (LAS unsigned*)(lds + RING_OFF + c.wave * 16384);
#pragma unroll 1
                    for (int i = 0; i < 4; ++i) { const int row = t0 + 4 * c.wave + i; topk_row(WSP(float, WS_SC) + (size_t)row * SEQ, row + 1, WSP(unsigned, WS_BM) + (size_t)row * 256, hist, c.lane); } }
                __syncthreads();
                if (PROBE_UNIT == 1 || PROBE_UNIT == 4) dsa_attn_wave(WSP(bf16, WS_P), WSP(unsigned, WS_BM), WSP(bf16, WS_KF), WSP(bf16, WS_VFR), WSP(bf16, WS_MIX), t0, c.wave, lds + RING_OFF + c.wave * 16384, (LAS float*)(lds + MISC_OFF + 1024 + c.wave * 256), c.lane);
                if (PROBE_UNIT == 5) scan_unit(c.ws, c.l, 0, c.wave, c.lane, lds + RING_OFF);
            }
#endif
            SEAM5(pb + 5);
        }
        if (IN(pb + 10)) REPEAT(10) { const Ctx c = ctx_make(wave0, L); finalize_mix(c.ws, (gu32*)(c.ws + WS_CTL), c.l, c.gw, c.NGW, c.lane); SEAM(pb + 10); }
        if (IN(pb + 11)) REPEAT(11) { const Ctx c = ctx_make(wave0, L);
            pg8::Gemm g{WSP(bf16, WS_MIX), WSP(bf16, WS_WOUT), SEQ, DM, DM, DM, DM}; pg8::StaticOrder S; S.init(SEQ, DM, c.G, c.bx);
            pg8::EpiResN E{(pg8::bf16_t*)(c.ws + WS_XR), DM, nullptr, (const pg8::bf16_t*)(c.ws + WS_XR), (unsigned long long*)((gu32*)(c.ws + WS_CTL) + CW_SS + 16384 * L)};
            pg8::gemm_phase<pg8::EpiResN, pg8::StaticOrder, true, true>(lds + RING_OFF, g, S, E, c.tid);
            SEAM(pb + 11);
        }
        if (IN(pb + 13)) REPEAT(13) { const Ctx c = ctx_make(wave0, L);
            pg8::Gemm g{WSP(bf16, WS_XR), WSP(bf16, WS_WUP), SEQ, DFF, DM, DM, DM}; pg8::StaticOrder S; S.init(SEQ, DFF, c.G, c.bx);
            pg8::EpiUpN E{WSP(bf16, WS_U), DFF, (const unsigned long long*)((gu32*)(c.ws + WS_CTL) + CW_SS + 16384 * L), 1.f / DM, RMS_EPS};
            pg8::gemm_phase<pg8::EpiUpN, pg8::StaticOrder, true, true>(lds + RING_OFF, g, S, E, c.tid);
            SEAM(pb + 13);
        }
        if (IN(pb + 14)) REPEAT(14) { const Ctx c = ctx_make(wave0, L);
            pg8::Gemm g{WSP(bf16, WS_U), WSP(bf16, WS_WDN), SEQ, DM, DFF, DFF, DFF}; pg8::StaticOrder S; S.init(SEQ, DM, c.G, c.bx);
            pg8::EpiResN E{(pg8::bf16_t*)(c.ws + WS_XR), DM, nullptr, (const pg8::bf16_t*)(c.ws + WS_XR), (L == 0) ? (unsigned long long*)((gu32*)(c.ws + WS_CTL) + CW_SS + 32768) : nullptr};
            pg8::gemm_phase<pg8::EpiResN, pg8::StaticOrder, true, true>(lds + RING_OFF, g, S, E, c.tid);
            SEAM(pb + 14);
        }
    }
__global__ void __launch_bounds__(NWAVES * 64, 2) mk_fwd(Args args) {
    LAS unsigned char* lds = (LAS unsigned char*)lds_;
    volatile LAS unsigned* MISC = (volatile LAS unsigned*)(lds + MISC_OFF);
    for (int u = threadIdx.x; u < (LDS_BYTES - LDSCTL_OFF) / 4; u += NWAVES * 64) ((LAS unsigned*)(lds + LDSCTL_OFF))[u] = 0u;
    __syncthreads();
    const int lo = args.ph_lo, hi = args.ph_hi, wave0 = __builtin_amdgcn_readfirstlane((int)threadIdx.x >> 6);
    if (hi - lo > 1) (void)xcd_barrier_post((unsigned*)(ARG_WS + WS_CTL) + CW_BAR, MISC + 8);

    layer_phases<0>(lo, hi, wave0);
    layer_phases<1>(lo, hi, wave0);
    if (IN(PH_FINAL)) { const Ctx c = ctx_make(wave0); rmsnorm_rows_from_bf16<true>((const bf16*)(c.ws + WS_XR), inp<I_NFIN>(), ARG_OUT, c.gw, c.NGW, c.lane); }
#undef IN
#undef SEAM
#undef WSP
}

extern "C" void kernel_launch(void* const* d_in, const int* in_sizes, int n_in, void* d_out, int out_size, void* d_ws, size_t ws_size, hipStream_t stream) {
    static int grid = 0;
    if (grid == 0) {
        if (n_in != N_INPUTS || in_sizes[0] != SEQ * DM || out_size != SEQ * DM || ws_size < WS_END) {
            fprintf(stderr, "kernel_launch: unexpected shapes: n_in %d in0 %d out %d ws %zu (need %zu)\n", n_in, n_in > 0 ? in_sizes[0] : -1, out_size, ws_size, (size_t)WS_END); _exit(77); }
        int dev = 0, cus = 0;
        if (hipGetDevice(&dev) != hipSuccess || hipDeviceGetAttribute(&cus, hipDeviceAttributeMultiprocessorCount, dev) != hipSuccess) { grid = -1; return; }
        if (hipFuncSetAttribute((const void*)mk_fwd, hipFuncAttributeMaxDynamicSharedMemorySize, LDS_BYTES) != hipSuccess) { fprintf(stderr, "kernel_launch: hipFuncSetAttribute failed\n"); grid = -1; return; }
        (void)hipGetLastError();
        grid = cus;
    }
    if (grid < 0) return;
    if (hipMemsetAsync((char*)d_ws + WS_CTL, 0, CTL_ZERO_BYTES, stream) != hipSuccess) return;
    Args a{};
    for (int i = 0; i < N_INPUTS; ++i) a.in[i] = (const float*)d_in[i];
    a.out = (float*)d_out; a.ws = (unsigned char*)d_ws;
#ifndef MK_ONE_LAUNCH
#ifndef MK_MAXPH
#define MK_MAXPH N_PHASES
#endif
    for (int ph = 0; ph < MK_MAXPH; ++ph) { a.ph_lo = ph; a.ph_hi = ph + 1;
        hipLaunchKernelGGL(mk_fwd, dim3(grid), dim3(NWAVES * 64), LDS_BYTES, stream, a); }
#else
    a.ph_lo = 0; a.ph_hi = N_PHASES;
    hipLaunchKernelGGL(mk_fwd, dim3(grid), dim3(NWAVES * 64), LDS_BYTES, stream, a);
#endif
}
```
